# Optimizing an MI355X kernel written in HIP

```python
import math
import jax, jax.numpy as jnp
from jax import lax
import numpy as np

D_MODEL = 2048
BATCH = 8
SEQ = 2048
DEPTH = 1

N_META = 16
MIX_WIDTH = D_MODEL
RWKV_WIDTH = MIX_WIDTH // 2
RWKV_HEAD_DIM = 64
RWKV_HEADS = RWKV_WIDTH // RWKV_HEAD_DIM
RWKV_LORA_W = 64
RWKV_LORA_A = 64
RWKV_SHIFT_COLS = 3 * RWKV_WIDTH + RWKV_LORA_W + RWKV_LORA_A
RWKV_COLS = RWKV_SHIFT_COLS + RWKV_WIDTH
DIFF_WIDTH = MIX_WIDTH - RWKV_WIDTH
DIFF_HEAD_DIM = 64
DIFF_V_DIM = 2 * DIFF_HEAD_DIM
DIFF_HEADS = DIFF_WIDTH // DIFF_V_DIM
DIFF_COLS = 4 * DIFF_WIDTH
IN_COLS = RWKV_COLS + DIFF_COLS

ROPE_THETA = 10000.0
Q_BLOCK = 128
NORM_EPS = 1e-6
GN_EPS = 64e-5
SUBLN_EPS = 1e-5

kernel_name = "hymba_rwkv7_diffattn_hybrid"


def rms_norm(x, g, eps=NORM_EPS):
    xf = x.astype(jnp.float32)
    y = xf * lax.rsqrt(jnp.mean(xf * xf, axis=-1, keepdims=True) + eps)
    return (y * g.astype(jnp.float32)).astype(x.dtype)


def rope_tables(L):
    pos = jnp.arange(L, dtype=jnp.float32)
    inv_freq = ROPE_THETA ** (-jnp.arange(0, DIFF_HEAD_DIM, 2, dtype=jnp.float32) / DIFF_HEAD_DIM)
    ang = pos[:, None] * inv_freq[None, :]
    ang = jnp.concatenate([ang, ang], axis=-1)
    return jnp.cos(ang), jnp.sin(ang)


def apply_rope(x, cos, sin):
    half = x.shape[-1] // 2
    x1, x2 = x[..., :half], x[..., half:]
    rot = jnp.concatenate([-x2, x1], axis=-1)
    c = cos[None, :, None, :].astype(x.dtype)
    s = sin[None, :, None, :].astype(x.dtype)
    return x * c + rot * s


def rwkv7_branch(u, mu, w0, w_up, a0, a_up, k_k, k_a, r_k, gn_w, gn_b):
    Bn, L, _ = u.shape
    H, Dh, C = RWKV_HEADS, RWKV_HEAD_DIM, RWKV_WIDTH
    u_prev = jnp.pad(u, ((0, 0), (1, 0), (0, 0)))[:, :-1]
    u = u + (u_prev - u) * mu.astype(u.dtype)
    r = u[..., :C]
    k = u[..., C:2 * C]
    v = u[..., 2 * C:3 * C]
    wd = u[..., 3 * C:3 * C + RWKV_LORA_W]
    ad = u[..., 3 * C + RWKV_LORA_W:]
    w = -jax.nn.softplus(-(w0 + jnp.tanh(wd) @ w_up).astype(jnp.float32)) - 0.5
    decay = jnp.exp(-jnp.exp(w))
    a = jax.nn.sigmoid((a0 + ad @ a_up).astype(jnp.float32))
    hs = lambda t: t.reshape(Bn, L, H, Dh).astype(jnp.float32)
    r, k, v, decay, a = hs(r), hs(k), hs(v), hs(decay), hs(a)
    kk = k * k_k.reshape(H, Dh).astype(jnp.float32)
    kk = kk / jnp.maximum(jnp.sqrt(jnp.sum(kk * kk, axis=-1, keepdims=True)), 1e-12)
    k = k * (1.0 + (a - 1.0) * k_a.reshape(H, Dh).astype(jnp.float32))
    b = kk * a

    def step(S, inp):
        r_t, w_t, k_t, v_t, kk_t, b_t = inp
        sa = jnp.einsum('bhvk,bhk->bhv', S, -kk_t)
        S = S * w_t[:, :, None, :] + sa[..., None] * b_t[:, :, None, :] + v_t[..., None] * k_t[:, :, None, :]
        y = jnp.einsum('bhvk,bhk->bhv', S, r_t)
        return S, y

    tm = lambda t: jnp.moveaxis(t, 1, 0)
    S0 = jnp.zeros((Bn, H, Dh, Dh), jnp.float32)
    _, ys = lax.scan(step, S0, (tm(r), tm(decay), tm(k), tm(v), tm(kk), tm(b)))
    y = jnp.moveaxis(ys, 0, 1)
    mean = jnp.mean(y, axis=-1, keepdims=True)
    var = jnp.mean(jnp.square(y - mean), axis=-1, keepdims=True)
    y = ((y - mean) * lax.rsqrt(var + GN_EPS)).reshape(Bn, L, C)
    y = y * gn_w.astype(jnp.float32) + gn_b.astype(jnp.float32)
    bonus = jnp.sum(r * k * r_k.astype(jnp.float32)[None, None], axis=-1, keepdims=True) * v
    y = y + bonus.reshape(Bn, L, C)
    return y.astype(u.dtype)


def diff_attn_branch(q, k, v, cos, sin, lam_q1, lam_k1, lam_q2, lam_k2, subln_w, lambda_init):
    Bn, L, _ = q.shape
    H, Dh = DIFF_HEADS, DIFF_HEAD_DIM
    q = apply_rope(q.reshape(Bn, L, 2 * H, Dh), cos, sin).reshape(Bn, L, H, 2, Dh)
    k = apply_rope(k.reshape(Bn, L, 2 * H, Dh), cos, sin).reshape(Bn, L, H, 2, Dh)
    v = v.reshape(Bn, L, H, DIFF_V_DIM)
    lam = (jnp.exp(jnp.sum(lam_q1.astype(jnp.float32) * lam_k1.astype(jnp.float32)))
           - jnp.exp(jnp.sum(lam_q2.astype(jnp.float32) * lam_k2.astype(jnp.float32)))
           + lambda_init)
    scale = Dh ** -0.5
    bounds = [0] + list(range(N_META, L, Q_BLOCK)) + [L]
    outs = []
    for s, e in zip(bounds[:-1], bounds[1:]):
        qb = q[:, s:e]
        kb = k[:, :e]
        vb = v[:, :e]
        sc = jnp.einsum('bqhcd,bkhcd->bhcqk', qb, kb).astype(jnp.float32) * scale
        mask = jnp.arange(e)[None, :] <= jnp.arange(s, e)[:, None]
        sc = jnp.where(mask, sc, -jnp.inf)
        p = jax.nn.softmax(sc, axis=-1)
        attn = p[:, :, 0] - lam * p[:, :, 1]
        outs.append(jnp.einsum('bhqk,bkhd->bqhd', attn.astype(vb.dtype), vb))
    o = jnp.concatenate(outs, axis=1)
    o = rms_norm(o, subln_w, SUBLN_EPS) * (1.0 - lambda_init)
    return o.reshape(Bn, L, DIFF_WIDTH)


def setup_inputs(seed: int = 0) -> dict:
    key = jax.random.key(seed)
    ks = jax.random.split(key, 24)
    f32 = jnp.float32
    nrm = lambda k, shape, s: jax.random.normal(k, shape, f32) * s
    H, Dh = RWKV_HEADS, RWKV_HEAD_DIM
    return {
        "x": nrm(ks[0], (BATCH, SEQ, D_MODEL), 1.0),
        "meta_tokens": nrm(ks[1], (N_META, D_MODEL), 1.0),
        "pre_norm_w": 1.0 + nrm(ks[2], (DEPTH, D_MODEL), 0.05),
        "w_in": nrm(ks[3], (DEPTH, D_MODEL, IN_COLS), D_MODEL ** -0.5),
        "rwkv_mu": jax.random.uniform(ks[4], (DEPTH, RWKV_SHIFT_COLS), f32, 0.0, 1.0),
        "rwkv_w0": jax.random.uniform(ks[5], (DEPTH, RWKV_WIDTH), f32, -3.0, 1.0),
        "rwkv_w_up": nrm(ks[6], (DEPTH, RWKV_LORA_W, RWKV_WIDTH), 0.1),
        "rwkv_a0": nrm(ks[7], (DEPTH, RWKV_WIDTH), 0.1),
        "rwkv_a_up": nrm(ks[8], (DEPTH, RWKV_LORA_A, RWKV_WIDTH), 0.1),
        "rwkv_k_k": 0.85 + nrm(ks[9], (DEPTH, RWKV_WIDTH), 0.05),
        "rwkv_k_a": 1.0 + nrm(ks[10], (DEPTH, RWKV_WIDTH), 0.05),
        "rwkv_r_k": nrm(ks[11], (DEPTH, H, Dh), 0.1),
        "rwkv_gn_w": 1.0 + nrm(ks[12], (DEPTH, RWKV_WIDTH), 0.05),
        "rwkv_gn_b": nrm(ks[13], (DEPTH, RWKV_WIDTH), 0.01),
        "diff_lam_q1": nrm(ks[14], (DEPTH, DIFF_HEAD_DIM), 0.1),
        "diff_lam_k1": nrm(ks[15], (DEPTH, DIFF_HEAD_DIM), 0.1),
        "diff_lam_q2": nrm(ks[16], (DEPTH, DIFF_HEAD_DIM), 0.1),
        "diff_lam_k2": nrm(ks[17], (DEPTH, DIFF_HEAD_DIM), 0.1),
        "diff_subln_w": 1.0 + nrm(ks[18], (DEPTH, DIFF_V_DIM), 0.05),
        "w_out": nrm(ks[19], (DEPTH, MIX_WIDTH, D_MODEL), MIX_WIDTH ** -0.5),
        "post_norm_w": 1.0 + nrm(ks[20], (DEPTH, D_MODEL), 0.05),
    }


def reference(x, meta_tokens, pre_norm_w, w_in, rwkv_mu, rwkv_w0, rwkv_w_up, rwkv_a0, rwkv_a_up,
              rwkv_k_k, rwkv_k_a, rwkv_r_k, rwkv_gn_w, rwkv_gn_b, diff_lam_q1, diff_lam_k1,
              diff_lam_q2, diff_lam_k2, diff_subln_w, w_out, post_norm_w):
    Bn = x.shape[0]
    meta = jnp.broadcast_to(meta_tokens[None].astype(x.dtype), (Bn, N_META, D_MODEL))
    h = jnp.concatenate([meta, x], axis=1)
    L = h.shape[1]
    cos, sin = rope_tables(L)
    for layer in range(DEPTH):
        lambda_init = 0.8 - 0.6 * math.exp(-0.3 * layer)
        hn = rms_norm(h, pre_norm_w[layer])
        proj = hn @ w_in[layer]
        u_r = proj[..., :RWKV_SHIFT_COLS]
        g_r = proj[..., RWKV_SHIFT_COLS:RWKV_COLS]
        o = RWKV_COLS
        q_d = proj[..., o:o + DIFF_WIDTH]
        k_d = proj[..., o + DIFF_WIDTH:o + 2 * DIFF_WIDTH]
        v_d = proj[..., o + 2 * DIFF_WIDTH:o + 3 * DIFF_WIDTH]
        g_d = proj[..., o + 3 * DIFF_WIDTH:o + 4 * DIFF_WIDTH]
        y_r = rwkv7_branch(u_r, rwkv_mu[layer], rwkv_w0[layer], rwkv_w_up[layer], rwkv_a0[layer],
                           rwkv_a_up[layer], rwkv_k_k[layer], rwkv_k_a[layer], rwkv_r_k[layer],
                           rwkv_gn_w[layer], rwkv_gn_b[layer]) * jax.nn.silu(g_r)
        y_d = diff_attn_branch(q_d, k_d, v_d, cos, sin, diff_lam_q1[layer], diff_lam_k1[layer],
                               diff_lam_q2[layer], diff_lam_k2[layer], diff_subln_w[layer],
                               lambda_init) * jax.nn.silu(g_d)
        y = jnp.concatenate([y_r, y_d], axis=-1) @ w_out[layer]
        h = h + rms_norm(y, post_norm_w[layer])
    return h[:, N_META:]
```

```cpp
#include <hip/hip_runtime.h>
#include <hip/hip_cooperative_groups.h>
#include <cstdio>
#include <cstdint>
#include <cmath>
namespace cg = cooperative_groups;

#ifndef MK_N_LAUNCHES
#define MK_N_LAUNCHES 5
#endif

constexpr int NB = 8, TS = 2048, NMETA = 16, LSEQ = TS + NMETA, LP = 2112, DM = 2048;
constexpr int MR = NB * TS;
constexpr int MP = 16640;
constexpr int N1 = 8448;
constexpr int NIN = 8320;
constexpr int NPH = 5;

namespace pg8 {
#define PG8_LAS __attribute__((address_space(3)))
typedef unsigned short bf16_t;
typedef short bf16x8 __attribute__((ext_vector_type(8)));
typedef float f32x4 __attribute__((ext_vector_type(4)));
typedef unsigned u32x4 __attribute__((ext_vector_type(4)));
constexpr int BM = 256, BK = 64, HALF = 128, HTB = HALF * BK * 2, STAGE_BYTES = 8 * HTB, NXCD = 8, WGM = 8;

__host__ __device__ __forceinline__ int lds_byte(int r, int c) { const int st = (r >> 4) * 2 + (c >> 5), rr = r & 15, cc = c & 31, ob = rr * 64 + cc * 2; return st * 1024 + (ob ^ (((ob >> 9) & 1) << 5)); }
__host__ __device__ __forceinline__ void stage_rc(int b, int& R, int& C) { const int st = b / 1024, sb = b % 1024, swz = sb ^ (((sb >> 9) & 1) << 5); R = (st >> 1) * 16 + swz / 64; C = (st & 1) * 32 + (swz % 64) / 2; }
__host__ __device__ __forceinline__ int perm32(int rho) { const int n = rho >> 4, i = rho & 15; return 8 * (i >> 2) + 4 * n + (i & 3); }

struct Unit { int pm, pn; };
struct Gemm { const bf16_t* A; const bf16_t* Bt; int M, N, K; };

struct StaticOrder {
    int nM, nN, nwg, G, c;
    __host__ __device__ void init(int M, int N, int G_, int c_) { nM = M / BM; nN = N / BM; nwg = nM * nN; G = G_; c = c_; }
    __host__ __device__ bool next(int i, Unit& u) const {
        const long L = (long)i * G + c; if (L >= nwg) return false;
        int wgid = (int)L; { const int q = nwg / NXCD, r = nwg % NXCD, xcd = wgid % NXCD, off = wgid / NXCD; wgid = (xcd < r ? xcd * (q + 1) : r * (q + 1) + (xcd - r) * q) + off; }
        const int nig = WGM * nN, gid = wgid / nig, fm = gid * WGM, gsz = (nM - fm) < WGM ? (nM - fm) : WGM;
        u.pm = fm + ((wgid % nig) % gsz); u.pn = (wgid % nig) / gsz; return true;
    }
    __device__ __forceinline__ void a_ready(const Unit&) const {}
    __device__ __forceinline__ void done(const Unit&) const {}
};

__device__ __forceinline__ unsigned cvt_pk_bf16(float lo, float hi) { unsigned r; asm volatile("v_cvt_pk_bf16_f32 %0, %1, %2" : "=v"(r) : "v"(lo), "v"(hi)); return r; }

template <class Epi, class Sched, bool ALIGN_EPI = false, bool SP2 = false>
__device__ __forceinline__ void gemm_phase(PG8_LAS unsigned char* lds, const Gemm g, const Sched& S, const Epi& E) {
    const int tid = threadIdx.x, wid = __builtin_amdgcn_readfirstlane(tid >> 6), lane = tid & 63, wr = wid >> 2, wc = wid & 3, fr = lane & 15, fq = lane >> 4;
    const int K = g.K, nt = K / BK;
    unsigned voffA[2], voffB[2];
#pragma unroll
    for (int i = 0; i < 2; ++i) { int R, C; stage_rc(tid * 16 + i * 8192, R, C); const int Rb = Epi::PERM ? ((R & ~31) + perm32(R & 31)) : R;
        voffA[i] = (unsigned)(R * K + C) * 2u; voffB[i] = (unsigned)(Rb * K + C) * 2u; }
    const size_t kstep = (size_t)(BK * 2);
    const size_t hstep = (size_t)HALF * K * 2;
    const size_t tstep = 2 * hstep;
    const unsigned ldsw = (unsigned)wid * 1024u;
    const int aoff = lds_byte(wr * 64 + fr, fq * 8), boff = lds_byte(wc * 32 + fr, fq * 8);
#define PG8_SA(b, h) (((b) * 2 + (h)) * HTB)
#define PG8_SB(b, h) ((4 + (b) * 2 + (h)) * HTB)
#define PG8_STAGE(bufoff, gbase, voff) do { _Pragma("unroll") for (int _i = 0; _i < 2; ++_i) \
        __builtin_amdgcn_global_load_lds((const unsigned*)((const char*)(gbase) + (voff)[_i]), (PG8_LAS unsigned*)(lds + (bufoff) + ldsw + _i * 8192), 16, 0, 0); } while (0)
#define PG8_LDA(dst, b, h) do { _Pragma("unroll") for (int m = 0; m < 4; ++m) _Pragma("unroll") for (int k = 0; k < 2; ++k) dst[m][k] = *(const PG8_LAS bf16x8*)(lds + PG8_SA(b, h) + aoff + m * 2048 + k * 1024); } while (0)
#define PG8_LDB(dst, b, h) do { _Pragma("unroll") for (int n = 0; n < 2; ++n) _Pragma("unroll") for (int k = 0; k < 2; ++k) dst[n][k] = *(const PG8_LAS bf16x8*)(lds + PG8_SB(b, h) + boff + n * 2048 + k * 1024); } while (0)
#define PG8_MMA(ai, bj, At, Bt) do { __builtin_amdgcn_s_setprio(1); _Pragma("unroll") for (int m = 0; m < 4; ++m) _Pragma("unroll") for (int n = 0; n < 2; ++n) _Pragma("unroll") for (int k = 0; k < 2; ++k) \
        acc[ai][bj][m][n] = __builtin_amdgcn_mfma_f32_16x16x32_bf16(Bt[n][k], At[m][k], acc[ai][bj][m][n], 0, 0, 0); __builtin_amdgcn_s_setprio(0); } while (0)
#define PG8_WAIT_V(n) asm volatile("s_waitcnt vmcnt(" #n ")" ::: "memory")
#define PG8_WAIT_L(n) asm volatile("s_waitcnt lgkmcnt(" #n ")" ::: "memory")
#define PG8_BAR __builtin_amdgcn_s_barrier()
#define PG8_SCHED __builtin_amdgcn_sched_barrier(0)
    Unit cur, nxt; int ui = 0;
    if (!S.next(0, cur)) return;
    f32x4 acc[2][2][4][2];
#pragma unroll
    for (int a = 0; a < 2; ++a)
#pragma unroll
        for (int b = 0; b < 2; ++b)
#pragma unroll
            for (int m = 0; m < 4; ++m)
#pragma unroll
                for (int n = 0; n < 2; ++n) acc[a][b][m][n] = (f32x4){0.f, 0.f, 0.f, 0.f};
    bf16x8 At[4][2], B0[2][2], B1[2][2];
    const char* cA = (const char*)g.A + (size_t)cur.pm * tstep; const char* cB = (const char*)g.Bt + (size_t)cur.pn * tstep;
    S.a_ready(cur);
    if constexpr (SP2) {
        PG8_STAGE(PG8_SB(0, 0), cB, voffB); PG8_STAGE(PG8_SB(0, 1), cB + hstep, voffB); PG8_STAGE(PG8_SA(0, 0), cA, voffA); PG8_STAGE(PG8_SA(0, 1), cA + hstep, voffA);
        if (wr == 1) PG8_BAR;
        PG8_WAIT_V(2); PG8_BAR;
        PG8_STAGE(PG8_SB(1, 0), cB + kstep, voffB); PG8_STAGE(PG8_SA(1, 0), cA + kstep, voffA); PG8_STAGE(PG8_SB(1, 1), cB + hstep + kstep, voffB);
        PG8_WAIT_V(6); PG8_BAR;
    } else {
        PG8_STAGE(PG8_SB(0, 0), cB, voffB); PG8_STAGE(PG8_SA(0, 0), cA, voffA); PG8_STAGE(PG8_SB(0, 1), cB + hstep, voffB); PG8_STAGE(PG8_SA(0, 1), cA + hstep, voffA);
        if (wr == 1) PG8_BAR;
        PG8_WAIT_V(4); PG8_BAR;
        PG8_STAGE(PG8_SB(1, 0), cB + kstep, voffB); PG8_STAGE(PG8_SA(1, 0), cA + kstep, voffA); PG8_STAGE(PG8_SB(1, 1), cB + hstep + kstep, voffB);
        PG8_WAIT_V(6); PG8_BAR;
    }
    for (;;) {
        const bool has_next = S.next(ui + 1, nxt);
        const char* nA = has_next ? (const char*)g.A + (size_t)nxt.pm * tstep : cA; const char* nB = has_next ? (const char*)g.Bt + (size_t)nxt.pn * tstep : cB;
        for (int t = 0; t < nt; t += 2) {
            const bool last = (t == nt - 2);
            const char* a1 = cA + (size_t)(t + 1) * kstep;
            const char* a2 = last ? nA : cA + (size_t)(t + 2) * kstep; const char* b2 = last ? nB : cB + (size_t)(t + 2) * kstep;
            const char* a3 = a2 + kstep; const char* b3 = b2 + kstep;
            if (last && has_next) S.a_ready(nxt);
            if constexpr (SP2) {
            PG8_LDB(B0, 0, 0); PG8_LDB(B1, 0, 1); PG8_SCHED; PG8_LDA(At, 0, 0); PG8_STAGE(PG8_SA(1, 1), a1 + hstep, voffA);
            PG8_WAIT_V(8); PG8_WAIT_L(0); PG8_BAR; PG8_MMA(0, 0, At, B0); PG8_MMA(0, 1, At, B1); PG8_BAR; PG8_SCHED;
            PG8_LDA(At, 0, 1); PG8_STAGE(PG8_SB(0, 0), b2, voffB); PG8_STAGE(PG8_SB(0, 1), b2 + hstep, voffB); PG8_STAGE(PG8_SA(0, 0), a2, voffA);
            PG8_WAIT_V(8); PG8_WAIT_L(0); PG8_BAR; PG8_MMA(1, 0, At, B0); PG8_MMA(1, 1, At, B1); PG8_BAR; PG8_SCHED;
            PG8_LDB(B0, 1, 0); PG8_LDB(B1, 1, 1); PG8_SCHED; PG8_LDA(At, 1, 0); PG8_STAGE(PG8_SA(0, 1), a2 + hstep, voffA);
            PG8_WAIT_V(8); PG8_WAIT_L(0); PG8_BAR; PG8_MMA(0, 0, At, B0); PG8_MMA(0, 1, At, B1); PG8_BAR; PG8_SCHED;
            PG8_LDA(At, 1, 1); PG8_STAGE(PG8_SB(1, 0), b3, voffB); PG8_STAGE(PG8_SB(1, 1), b3 + hstep, voffB); PG8_STAGE(PG8_SA(1, 0), a3, voffA);
            PG8_WAIT_V(8); PG8_WAIT_L(0); PG8_BAR; PG8_MMA(1, 0, At, B0); PG8_MMA(1, 1, At, B1); PG8_BAR; PG8_SCHED;
            } else {
            PG8_LDB(B0, 0, 0); PG8_SCHED; PG8_LDA(At, 0, 0); PG8_STAGE(PG8_SA(1, 1), a1 + hstep, voffA);
            PG8_WAIT_L(8); PG8_BAR; PG8_WAIT_L(0); PG8_MMA(0, 0, At, B0); PG8_BAR; PG8_SCHED;
            PG8_LDB(B1, 0, 1); PG8_STAGE(PG8_SB(0, 0), b2, voffB);
            PG8_BAR; PG8_WAIT_L(0); PG8_MMA(0, 1, At, B1); PG8_BAR;
            PG8_LDA(At, 0, 1); PG8_STAGE(PG8_SA(0, 0), a2, voffA);
            PG8_BAR; PG8_WAIT_L(0); PG8_MMA(1, 0, At, B0); PG8_BAR; PG8_SCHED;
            PG8_STAGE(PG8_SB(0, 1), b2 + hstep, voffB);
            PG8_WAIT_V(6); PG8_BAR; PG8_MMA(1, 1, At, B1); PG8_BAR;
            PG8_LDB(B0, 1, 0); PG8_SCHED; PG8_LDA(At, 1, 0); PG8_STAGE(PG8_SA(0, 1), a2 + hstep, voffA);
            PG8_WAIT_L(8); PG8_BAR; PG8_WAIT_L(0); PG8_MMA(0, 0, At, B0); PG8_BAR; PG8_SCHED;
            PG8_LDB(B1, 1, 1); PG8_STAGE(PG8_SB(1, 0), b3, voffB);
            PG8_BAR; PG8_WAIT_L(0); PG8_MMA(0, 1, At, B1); PG8_BAR;
            PG8_LDA(At, 1, 1); PG8_STAGE(PG8_SA(1, 0), a3, voffA);
            PG8_BAR; PG8_WAIT_L(0); PG8_MMA(1, 0, At, B0); PG8_BAR; PG8_SCHED;
            PG8_STAGE(PG8_SB(1, 1), b3 + hstep, voffB);
            PG8_WAIT_V(6); PG8_BAR; PG8_MMA(1, 1, At, B1); PG8_BAR;
            }
        }
        if constexpr (ALIGN_EPI) { if (wr == 0) PG8_BAR; }
        if constexpr (!Epi::AFTER_DRAIN) { E(acc, cur, wr, wc, fr, fq); S.done(cur); }
        if (!has_next) break;
#pragma unroll
        for (int a = 0; a < 2; ++a)
#pragma unroll
            for (int b = 0; b < 2; ++b)
#pragma unroll
                for (int m = 0; m < 4; ++m)
#pragma unroll
                    for (int n = 0; n < 2; ++n) acc[a][b][m][n] = (f32x4){0.f, 0.f, 0.f, 0.f};
        cur = nxt; cA = nA; cB = nB; ++ui;
        if constexpr (ALIGN_EPI) { if (wr == 1) PG8_BAR; }
    }
    PG8_WAIT_V(0);
    if constexpr (!ALIGN_EPI) { if (wr == 0) PG8_BAR; }
    PG8_BAR;
    if constexpr (Epi::AFTER_DRAIN) { E.fused(acc, cur, wr, wc, fr, fq, lds, wid, lane); S.done(cur); }
#undef PG8_SA
#undef PG8_SB
#undef PG8_STAGE
#undef PG8_LDA
#undef PG8_LDB
#undef PG8_MMA
#undef PG8_WAIT_V
#undef PG8_WAIT_L
#undef PG8_BAR
#undef PG8_SCHED
}
}

#define LAS __attribute__((address_space(3)))
typedef unsigned short bf16_t;
typedef short bf16x8 __attribute__((ext_vector_type(8)));
typedef short s16x4 __attribute__((ext_vector_type(4)));
typedef float f32x4 __attribute__((ext_vector_type(4)));
typedef float f32x2 __attribute__((ext_vector_type(2)));
typedef float f32x16 __attribute__((ext_vector_type(16)));
typedef unsigned u32x4 __attribute__((ext_vector_type(4)));
typedef unsigned u32x2 __attribute__((ext_vector_type(2)));
typedef __bf16 bf16x2_t __attribute__((ext_vector_type(2)));

__device__ __forceinline__ unsigned pk2(float lo, float hi) { f32x2 v = {lo, hi}; bf16x2_t b = __builtin_convertvector(v, bf16x2_t); return __builtin_bit_cast(unsigned, b); }
__device__ __forceinline__ float bflo(unsigned u) { return __uint_as_float(u << 16); }
__device__ __forceinline__ float bfhi(unsigned u) { return __uint_as_float(u & 0xffff0000u); }
__device__ __forceinline__ float fexp(float x) { return __builtin_amdgcn_exp2f(x * 1.4426950408889634f); }
__device__ __forceinline__ float frcp(float x) { return __builtin_amdgcn_rcpf(x); }
__device__ __forceinline__ float sigmoidf_(float x) { return frcp(1.f + fexp(-x)); }
template <int CTRL> __device__ __forceinline__ float dpp(float x) { return __builtin_bit_cast(float, __builtin_amdgcn_update_dpp(0, __builtin_bit_cast(int, x), CTRL, 0xf, 0xf, true)); }
__device__ __forceinline__ float swap32_sum(float x) { auto rr = __builtin_amdgcn_permlane32_swap(__float_as_uint(x), __float_as_uint(x), false, false); return __uint_as_float(rr[0]) + __uint_as_float(rr[1]); }
__device__ __forceinline__ float swap32_max(float x) { auto rr = __builtin_amdgcn_permlane32_swap(__float_as_uint(x), __float_as_uint(x), false, false); return fmaxf(__uint_as_float(rr[0]), __uint_as_float(rr[1])); }
__device__ __forceinline__ float swap16_sum(float x) { auto rr = __builtin_amdgcn_permlane16_swap(__float_as_uint(x), __float_as_uint(x), false, false); return __uint_as_float(rr[0]) + __uint_as_float(rr[1]); }
__device__ __forceinline__ float sum8(float x) { x += dpp<0xB1>(x); x += dpp<0x4E>(x); x += dpp<0x141>(x); return x; }
__device__ __forceinline__ float wave_sum(float x) { x += dpp<0xB1>(x); x += dpp<0x4E>(x); x += dpp<0x141>(x); x += dpp<0x140>(x); x = swap16_sum(x); x = swap32_sum(x); return x; }

constexpr size_t MiB = 1u << 20;
constexpr size_t WS_CTL = 0, CTL_ZERO_BYTES = 4096;
constexpr size_t WS_ROPE = 1 * MiB;
constexpr size_t WS_W1T = 2 * MiB;
constexpr size_t WS_W2T = 36 * MiB;
constexpr size_t WS_XN = 44 * MiB;
constexpr size_t WS_RKV = 110 * MiB;
constexpr size_t WS_GR = 210 * MiB;
constexpr size_t WS_WA = 244 * MiB;
constexpr size_t WS_QD = 250 * MiB, WS_KD = 284 * MiB, WS_VD = 318 * MiB, WS_GD = 352 * MiB;
constexpr size_t WS_Y = 386 * MiB;
constexpr size_t WS_SSQ = 451 * MiB;
constexpr size_t WS_END = 454 * MiB;
constexpr int LDS_BYTES = 147456;
constexpr int LDS_QW = 147440;

struct Args {
    const float* in[21]; float* out; unsigned char* ws; float inv_freq[32]; int ph_lo, ph_hi, coop, pad;
};

constexpr float C2 = 0.125f * 1.4426950408889634f;
struct EpiProj {
    static constexpr bool PERM = true, AFTER_DRAIN = false;
    bf16_t *RKV, *GR, *WA, *QD, *KD, *VD, *GD; const float* rope;
    __device__ __forceinline__ void operator()(const f32x4 (&acc)[2][2][4][2], const pg8::Unit& u, int wr, int wc, int fr, int fq) const {
        const int pn = u.pn; bf16_t* base; int ld, colt, kind = 0;
        if (pn < 12) { base = RKV; ld = 3072; colt = pn * 256; }
        else if (pn < 16) { base = GR; ld = 1024; colt = (pn - 12) * 256; }
        else if (pn < 20) { base = QD; ld = 1024; colt = (pn - 16) * 256; kind = 1; }
        else if (pn < 24) { base = KD; ld = 1024; colt = (pn - 20) * 256; kind = 2; }
        else if (pn < 28) { base = VD; ld = 1024; colt = (pn - 24) * 256; }
        else if (pn < 32) { base = GD; ld = 1024; colt = (pn - 28) * 256; }
        else { base = WA; ld = 128; colt = 0; kind = 3; }
        const bool meta = (u.pm == 64);
        const int pos0 = meta ? 0 : (NMETA + (u.pm & 7) * 256);
        const int brow0 = meta ? 0 : (u.pm >> 3) * LP;
        const int cl = wc * 32 + 8 * fq;
        const int i0 = ((wc & 1) * 16 + 4 * fq);
        const float qs = (kind == 1) ? C2 : 1.f;
#pragma unroll
        for (int ai = 0; ai < 2; ++ai)
#pragma unroll
            for (int m = 0; m < 4; ++m) {
                const int rt = ai * 128 + wr * 64 + m * 16 + fr;
                if (meta && rt >= NMETA) continue;
                const int pos = pos0 + rt;
#pragma unroll
                for (int bj = 0; bj < 2; ++bj) {
                    if (kind == 3 && bj == 1) continue;
                    f32x4 v0 = acc[ai][bj][m][0], v1 = acc[ai][bj][m][1];
                    if (kind == 1 || kind == 2) {
                        const f32x4 cs0 = *(const f32x4*)(rope + ((size_t)pos * 32 + i0) * 2), cs1 = *(const f32x4*)(rope + ((size_t)pos * 32 + i0) * 2 + 4);
                        f32x4 o0, o1;
                        o0[0] = (v0[0] * cs0[0] - v0[1] * cs0[1]) * qs; o0[1] = (v0[1] * cs0[0] + v0[0] * cs0[1]) * qs;
                        o0[2] = (v0[2] * cs0[2] - v0[3] * cs0[3]) * qs; o0[3] = (v0[3] * cs0[2] + v0[2] * cs0[3]) * qs;
                        o1[0] = (v1[0] * cs1[0] - v1[1] * cs1[1]) * qs; o1[1] = (v1[1] * cs1[0] + v1[0] * cs1[1]) * qs;
                        o1[2] = (v1[2] * cs1[2] - v1[3] * cs1[3]) * qs; o1[3] = (v1[3] * cs1[2] + v1[2] * cs1[3]) * qs;
                        v0 = o0; v1 = o1;
                    }
                    u32x4 w; w.x = pk2(v0[0], v0[1]); w.y = pk2(v0[2], v0[3]); w.z = pk2(v1[0], v1[1]); w.w = pk2(v1[2], v1[3]);
                    const int col = colt + bj * 128 + cl;
                    if (!meta) { *(u32x4*)(base + (size_t)(brow0 + pos) * ld + col) = w; }
                    else {
#pragma unroll
                        for (int b = 0; b < NB; ++b) *(u32x4*)(base + (size_t)(b * LP + pos) * ld + col) = w;
                    }
                }
            }
    }
};

struct EpiY {
    static constexpr bool PERM = true, AFTER_DRAIN = false;
    bf16_t* YO; float* SSQ;
    __device__ __forceinline__ void operator()(const f32x4 (&acc)[2][2][4][2], const pg8::Unit& u, int wr, int wc, int fr, int fq) const {
        const int cl = u.pn * 256 + wc * 32 + 8 * fq;
#pragma unroll
        for (int ai = 0; ai < 2; ++ai)
#pragma unroll
            for (int m = 0; m < 4; ++m) {
                const int row = u.pm * 256 + ai * 128 + wr * 64 + m * 16 + fr; float ss = 0.f;
#pragma unroll
                for (int bj = 0; bj < 2; ++bj) {
                    const f32x4 v0 = acc[ai][bj][m][0], v1 = acc[ai][bj][m][1];
                    ss += (v0[0] * v0[0] + v0[1] * v0[1]) + (v0[2] * v0[2] + v0[3] * v0[3]) + (v1[0] * v1[0] + v1[1] * v1[1]) + (v1[2] * v1[2] + v1[3] * v1[3]);
                    u32x4 w; w.x = pk2(v0[0], v0[1]); w.y = pk2(v0[2], v0[3]); w.z = pk2(v1[0], v1[1]); w.w = pk2(v1[2], v1[3]);
                    *(u32x4*)(YO + (size_t)row * DM + cl + bj * 128) = w;
                }
                ss = swap16_sum(ss); ss = swap32_sum(ss);
                if (fq == 0) SSQ[(size_t)row * 32 + u.pn * 4 + wc] = ss;
            }
    }
};

__device__ __forceinline__ int w1_src_col(int n) {
    const int t = n >> 8, ct = n & 255;
    if (t < 12) return n;
    if (t < 16) return 3200 + (n - 3072);
    if (t < 24) { const int base = 4224 + (t - 16) * 256, hc = ct >> 6, p = ct & 63; return base + hc * 64 + (p >> 1) + 32 * (p & 1); }
    if (t < 32) return 6272 + (n - 6144);
    return ct < 128 ? 3072 + ct : -1;
}
template <bool MAP> __device__ __forceinline__ void p0_transpose_item(const float* W, int NS, bf16_t* WT, int nblk, LAS float* scr, int item, int lane) {
    const int kb = item / nblk, nb = item % nblk, k0 = 64 * kb, n0 = 32 * nb;
    const int sc = MAP ? w1_src_col(n0 + (lane & 31)) : (n0 + (lane & 31));
#pragma unroll 8
    for (int i = 0; i < 32; ++i) { const int kk = 2 * i + (lane >> 5); scr[kk * 33 + (lane & 31)] = (sc >= 0) ? W[(size_t)(k0 + kk) * NS + sc] : 0.f; }
    asm volatile("s_waitcnt lgkmcnt(0)" ::: "memory");
    const int c = lane & 7;
#pragma unroll
    for (int j = 0; j < 4; ++j) { const int n = (lane >> 3) + 8 * j; const LAS float* s = scr + (8 * c) * 33 + n;
        u32x4 o; o.x = pk2(s[0 * 33], s[1 * 33]); o.y = pk2(s[2 * 33], s[3 * 33]); o.z = pk2(s[4 * 33], s[5 * 33]); o.w = pk2(s[6 * 33], s[7 * 33]);
        *(u32x4*)(WT + (size_t)(n0 + n) * 2048 + k0 + 8 * c) = o; }
    asm volatile("s_waitcnt lgkmcnt(0)" ::: "memory");
}

namespace rw {
constexpr int TC = 32, PT = 68;
constexpr int ARR = TC * PT;
constexpr int O_R = 0, O_KP = ARR, O_V = 2 * ARR, O_DEC = 3 * ARR, O_KK = 4 * ARR, O_BB = 5 * ARR, O_WD = 6 * ARR, O_AD = 7 * ARR, O_AA = 8 * ARR, O_YC = 9 * ARR, O_BON = 10 * ARR;

struct Raw { u32x2 r0, r1, k0, k1, v0, v1, w0, w1, a0, a1; };

__device__ __forceinline__ void load_raw(Raw& R, const bf16_t* RKV, const bf16_t* WA, int b, int h, int t0, int tid) {
    const int tk = tid >> 4, c4 = (tid & 15) * 4, t = t0 + tk;
    const u32x2 z = {0u, 0u};
    R.r0 = R.r1 = R.k0 = R.k1 = R.v0 = R.v1 = R.w0 = R.w1 = R.a0 = R.a1 = z;
    if (t < LSEQ) {
        const bf16_t* p = RKV + (size_t)(b * LP + t) * 3072 + h * 64 + c4; const bf16_t* q = WA + (size_t)(b * LP + t) * 128 + c4;
        R.r0 = *(const u32x2*)p; R.k0 = *(const u32x2*)(p + 1024); R.v0 = *(const u32x2*)(p + 2048); R.w0 = *(const u32x2*)q; R.a0 = *(const u32x2*)(q + 64);
        if (t > 0) { R.r1 = *(const u32x2*)(p - 3072); R.k1 = *(const u32x2*)(p - 3072 + 1024); R.v1 = *(const u32x2*)(p - 3072 + 2048); R.w1 = *(const u32x2*)(q - 128); R.a1 = *(const u32x2*)(q - 128 + 64); }
    }
}
__device__ __forceinline__ f32x4 lerp4(u32x2 c, u32x2 p, f32x4 mu) {
    f32x4 a = {bflo(c.x), bfhi(c.x), bflo(c.y), bfhi(c.y)}, q = {bflo(p.x), bfhi(p.x), bflo(p.y), bfhi(p.y)};
    return a + (q - a) * mu;
}
__device__ __forceinline__ float tanh_(float x) { return 1.f - 2.f * frcp(fexp(2.f * x) + 1.f); }

__device__ __forceinline__ void chain(const Args& A, int b, int h, unsigned char* ldsb) {
    float* L = (float*)ldsb;
    const int tid = threadIdx.x, lane = tid & 63, wid = __builtin_amdgcn_readfirstlane(tid >> 6);
    const bf16_t* RKV = (const bf16_t*)(A.ws + WS_RKV); const bf16_t* WA = (const bf16_t*)(A.ws + WS_WA); const bf16_t* GR = (const bf16_t*)(A.ws + WS_GR);
    bf16_t* Y = (bf16_t*)(A.ws + WS_Y);
    const float* mu = A.in[4];
    const int tkA = tid >> 4, c4 = (tid & 15) * 4;
    const f32x4 mu_r = *(const f32x4*)(mu + h * 64 + c4), mu_k = *(const f32x4*)(mu + 1024 + h * 64 + c4), mu_v = *(const f32x4*)(mu + 2048 + h * 64 + c4),
                mu_w = *(const f32x4*)(mu + 3072 + c4), mu_a = *(const f32x4*)(mu + 3136 + c4);
    const int r32 = lane & 31, hh = lane >> 5;
    bf16x8 Bf[4]; float bias = 0.f;
    if (wid < 4) {
        const int which = wid >> 1, nb = wid & 1; const float* up = which ? A.in[8] : A.in[6]; const float* b0 = which ? A.in[7] : A.in[5];
        const int col = h * 64 + nb * 32 + r32; bias = b0[col];
#pragma unroll
        for (int ks = 0; ks < 4; ++ks) { unsigned w[4];
#pragma unroll
            for (int j = 0; j < 4; ++j) w[j] = pk2(up[(size_t)(16 * ks + 8 * hh + 2 * j) * 1024 + col], up[(size_t)(16 * ks + 8 * hh + 2 * j + 1) * 1024 + col]);
            Bf[ks] = __builtin_bit_cast(bf16x8, (u32x4){w[0], w[1], w[2], w[3]}); }
    }
    const float kkw = A.in[9][h * 64 + lane], kaw = A.in[10][h * 64 + lane], rkw = A.in[11][h * 64 + lane], gnw = A.in[12][h * 64 + lane], gnb = A.in[13][h * 64 + lane];
    const int sv = tid >> 3, kb = tid & 7;
    float S[8];
#pragma unroll
    for (int i = 0; i < 8; ++i) S[i] = 0.f;
    Raw raw; load_raw(raw, RKV, WA, b, h, 0, tid);
    constexpr int NCH = (LSEQ + TC - 1) / TC;
    for (int c = 0; c < NCH; ++c) {
        const int t0 = c * TC, nt = (LSEQ - t0) < TC ? (LSEQ - t0) : TC;
        { const f32x4 r = lerp4(raw.r0, raw.r1, mu_r), k = lerp4(raw.k0, raw.k1, mu_k), v = lerp4(raw.v0, raw.v1, mu_v), w = lerp4(raw.w0, raw.w1, mu_w), a = lerp4(raw.a0, raw.a1, mu_a);
          *(f32x4*)(L + O_R + tkA * PT + c4) = r; *(f32x4*)(L + O_KP + tkA * PT + c4) = k; *(f32x4*)(L + O_V + tkA * PT + c4) = v;
          *(f32x4*)(L + O_WD + tkA * PT + c4) = (f32x4){tanh_(w[0]), tanh_(w[1]), tanh_(w[2]), tanh_(w[3])}; *(f32x4*)(L + O_AD + tkA * PT + c4) = a; }
        if (c + 1 < NCH) load_raw(raw, RKV, WA, b, h, t0 + TC, tid);
        float gate[4];
#pragma unroll
        for (int i = 0; i < 4; ++i) { const int t = t0 + 4 * wid + i; gate[i] = (t >= NMETA && t < LSEQ) ? __uint_as_float((unsigned)GR[(size_t)(b * LP + t) * 1024 + h * 64 + lane] << 16) : 0.f; }
        __syncthreads();
        if (wid < 4) {
            const int which = wid >> 1, nb = wid & 1; const float* src = L + (which ? O_AD : O_WD) + r32 * PT;
            f32x16 acc;
#pragma unroll
            for (int i = 0; i < 16; ++i) acc[i] = 0.f;
#pragma unroll
            for (int ks = 0; ks < 4; ++ks) { const f32x4 x0 = *(const f32x4*)(src + 16 * ks + 8 * hh), x1 = *(const f32x4*)(src + 16 * ks + 8 * hh + 4);
                const bf16x8 af = __builtin_bit_cast(bf16x8, (u32x4){pk2(x0[0], x0[1]), pk2(x0[2], x0[3]), pk2(x1[0], x1[1]), pk2(x1[2], x1[3])});
                acc = __builtin_amdgcn_mfma_f32_32x32x16_bf16(af, Bf[ks], acc, 0, 0, 0); }
            float* dst = L + (which ? O_AA : O_DEC) + nb * 32 + r32;
#pragma unroll
            for (int r = 0; r < 16; ++r) { const int tok = (r & 3) + 8 * (r >> 2) + 4 * hh; const float sg = sigmoidf_(acc[r] + bias);
                dst[tok * PT] = which ? sg : fexp(-0.6065306597126334f * sg); }
        }
        __syncthreads();
#pragma unroll
        for (int i = 0; i < 4; ++i) { const int tk = 4 * wid + i;
            const float k = L[O_KP + tk * PT + lane], a = L[O_AA + tk * PT + lane], r = L[O_R + tk * PT + lane];
            float kk = k * kkw; const float ss = wave_sum(kk * kk); kk = kk / fmaxf(sqrtf(ss), 1e-12f);
            const float kp = k * (1.f + (a - 1.f) * kaw); const float bon = wave_sum(r * kp * rkw);
            L[O_KK + tk * PT + lane] = kk; L[O_KP + tk * PT + lane] = kp; L[O_BB + tk * PT + lane] = kk * a; if (lane == 0) L[O_BON + tk] = bon; }
        __syncthreads();
        for (int tk = 0; tk < nt; ++tk) {
            const float* base = L + tk * PT + 8 * kb;
            const f32x4 kk0 = *(const f32x4*)(base + O_KK), kk1 = *(const f32x4*)(base + O_KK + 4), de0 = *(const f32x4*)(base + O_DEC), de1 = *(const f32x4*)(base + O_DEC + 4),
                        bb0 = *(const f32x4*)(base + O_BB), bb1 = *(const f32x4*)(base + O_BB + 4), kp0 = *(const f32x4*)(base + O_KP), kp1 = *(const f32x4*)(base + O_KP + 4),
                        rr0 = *(const f32x4*)(base + O_R), rr1 = *(const f32x4*)(base + O_R + 4);
            const float vv = L[O_V + tk * PT + sv];
            float sa = (S[0] * kk0[0] + S[1] * kk0[1]) + (S[2] * kk0[2] + S[3] * kk0[3]) + (S[4] * kk1[0] + S[5] * kk1[1]) + (S[6] * kk1[2] + S[7] * kk1[3]);
            sa = -sum8(sa);
            S[0] = S[0] * de0[0] + sa * bb0[0] + vv * kp0[0]; S[1] = S[1] * de0[1] + sa * bb0[1] + vv * kp0[1]; S[2] = S[2] * de0[2] + sa * bb0[2] + vv * kp0[2]; S[3] = S[3] * de0[3] + sa * bb0[3] + vv * kp0[3];
            S[4] = S[4] * de1[0] + sa * bb1[0] + vv * kp1[0]; S[5] = S[5] * de1[1] + sa * bb1[1] + vv * kp1[1]; S[6] = S[6] * de1[2] + sa * bb1[2] + vv * kp1[2]; S[7] = S[7] * de1[3] + sa * bb1[3] + vv * kp1[3];
            float y = (S[0] * rr0[0] + S[1] * rr0[1]) + (S[2] * rr0[2] + S[3] * rr0[3]) + (S[4] * rr1[0] + S[5] * rr1[1]) + (S[6] * rr1[2] + S[7] * rr1[3]);
            y = sum8(y);
            if (kb == 0) L[O_YC + tk * PT + sv] = y;
        }
        __syncthreads();
#pragma unroll
        for (int i = 0; i < 4; ++i) { const int tk = 4 * wid + i, t = t0 + tk;
            if (t >= NMETA && t < LSEQ) {
                const float y = L[O_YC + tk * PT + lane]; const float mean = wave_sum(y) * (1.f / 64.f); const float d = y - mean; const float var = wave_sum(d * d) * (1.f / 64.f);
                float o = d * __builtin_amdgcn_rsqf(var + 64e-5f) * gnw + gnb; o += L[O_BON + tk] * L[O_V + tk * PT + lane];
                const float g = gate[i]; o *= g * sigmoidf_(g);
                Y[(size_t)(b * TS + t - NMETA) * DM + h * 64 + lane] = (bf16_t)(pk2(o, 0.f) & 0xffffu); } }
        __syncthreads();
    }
}
}

namespace att {
constexpr float THR = 8.f;
constexpr int O_K = 0, O_V = 32768, O_WSF = 69632, XP = 132;
__device__ __forceinline__ unsigned off_b(unsigned row, unsigned ch) { return 256u * row + 16u * (ch ^ (((row & 3u) << 2) | ((row >> 2) & 3u))); }

__device__ __forceinline__ void unit(const Args& A, int b, int h, int qb, float lam, unsigned char* ldsb) {
    const int tid = threadIdx.x, lane = tid & 63, wid = __builtin_amdgcn_readfirstlane(tid >> 6), r32 = lane & 31, hh = lane >> 5, qblk = wid >> 1, comp = wid & 1;
    const bf16_t* QD = (const bf16_t*)(A.ws + WS_QD); const bf16_t* KD = (const bf16_t*)(A.ws + WS_KD); const bf16_t* VD = (const bf16_t*)(A.ws + WS_VD); const bf16_t* GD = (const bf16_t*)(A.ws + WS_GD);
    bf16_t* Y = (bf16_t*)(A.ws + WS_Y);
    LAS unsigned char* lds3 = (LAS unsigned char*)ldsb;
    const int qpos0 = NMETA + 128 * qb + 32 * qblk, qpos = qpos0 + r32;
    const int NT = 2 * qb + 3, wlast = (qpos0 + 31) >> 6;
    bf16x8 qf[4];
    { const bf16_t* qp = QD + (size_t)(b * LP + qpos) * 1024 + h * 128 + comp * 64 + 8 * hh;
#pragma unroll
      for (int d0 = 0; d0 < 4; ++d0) qf[d0] = *(const bf16x8*)(qp + 16 * d0); }
    const int srow = tid >> 4, sch = tid & 15;
    const unsigned sdst0 = off_b(srow, sch), sdst1 = off_b(srow + 32, sch);
    const bf16_t* kg = KD + (size_t)(b * LP + srow) * 1024 + h * 128 + sch * 8; const bf16_t* vg = VD + (size_t)(b * LP + srow) * 1024 + h * 128 + sch * 8;
    u32x4 kr0, kr1, vr0, vr1;
#define ATT_LOAD(tl) do { const size_t o_ = (size_t)(tl) * 64 * 1024; kr0 = *(const u32x4*)(kg + o_); kr1 = *(const u32x4*)(kg + o_ + 32 * 1024); vr0 = *(const u32x4*)(vg + o_); vr1 = *(const u32x4*)(vg + o_ + 32 * 1024); } while (0)
#define ATT_STORE(buf) do { *(LAS u32x4*)(lds3 + O_K + (buf) * 16384 + sdst0) = kr0; *(LAS u32x4*)(lds3 + O_K + (buf) * 16384 + sdst1) = kr1; \
                            *(LAS u32x4*)(lds3 + O_V + (buf) * 16384 + sdst0) = vr0; *(LAS u32x4*)(lds3 + O_V + (buf) * 16384 + sdst1) = vr1; } while (0)
    const unsigned sw = ((r32 & 3) << 2) | ((r32 >> 2) & 3);
    const unsigned kx = (unsigned)(comp * 8 + hh) ^ sw;
    const unsigned kbase = 256u * r32;
    const unsigned q4 = (lane & 15) >> 2, p4 = lane & 3, blk = (lane >> 4) & 1, cb = 2 * blk + (p4 >> 1);
    float m = -INFINITY, lsum = 0.f;
    f32x16 O[4];
#pragma unroll
    for (int d = 0; d < 4; ++d)
#pragma unroll
        for (int i = 0; i < 16; ++i) O[d][i] = 0.f;
    LAS float* wsf = (LAS float*)(lds3 + O_WSF) + wid * 64;

    ATT_LOAD(0); ATT_STORE(0);
    __syncthreads();
    for (int tl = 0; tl < NT; ++tl) {
        const int cur = tl & 1;
        if (tl + 1 < NT) ATT_LOAD(tl + 1);
        if (tl <= wlast) {
            LAS unsigned char* Kb = lds3 + O_K + cur * 16384; LAS unsigned char* Vb = lds3 + O_V + cur * 16384;
            f32x16 p0, p1;
#pragma unroll
            for (int i = 0; i < 16; ++i) { p0[i] = 0.f; p1[i] = 0.f; }
#pragma unroll
            for (int d0 = 0; d0 < 4; ++d0) {
                const bf16x8 a0 = *(const LAS bf16x8*)(Kb + kbase + 16u * (kx ^ (2u * d0)));
                const bf16x8 a1 = *(const LAS bf16x8*)(Kb + 8192 + kbase + 16u * (kx ^ (2u * d0)));
                p0 = __builtin_amdgcn_mfma_f32_32x32x16_bf16(a0, qf[d0], p0, 0, 0, 0);
                p1 = __builtin_amdgcn_mfma_f32_32x32x16_bf16(a1, qf[d0], p1, 0, 0, 0);
            }
            if (64 * tl + 63 > qpos0) {
#pragma unroll
                for (int r = 0; r < 16; ++r) { const int kp = 64 * tl + (r & 3) + 8 * (r >> 2) + 4 * hh; if (kp > qpos) p0[r] = -INFINITY; if (kp + 32 > qpos) p1[r] = -INFINITY; }
            }
            float rm = fmaxf(p0[0], p1[0]);
#pragma unroll
            for (int r = 1; r < 16; ++r) rm = fmaxf(rm, fmaxf(p0[r], p1[r]));
            rm = swap32_max(rm);
            if (__any(rm > m + THR)) {
                const float mn = fmaxf(m, rm), alpha = __builtin_amdgcn_exp2f(m - mn);
                lsum *= alpha; m = mn;
                if (hh == 0) wsf[r32] = alpha;
                asm volatile("s_waitcnt lgkmcnt(0)" ::: "memory");
#pragma unroll
                for (int g = 0; g < 4; ++g) { const f32x4 a4 = *(const LAS f32x4*)(wsf + 8 * g + 4 * hh);
#pragma unroll
                    for (int d = 0; d < 4; ++d) { O[d][4 * g] *= a4[0]; O[d][4 * g + 1] *= a4[1]; O[d][4 * g + 2] *= a4[2]; O[d][4 * g + 3] *= a4[3]; } }
            }
            float ps = 0.f;
#pragma unroll
            for (int r = 0; r < 16; ++r) { p0[r] = __builtin_amdgcn_exp2f(p0[r] - m); p1[r] = __builtin_amdgcn_exp2f(p1[r] - m); ps += p0[r] + p1[r]; }
            lsum += ps;
            bf16x8 pw[4];
            pw[0] = __builtin_bit_cast(bf16x8, (u32x4){pk2(p0[0], p0[1]), pk2(p0[2], p0[3]), pk2(p0[4], p0[5]), pk2(p0[6], p0[7])});
            pw[1] = __builtin_bit_cast(bf16x8, (u32x4){pk2(p0[8], p0[9]), pk2(p0[10], p0[11]), pk2(p0[12], p0[13]), pk2(p0[14], p0[15])});
            pw[2] = __builtin_bit_cast(bf16x8, (u32x4){pk2(p1[0], p1[1]), pk2(p1[2], p1[3]), pk2(p1[4], p1[5]), pk2(p1[6], p1[7])});
            pw[3] = __builtin_bit_cast(bf16x8, (u32x4){pk2(p1[8], p1[9]), pk2(p1[10], p1[11]), pk2(p1[12], p1[13]), pk2(p1[14], p1[15])});
#pragma unroll
            for (int s = 0; s < 4; ++s)
#pragma unroll
                for (int d = 0; d < 4; ++d) {
                    const unsigned a_lo = 256u * (16 * s + 4 * hh + q4) + 16u * ((((unsigned)d ^ q4) << 2) | (cb ^ (unsigned)hh)) + 8u * (p4 & 1);
                    const unsigned a_hi = 256u * (16 * s + 8 + 4 * hh + q4) + 16u * ((((unsigned)d ^ q4) << 2) | (cb ^ (2u + (unsigned)hh))) + 8u * (p4 & 1);
                    const s16x4 lo = __builtin_amdgcn_ds_read_tr16_b64_v4i16((LAS s16x4*)(Vb + a_lo));
                    const s16x4 hi = __builtin_amdgcn_ds_read_tr16_b64_v4i16((LAS s16x4*)(Vb + a_hi));
                    const bf16x8 vf = {lo[0], lo[1], lo[2], lo[3], hi[0], hi[1], hi[2], hi[3]};
                    O[d] = __builtin_amdgcn_mfma_f32_32x32x16_bf16(pw[s], vf, O[d], 0, 0, 0);
                }
        }
        if (tl + 1 < NT) ATT_STORE(cur ^ 1);
        __syncthreads();
    }
#undef ATT_LOAD
#undef ATT_STORE
    const float lt = swap32_sum(lsum);
    const float sc = (comp ? lam : 1.f) / lt;
    if (hh == 0) wsf[r32] = sc;
    asm volatile("s_waitcnt lgkmcnt(0)" ::: "memory");
    LAS float* X = (LAS float*)lds3 + qblk * (32 * XP);
    if (comp == 1) {
#pragma unroll
        for (int g = 0; g < 4; ++g) { const f32x4 s4 = *(const LAS f32x4*)(wsf + 8 * g + 4 * hh);
#pragma unroll
            for (int i = 0; i < 4; ++i)
#pragma unroll
                for (int d = 0; d < 4; ++d) X[(8 * g + 4 * hh + i) * XP + 32 * d + r32] = O[d][4 * g + i] * s4[i]; }
    }
    __syncthreads();
    if (comp == 0) {
#pragma unroll
        for (int g = 0; g < 4; ++g) { const f32x4 s4 = *(const LAS f32x4*)(wsf + 8 * g + 4 * hh);
#pragma unroll
            for (int i = 0; i < 4; ++i)
#pragma unroll
                for (int d = 0; d < 4; ++d) { LAS float* xp = X + (8 * g + 4 * hh + i) * XP + 32 * d + r32; *xp = O[d][4 * g + i] * s4[i] - *xp; } }
        asm volatile("s_waitcnt lgkmcnt(0)" ::: "memory");
        const LAS float* xr = X + r32 * XP + 64 * hh;
        f32x4 dv[16]; float ss = 0.f;
#pragma unroll
        for (int i = 0; i < 16; ++i) { dv[i] = *(const LAS f32x4*)(xr + 4 * i); ss += (dv[i][0] * dv[i][0] + dv[i][1] * dv[i][1]) + (dv[i][2] * dv[i][2] + dv[i][3] * dv[i][3]); }
        ss = swap32_sum(ss);
        const float rms = __builtin_amdgcn_rsqf(ss * (1.f / 128.f) + 1e-5f) * 0.8f;
        const bf16_t* gp = GD + (size_t)(b * LP + qpos) * 1024 + h * 128 + 64 * hh; const float* sw_ = A.in[18] + 64 * hh;
        bf16_t* yp = Y + (size_t)(b * TS + qpos - NMETA) * DM + 1024 + h * 128 + 64 * hh;
#pragma unroll
        for (int c8 = 0; c8 < 8; ++c8) {
            const u32x4 gv = *(const u32x4*)(gp + 8 * c8); const f32x4 w0 = *(const f32x4*)(sw_ + 8 * c8), w1 = *(const f32x4*)(sw_ + 8 * c8 + 4);
            const float g0 = bflo(gv.x), g1 = bfhi(gv.x), g2 = bflo(gv.y), g3 = bfhi(gv.y), g4 = bflo(gv.z), g5 = bfhi(gv.z), g6 = bflo(gv.w), g7 = bfhi(gv.w);
            const f32x4 d0 = dv[2 * c8], d1 = dv[2 * c8 + 1];
            u32x4 o;
            o.x = pk2(d0[0] * rms * w0[0] * g0 * sigmoidf_(g0), d0[1] * rms * w0[1] * g1 * sigmoidf_(g1));
            o.y = pk2(d0[2] * rms * w0[2] * g2 * sigmoidf_(g2), d0[3] * rms * w0[3] * g3 * sigmoidf_(g3));
            o.z = pk2(d1[0] * rms * w1[0] * g4 * sigmoidf_(g4), d1[1] * rms * w1[1] * g5 * sigmoidf_(g5));
            o.w = pk2(d1[2] * rms * w1[2] * g6 * sigmoidf_(g6), d1[3] * rms * w1[3] * g7 * sigmoidf_(g7));
            *(u32x4*)(yp + 8 * c8) = o;
        }
    }
    __syncthreads();
}
}

__global__ void __launch_bounds__(512, 2) hymba_fwd(Args A) {
    extern __shared__ __attribute__((aligned(16))) unsigned char lds[];
    const int tid = threadIdx.x, lane = tid & 63, wave = __builtin_amdgcn_readfirstlane(tid >> 6);
    const int G = gridDim.x, bx = blockIdx.x;
    const int lo = A.ph_lo, hi = A.ph_hi;
    unsigned char* ws = A.ws;
    bf16_t* W1T = (bf16_t*)(ws + WS_W1T); bf16_t* W2T = (bf16_t*)(ws + WS_W2T); bf16_t* XN = (bf16_t*)(ws + WS_XN);
    float* ROPE = (float*)(ws + WS_ROPE); float* SSQ = (float*)(ws + WS_SSQ);
#define IN_PH(k) (lo <= (k) && (k) < hi)
#define GRID_SYNC(k) do { if (A.coop && IN_PH(k) && IN_PH((k) + 1)) { cg::this_grid().sync(); } } while (0)

    if (IN_PH(0)) {
        const int gw = bx * 8 + wave, NGW = G * 8;
        LAS float* scr = (LAS float*)((LAS unsigned char*)lds + wave * 16384);
        constexpr int I_1 = 32 * (N1 / 32), I_2 = 32 * (2048 / 32);
        for (int it = gw; it < I_1 + I_2; it += NGW) {
            if (it < I_1) p0_transpose_item<true>(A.in[3], NIN, W1T, N1 / 32, scr, it, lane);
            else p0_transpose_item<false>(A.in[19], 2048, W2T, 2048 / 32, scr, it - I_1, lane);
        }
        { const f32x4* wv = (const f32x4*)A.in[2] + lane; f32x4 pw[8];
#pragma unroll
          for (int j = 0; j < 8; ++j) pw[j] = wv[64 * j];
          for (int mrow = gw; mrow < MP; mrow += NGW) {
              unsigned long long* o8 = (unsigned long long*)(XN + (size_t)mrow * DM) + lane;
              if (mrow >= MR + NMETA) {
#pragma unroll
                  for (int j = 0; j < 8; ++j) o8[64 * j] = 0ull;
                  continue; }
              const float* src = (mrow < MR) ? A.in[0] + (size_t)mrow * DM : A.in[1] + (size_t)(mrow - MR) * DM;
              const f32x4* xr = (const f32x4*)src + lane; f32x4 v[8]; float s = 0.f;
#pragma unroll
              for (int j = 0; j < 8; ++j) { v[j] = xr[64 * j]; s += (v[j][0] * v[j][0] + v[j][1] * v[j][1]) + (v[j][2] * v[j][2] + v[j][3] * v[j][3]); }
              const float rstd = __builtin_amdgcn_rsqf(wave_sum(s) * (1.f / DM) + 1e-6f);
#pragma unroll
              for (int j = 0; j < 8; ++j) { const f32x4 y = v[j] * rstd * pw[j]; o8[64 * j] = (unsigned long long)pk2(y[0], y[1]) | ((unsigned long long)pk2(y[2], y[3]) << 32); }
          } }
        for (int e = bx * 512 + tid; e < LSEQ * 32; e += G * 512) {
            const int pos = e >> 5, i = e & 31; const double rev = (double)pos * (double)A.inv_freq[i] * 0.15915494309189535; const float f = (float)(rev - floor(rev));
            ROPE[2 * e] = __builtin_amdgcn_cosf(f); ROPE[2 * e + 1] = __builtin_amdgcn_sinf(f); }
        { bf16_t* KD = (bf16_t*)(ws + WS_KD); bf16_t* VD = (bf16_t*)(ws + WS_VD); constexpr int PADC = (LP - LSEQ) * 1024 / 8;
          for (int e = bx * 512 + tid; e < NB * PADC * 2; e += G * 512) { const int which = e / (NB * PADC), r = e % (NB * PADC), b = r / PADC, c = r % PADC;
              *(u32x4*)((which ? VD : KD) + (size_t)(b * LP + LSEQ) * 1024 + (size_t)c * 8) = (u32x4){0u, 0u, 0u, 0u}; } }
    }
    GRID_SYNC(0);

    if (IN_PH(1)) {
        pg8::Gemm g{XN, W1T, MP, N1, DM}; pg8::StaticOrder S; S.init(MP, N1, G, bx);
        EpiProj E{(bf16_t*)(ws + WS_RKV), (bf16_t*)(ws + WS_GR), (bf16_t*)(ws + WS_WA), (bf16_t*)(ws + WS_QD), (bf16_t*)(ws + WS_KD), (bf16_t*)(ws + WS_VD), (bf16_t*)(ws + WS_GD), ROPE};
        pg8::gemm_phase<EpiProj, pg8::StaticOrder, true, true>((PG8_LAS unsigned char*)lds, g, S, E);
    }
    GRID_SYNC(1);

    if (IN_PH(2)) {
        float lam;
        { const float a = (lane < 64) ? A.in[14][lane] * A.in[15][lane] : 0.f, c = A.in[16][lane] * A.in[17][lane];
          lam = fexp(wave_sum(a)) - fexp(wave_sum(c)) + 0.2f; }
        unsigned* qctr = (unsigned*)(ws + WS_CTL);
        volatile LAS int* qw = (volatile LAS int*)((LAS unsigned char*)lds + LDS_QW);
        constexpr int NITEMS = 128 + 1024;
#define Q_FETCH(dst) do { __syncthreads(); if (tid == 0) *qw = (int)atomicAdd(qctr, 1u); __syncthreads(); dst = *qw; } while (0)
        int item; Q_FETCH(item);
        while (item < 128) { rw::chain(A, item >> 4, item & 15, lds); Q_FETCH(item); }
        while (item < NITEMS) { const int a = item - 128, qb = 15 - (a >> 6), bh = a & 63; att::unit(A, bh >> 3, bh & 7, qb, lam, lds); Q_FETCH(item); }
#undef Q_FETCH
    }
    GRID_SYNC(2);

    if (IN_PH(3)) {
        pg8::Gemm g{(const bf16_t*)(ws + WS_Y), W2T, MR, DM, DM}; pg8::StaticOrder S; S.init(MR, DM, G, bx);
        EpiY E{XN  , SSQ};
        pg8::gemm_phase<EpiY, pg8::StaticOrder, true, true>((PG8_LAS unsigned char*)lds, g, S, E);
    }
    GRID_SYNC(3);

    if (IN_PH(4)) {
        const int gw = bx * 8 + wave, NGW = G * 8;
        const f32x4* wv = (const f32x4*)A.in[20] + lane; f32x4 pw[8];
#pragma unroll
        for (int j = 0; j < 8; ++j) pw[j] = wv[64 * j];
        const bf16_t* YO = XN;
        for (int row = gw; row < MR; row += NGW) {
            const float part = (lane < 32) ? SSQ[(size_t)row * 32 + lane] : 0.f;
            const float rstd = __builtin_amdgcn_rsqf(wave_sum(part) * (1.f / DM) + 1e-6f);
            const f32x4* xr = (const f32x4*)(A.in[0] + (size_t)row * DM) + lane; const u32x2* yr = (const u32x2*)(YO + (size_t)row * DM) + lane;
            f32x4* orow = (f32x4*)(A.out + (size_t)row * DM) + lane;
#pragma unroll
            for (int j = 0; j < 8; ++j) { const f32x4 x = xr[64 * j]; const u32x2 yv = yr[64 * j];
                const f32x4 y = {bflo(yv.x), bfhi(yv.x), bflo(yv.y), bfhi(yv.y)};
                orow[64 * j] = x + y * rstd * pw[j]; }
        }
    }
#undef IN_PH
#undef GRID_SYNC
}

extern "C" void kernel_launch(void* const* d_in, const int* in_sizes, int n_in, void* d_out, int out_size, void* d_ws, size_t ws_size, hipStream_t stream) {
    static int grid = 0;
    if (grid == 0) {
        if (n_in != 21 || in_sizes[0] != MR * DM || out_size != MR * DM || ws_size < WS_END) { fprintf(stderr, "kernel_launch: unexpected shapes (n_in %d, in0 %d, out %d, ws %zu); nothing launched\n", n_in, n_in > 0 ? in_sizes[0] : -1, out_size, ws_size); grid = -1; return; }
        int dev = 0, cus = 0, per_cu = 0;
        if (hipGetDevice(&dev) != hipSuccess || hipDeviceGetAttribute(&cus, hipDeviceAttributeMultiprocessorCount, dev) != hipSuccess) { grid = -1; return; }
        if (hipFuncSetAttribute((const void*)hymba_fwd, hipFuncAttributeMaxDynamicSharedMemorySize, LDS_BYTES) != hipSuccess) { fprintf(stderr, "kernel_launch: hipFuncSetAttribute failed\n"); grid = -1; return; }
        if (hipOccupancyMaxActiveBlocksPerMultiprocessor(&per_cu, (const void*)hymba_fwd, 512, LDS_BYTES) != hipSuccess || per_cu < 1) { fprintf(stderr, "kernel_launch: occupancy query reports %d\n", per_cu); per_cu = 1; }
        (void)hipGetLastError();
        grid = cus;
    }
    if (grid < 0) return;
    (void)hipMemsetAsync((char*)d_ws + WS_CTL, 0, CTL_ZERO_BYTES, stream);
    Args a{};
    for (int i = 0; i < 21; ++i) a.in[i] = (const float*)d_in[i];
    a.out = (float*)d_out; a.ws = (unsigned char*)d_ws;
    for (int i = 0; i < 32; ++i) a.inv_freq[i] = (float)pow(10000.0, -(double)(2 * i) / 64.0);
#if MK_N_LAUNCHES == 1
    a.ph_lo = 0; a.ph_hi = NPH; a.coop = 1;
    void* kargs[] = {&a};
    hipError_t e = hipLaunchCooperativeKernel((const void*)hymba_fwd, dim3(grid), dim3(512), kargs, LDS_BYTES, stream);
    if (e != hipSuccess) fprintf(stderr, "cooperative launch failed: %s (grid %d)\n", hipGetErrorString(e), grid);
#else
    for (int p = 0; p < NPH; ++p) { a.ph_lo = p; a.ph_hi = p + 1; a.coop = 0; hipLaunchKernelGGL(hymba_fwd, dim3(grid), dim3(512), LDS_BYTES, stream, a); }
#endif
}
```

```cpp
#include <hip/hip_runtime.h>
#include <hip/hip_cooperative_groups.h>
#include <cstdio>
#include <cstdint>
#include <cmath>
namespace cg = cooperative_groups;

#ifndef REP_PH
#define REP_PH -1
#endif
#ifndef MK_N_LAUNCHES
#define MK_N_LAUNCHES 1
#endif

constexpr int NB = 8, TS = 2048, NMETA = 16, LSEQ = TS + NMETA, LP = 2112, DM = 2048;
constexpr int MR = NB * TS;
constexpr int MP = 16640;
constexpr int N1 = 8448;
constexpr int NIN = 8320;
constexpr int NPH = 7;

namespace pg8 {
#define PG8_LAS __attribute__((address_space(3)))
typedef unsigned short bf16_t;
typedef short bf16x8 __attribute__((ext_vector_type(8)));
typedef float f32x4 __attribute__((ext_vector_type(4)));
typedef unsigned u32x4 __attribute__((ext_vector_type(4)));
constexpr int BM = 256, BK = 64, HALF = 128, HTB = HALF * BK * 2, STAGE_BYTES = 8 * HTB, NXCD = 8, WGM = 8;

__host__ __device__ __forceinline__ int lds_byte(int r, int c) { const int st = (r >> 4) * 2 + (c >> 5), rr = r & 15, cc = c & 31, ob = rr * 64 + cc * 2; return st * 1024 + (ob ^ (((ob >> 9) & 1) << 5)); }
__host__ __device__ __forceinline__ void stage_rc(int b, int& R, int& C) { const int st = b / 1024, sb = b % 1024, swz = sb ^ (((sb >> 9) & 1) << 5); R = (st >> 1) * 16 + swz / 64; C = (st & 1) * 32 + (swz % 64) / 2; }
__host__ __device__ __forceinline__ int perm32(int rho) { const int n = rho >> 4, i = rho & 15; return 8 * (i >> 2) + 4 * n + (i & 3); }

struct Unit { int pm, pn; };
struct Gemm { const bf16_t* A; const bf16_t* Bt; int M, N, K; };

struct StaticOrder {
    int nM, nN, nwg, G, c;
    __host__ __device__ void init(int M, int N, int G_, int c_) { nM = M / BM; nN = N / BM; nwg = nM * nN; G = G_; c = c_; }
    __host__ __device__ bool next(int i, Unit& u) const {
        const long L = (long)i * G + c; if (L >= nwg) return false;
        int wgid = (int)L; { const int q = nwg / NXCD, r = nwg % NXCD, xcd = wgid % NXCD, off = wgid / NXCD; wgid = (xcd < r ? xcd * (q + 1) : r * (q + 1) + (xcd - r) * q) + off; }
        const int nig = WGM * nN, gid = wgid / nig, fm = gid * WGM, gsz = (nM - fm) < WGM ? (nM - fm) : WGM;
        u.pm = fm + ((wgid % nig) % gsz); u.pn = (wgid % nig) / gsz; return true;
    }
    __device__ __forceinline__ void a_ready(const Unit&) const {}
    __device__ __forceinline__ void done(const Unit&) const {}
};

__device__ __forceinline__ unsigned cvt_pk_bf16(float lo, float hi) { unsigned r; asm volatile("v_cvt_pk_bf16_f32 %0, %1, %2" : "=v"(r) : "v"(lo), "v"(hi)); return r; }

template <class Epi, class Sched, bool ALIGN_EPI = false, bool SP2 = false>
__device__ __forceinline__ void gemm_phase(PG8_LAS unsigned char* lds, const Gemm g, const Sched& S, const Epi& E) {
    const int tid = threadIdx.x, wid = __builtin_amdgcn_readfirstlane(tid >> 6), lane = tid & 63, wr = wid >> 2, wc = wid & 3, fr = lane & 15, fq = lane >> 4;
    const int K = g.K, nt = K / BK;
    unsigned voffA[2], voffB[2];
#pragma unroll
    for (int i = 0; i < 2; ++i) { int R, C; stage_rc(tid * 16 + i * 8192, R, C); const int Rb = Epi::PERM ? ((R & ~31) + perm32(R & 31)) : R;
        voffA[i] = (unsigned)(R * K + C) * 2u; voffB[i] = (unsigned)(Rb * K + C) * 2u; }
    const size_t kstep = (size_t)(BK * 2);
    const size_t hstep = (size_t)HALF * K * 2;
    const size_t tstep = 2 * hstep;
    const unsigned ldsw = (unsigned)wid * 1024u;
    const int aoff = lds_byte(wr * 64 + fr, fq * 8), boff = lds_byte(wc * 32 + fr, fq * 8);
#define PG8_SA(b, h) (((b) * 2 + (h)) * HTB)
#define PG8_SB(b, h) ((4 + (b) * 2 + (h)) * HTB)
#define PG8_STAGE(bufoff, gbase, voff) do { _Pragma("unroll") for (int _i = 0; _i < 2; ++_i) \
        __builtin_amdgcn_global_load_lds((const unsigned*)((const char*)(gbase) + (voff)[_i]), (PG8_LAS unsigned*)(lds + (bufoff) + ldsw + _i * 8192), 16, 0, 0); } while (0)
#define PG8_LDA(dst, b, h) do { _Pragma("unroll") for (int m = 0; m < 4; ++m) _Pragma("unroll") for (int k = 0; k < 2; ++k) dst[m][k] = *(const PG8_LAS bf16x8*)(lds + PG8_SA(b, h) + aoff + m * 2048 + k * 1024); } while (0)
#define PG8_LDB(dst, b, h) do { _Pragma("unroll") for (int n = 0; n < 2; ++n) _Pragma("unroll") for (int k = 0; k < 2; ++k) dst[n][k] = *(const PG8_LAS bf16x8*)(lds + PG8_SB(b, h) + boff + n * 2048 + k * 1024); } while (0)
#define PG8_MMA(ai, bj, At, Bt) do { __builtin_amdgcn_s_setprio(1); _Pragma("unroll") for (int m = 0; m < 4; ++m) _Pragma("unroll") for (int n = 0; n < 2; ++n) _Pragma("unroll") for (int k = 0; k < 2; ++k) \
        acc[ai][bj][m][n] = __builtin_amdgcn_mfma_f32_16x16x32_bf16(Bt[n][k], At[m][k], acc[ai][bj][m][n], 0, 0, 0); __builtin_amdgcn_s_setprio(0); } while (0)
#define PG8_WAIT_V(n) asm volatile("s_waitcnt vmcnt(" #n ")" ::: "memory")
#define PG8_WAIT_L(n) asm volatile("s_waitcnt lgkmcnt(" #n ")" ::: "memory")
#define PG8_BAR __builtin_amdgcn_s_barrier()
#define PG8_SCHED __builtin_amdgcn_sched_barrier(0)
    Unit cur, nxt; int ui = 0;
    if (!S.next(0, cur)) return;
    f32x4 acc[2][2][4][2];
#pragma unroll
    for (int a = 0; a < 2; ++a)
#pragma unroll
        for (int b = 0; b < 2; ++b)
#pragma unroll
            for (int m = 0; m < 4; ++m)
#pragma unroll
                for (int n = 0; n < 2; ++n) acc[a][b][m][n] = (f32x4){0.f, 0.f, 0.f, 0.f};
    bf16x8 At[4][2], B0[2][2], B1[2][2];
    const char* cA = (const char*)g.A + (size_t)cur.pm * tstep; const char* cB = (const char*)g.Bt + (size_t)cur.pn * tstep;
    S.a_ready(cur);
    if constexpr (SP2) {
        PG8_STAGE(PG8_SB(0, 0), cB, voffB); PG8_STAGE(PG8_SB(0, 1), cB + hstep, voffB); PG8_STAGE(PG8_SA(0, 0), cA, voffA); PG8_STAGE(PG8_SA(0, 1), cA + hstep, voffA);
        if (wr == 1) PG8_BAR;
        PG8_WAIT_V(2); PG8_BAR;
        PG8_STAGE(PG8_SB(1, 0), cB + kstep, voffB); PG8_STAGE(PG8_SA(1, 0), cA + kstep, voffA); PG8_STAGE(PG8_SB(1, 1), cB + hstep + kstep, voffB);
        PG8_WAIT_V(6); PG8_BAR;
    } else {
        PG8_STAGE(PG8_SB(0, 0), cB, voffB); PG8_STAGE(PG8_SA(0, 0), cA, voffA); PG8_STAGE(PG8_SB(0, 1), cB + hstep, voffB); PG8_STAGE(PG8_SA(0, 1), cA + hstep, voffA);
        if (wr == 1) PG8_BAR;
        PG8_WAIT_V(4); PG8_BAR;
        PG8_STAGE(PG8_SB(1, 0), cB + kstep, voffB); PG8_STAGE(PG8_SA(1, 0), cA + kstep, voffA); PG8_STAGE(PG8_SB(1, 1), cB + hstep + kstep, voffB);
        PG8_WAIT_V(6); PG8_BAR;
    }
    for (;;) {
        const bool has_next = S.next(ui + 1, nxt);
        const char* nA = has_next ? (const char*)g.A + (size_t)nxt.pm * tstep : cA; const char* nB = has_next ? (const char*)g.Bt + (size_t)nxt.pn * tstep : cB;
        for (int t = 0; t < nt; t += 2) {
            const bool last = (t == nt - 2);
            const char* a1 = cA + (size_t)(t + 1) * kstep;
            const char* a2 = last ? nA : cA + (size_t)(t + 2) * kstep; const char* b2 = last ? nB : cB + (size_t)(t + 2) * kstep;
            const char* a3 = a2 + kstep; const char* b3 = b2 + kstep;
            if (last && has_next) S.a_ready(nxt);
            if constexpr (SP2) {
            PG8_LDB(B0, 0, 0); PG8_LDB(B1, 0, 1); PG8_SCHED; PG8_LDA(At, 0, 0); PG8_STAGE(PG8_SA(1, 1), a1 + hstep, voffA);
            PG8_WAIT_V(8); PG8_WAIT_L(0); PG8_BAR; PG8_MMA(0, 0, At, B0); PG8_MMA(0, 1, At, B1); PG8_BAR; PG8_SCHED;
            PG8_LDA(At, 0, 1); PG8_STAGE(PG8_SB(0, 0), b2, voffB); PG8_STAGE(PG8_SB(0, 1), b2 + hstep, voffB); PG8_STAGE(PG8_SA(0, 0), a2, voffA);
            PG8_WAIT_V(8); PG8_WAIT_L(0); PG8_BAR; PG8_MMA(1, 0, At, B0); PG8_MMA(1, 1, At, B1); PG8_BAR; PG8_SCHED;
            PG8_LDB(B0, 1, 0); PG8_LDB(B1, 1, 1); PG8_SCHED; PG8_LDA(At, 1, 0); PG8_STAGE(PG8_SA(0, 1), a2 + hstep, voffA);
            PG8_WAIT_V(8); PG8_WAIT_L(0); PG8_BAR; PG8_MMA(0, 0, At, B0); PG8_MMA(0, 1, At, B1); PG8_BAR; PG8_SCHED;
            PG8_LDA(At, 1, 1); PG8_STAGE(PG8_SB(1, 0), b3, voffB); PG8_STAGE(PG8_SB(1, 1), b3 + hstep, voffB); PG8_STAGE(PG8_SA(1, 0), a3, voffA);
            PG8_WAIT_V(8); PG8_WAIT_L(0); PG8_BAR; PG8_MMA(1, 0, At, B0); PG8_MMA(1, 1, At, B1); PG8_BAR; PG8_SCHED;
            } else {
            PG8_LDB(B0, 0, 0); PG8_SCHED; PG8_LDA(At, 0, 0); PG8_STAGE(PG8_SA(1, 1), a1 + hstep, voffA);
            PG8_WAIT_L(8); PG8_BAR; PG8_WAIT_L(0); PG8_MMA(0, 0, At, B0); PG8_BAR; PG8_SCHED;
            PG8_LDB(B1, 0, 1); PG8_STAGE(PG8_SB(0, 0), b2, voffB);
            PG8_BAR; PG8_WAIT_L(0); PG8_MMA(0, 1, At, B1); PG8_BAR;
            PG8_LDA(At, 0, 1); PG8_STAGE(PG8_SA(0, 0), a2, voffA);
            PG8_BAR; PG8_WAIT_L(0); PG8_MMA(1, 0, At, B0); PG8_BAR; PG8_SCHED;
            PG8_STAGE(PG8_SB(0, 1), b2 + hstep, voffB);
            PG8_WAIT_V(6); PG8_BAR; PG8_MMA(1, 1, At, B1); PG8_BAR;
            PG8_LDB(B0, 1, 0); PG8_SCHED; PG8_LDA(At, 1, 0); PG8_STAGE(PG8_SA(0, 1), a2 + hstep, voffA);
            PG8_WAIT_L(8); PG8_BAR; PG8_WAIT_L(0); PG8_MMA(0, 0, At, B0); PG8_BAR; PG8_SCHED;
            PG8_LDB(B1, 1, 1); PG8_STAGE(PG8_SB(1, 0), b3, voffB);
            PG8_BAR; PG8_WAIT_L(0); PG8_MMA(0, 1, At, B1); PG8_BAR;
            PG8_LDA(At, 1, 1); PG8_STAGE(PG8_SA(1, 0), a3, voffA);
            PG8_BAR; PG8_WAIT_L(0); PG8_MMA(1, 0, At, B0); PG8_BAR; PG8_SCHED;
            PG8_STAGE(PG8_SB(1, 1), b3 + hstep, voffB);
            PG8_WAIT_V(6); PG8_BAR; PG8_MMA(1, 1, At, B1); PG8_BAR;
            }
        }
        if constexpr (ALIGN_EPI) { if (wr == 0) PG8_BAR; }
        if constexpr (!Epi::AFTER_DRAIN) { E(acc, cur, wr, wc, fr, fq); S.done(cur); }
        if (!has_next) break;
#pragma unroll
        for (int a = 0; a < 2; ++a)
#pragma unroll
            for (int b = 0; b < 2; ++b)
#pragma unroll
                for (int m = 0; m < 4; ++m)
#pragma unroll
                    for (int n = 0; n < 2; ++n) acc[a][b][m][n] = (f32x4){0.f, 0.f, 0.f, 0.f};
        cur = nxt; cA = nA; cB = nB; ++ui;
        if constexpr (ALIGN_EPI) { if (wr == 1) PG8_BAR; }
    }
    PG8_WAIT_V(0);
    if constexpr (!ALIGN_EPI) { if (wr == 0) PG8_BAR; }
    PG8_BAR;
    if constexpr (Epi::AFTER_DRAIN) { E.fused(acc, cur, wr, wc, fr, fq, lds, wid, lane); S.done(cur); }
#undef PG8_SA
#undef PG8_SB
#undef PG8_STAGE
#undef PG8_LDA
#undef PG8_LDB
#undef PG8_MMA
#undef PG8_WAIT_V
#undef PG8_WAIT_L
#undef PG8_BAR
#undef PG8_SCHED
}
}

#define LAS __attribute__((address_space(3)))
typedef unsigned short bf16_t;
typedef short bf16x8 __attribute__((ext_vector_type(8)));
typedef short s16x4 __attribute__((ext_vector_type(4)));
typedef float f32x4 __attribute__((ext_vector_type(4)));
typedef float f32x2 __attribute__((ext_vector_type(2)));
typedef float f32x16 __attribute__((ext_vector_type(16)));
typedef unsigned u32x4 __attribute__((ext_vector_type(4)));
typedef unsigned u32x2 __attribute__((ext_vector_type(2)));
typedef __bf16 bf16x2_t __attribute__((ext_vector_type(2)));

__device__ __forceinline__ unsigned pk2(float lo, float hi) { f32x2 v = {lo, hi}; bf16x2_t b = __builtin_convertvector(v, bf16x2_t); return __builtin_bit_cast(unsigned, b); }
__device__ __forceinline__ float bflo(unsigned u) { return __uint_as_float(u << 16); }
__device__ __forceinline__ float bfhi(unsigned u) { return __uint_as_float(u & 0xffff0000u); }
__device__ __forceinline__ float fexp(float x) { return __builtin_amdgcn_exp2f(x * 1.4426950408889634f); }
__device__ __forceinline__ float frcp(float x) { return __builtin_amdgcn_rcpf(x); }
__device__ __forceinline__ float sigmoidf_(float x) { return frcp(1.f + fexp(-x)); }
template <int CTRL> __device__ __forceinline__ float dpp(float x) { return __builtin_bit_cast(float, __builtin_amdgcn_update_dpp(0, __builtin_bit_cast(int, x), CTRL, 0xf, 0xf, true)); }
__device__ __forceinline__ float swap32_sum(float x) { auto rr = __builtin_amdgcn_permlane32_swap(__float_as_uint(x), __float_as_uint(x), false, false); return __uint_as_float(rr[0]) + __uint_as_float(rr[1]); }
__device__ __forceinline__ float swap32_max(float x) { auto rr = __builtin_amdgcn_permlane32_swap(__float_as_uint(x), __float_as_uint(x), false, false); return fmaxf(__uint_as_float(rr[0]), __uint_as_float(rr[1])); }
__device__ __forceinline__ float swap16_sum(float x) { auto rr = __builtin_amdgcn_permlane16_swap(__float_as_uint(x), __float_as_uint(x), false, false); return __uint_as_float(rr[0]) + __uint_as_float(rr[1]); }
__device__ __forceinline__ float sum8(float x) { x += dpp<0xB1>(x); x += dpp<0x4E>(x); x += dpp<0x141>(x); return x; }
__device__ __forceinline__ float wave_sum(float x) { x += dpp<0xB1>(x); x += dpp<0x4E>(x); x += dpp<0x141>(x); x += dpp<0x140>(x); x = swap16_sum(x); x = swap32_sum(x); return x; }

constexpr size_t MiB = 1u << 20;
constexpr size_t WS_CTL = 0, CTL_ZERO_BYTES = 65536;
constexpr int CW_BAR = 4096, LDS_BARW = 147424;
constexpr size_t WS_ROPE = 1 * MiB;
constexpr size_t WS_LF = 1 * MiB + 640 * 1024;
constexpr size_t WS_W1T = 2 * MiB;
constexpr size_t WS_W2T = 35 * MiB;
constexpr size_t WS_XN = 43 * MiB;
constexpr size_t WS_RKV = 108 * MiB;
constexpr size_t WS_GR = 207 * MiB;
constexpr size_t WS_WA = 240 * MiB;
constexpr size_t WS_QD = 245 * MiB, WS_KD = 278 * MiB, WS_VD = 311 * MiB, WS_GD = 344 * MiB;
constexpr size_t WS_Y = 377 * MiB;
constexpr size_t WS_SSQ = 451 * MiB;
constexpr size_t WS_TAIL = 441 * MiB;
constexpr size_t WS_END = 512 * MiB;
constexpr int LDS_BYTES = 147456;
constexpr int LDS_QW = 147440;

struct Args {
    const float* in[21]; float* out; unsigned char* ws; float inv_freq[32]; int ph_lo, ph_hi, coop, pad;
};

constexpr float C2 = 0.125f * 1.4426950408889634f;
struct EpiProj {
    static constexpr bool PERM = true, AFTER_DRAIN = false;
    bf16_t *RKV, *GR, *WA, *QD, *KD, *VD, *GD; const float* rope;
    __device__ __forceinline__ void operator()(const f32x4 (&acc)[2][2][4][2], const pg8::Unit& u, int wr, int wc, int fr, int fq) const {
        const int pn = u.pn; bf16_t* base; int ld, colt, kind = 0;
        if (pn < 12) { base = RKV; ld = 3072; colt = pn * 256; }
        else if (pn < 16) { base = GR; ld = 1024; colt = (pn - 12) * 256; }
        else if (pn < 20) { base = QD; ld = 1024; colt = (pn - 16) * 256; kind = 1; }
        else if (pn < 24) { base = KD; ld = 1024; colt = (pn - 20) * 256; kind = 2; }
        else if (pn < 28) { base = VD; ld = 1024; colt = (pn - 24) * 256; }
        else if (pn < 32) { base = GD; ld = 1024; colt = (pn - 28) * 256; }
        else { base = WA; ld = 128; colt = 0; kind = 3; }
        const bool meta = (u.pm == 64);
        const int pos0 = meta ? 0 : (NMETA + (u.pm & 7) * 256);
        const int brow0 = meta ? 0 : (u.pm >> 3) * LP;
        const int cl = wc * 32 + 8 * fq;
        const int i0 = ((wc & 1) * 16 + 4 * fq);
        const float qs = (kind == 1) ? C2 : 1.f;
#pragma unroll
        for (int ai = 0; ai < 2; ++ai)
#pragma unroll
            for (int m = 0; m < 4; ++m) {
                const int rt = ai * 128 + wr * 64 + m * 16 + fr;
                if (meta && rt >= NMETA) continue;
                const int pos = pos0 + rt;
#pragma unroll
                for (int bj = 0; bj < 2; ++bj) {
                    if (kind == 3 && bj == 1) continue;
                    f32x4 v0 = acc[ai][bj][m][0], v1 = acc[ai][bj][m][1];
                    if (kind == 1 || kind == 2) {
                        const f32x4 cs0 = *(const f32x4*)(rope + ((size_t)pos * 32 + i0) * 2), cs1 = *(const f32x4*)(rope + ((size_t)pos * 32 + i0) * 2 + 4);
                        f32x4 o0, o1;
                        o0[0] = (v0[0] * cs0[0] - v0[1] * cs0[1]) * qs; o0[1] = (v0[1] * cs0[0] + v0[0] * cs0[1]) * qs;
                        o0[2] = (v0[2] * cs0[2] - v0[3] * cs0[3]) * qs; o0[3] = (v0[3] * cs0[2] + v0[2] * cs0[3]) * qs;
                        o1[0] = (v1[0] * cs1[0] - v1[1] * cs1[1]) * qs; o1[1] = (v1[1] * cs1[0] + v1[0] * cs1[1]) * qs;
                        o1[2] = (v1[2] * cs1[2] - v1[3] * cs1[3]) * qs; o1[3] = (v1[3] * cs1[2] + v1[2] * cs1[3]) * qs;
                        v0 = o0; v1 = o1;
                    }
                    u32x4 w; w.x = pk2(v0[0], v0[1]); w.y = pk2(v0[2], v0[3]); w.z = pk2(v1[0], v1[1]); w.w = pk2(v1[2], v1[3]);
                    const int col = colt + bj * 128 + cl;
                    if (!meta) { *(u32x4*)(base + (size_t)(brow0 + pos) * ld + col) = w; }
                    else {
#pragma unroll
                        for (int b = 0; b < NB; ++b) *(u32x4*)(base + (size_t)(b * LP + pos) * ld + col) = w;
                    }
                }
            }
    }
};

struct EpiY {
    static constexpr bool PERM = true, AFTER_DRAIN = false;
    bf16_t* YO; float* SSQ;
    __device__ __forceinline__ void operator()(const f32x4 (&acc)[2][2][4][2], const pg8::Unit& u, int wr, int wc, int fr, int fq) const {
        const int cl = u.pn * 256 + wc * 32 + 8 * fq;
#pragma unroll
        for (int ai = 0; ai < 2; ++ai)
#pragma unroll
            for (int m = 0; m < 4; ++m) {
                const int row = u.pm * 256 + ai * 128 + wr * 64 + m * 16 + fr;
#pragma unroll
                for (int bj = 0; bj < 2; ++bj) {
                    const f32x4 v0 = acc[ai][bj][m][0], v1 = acc[ai][bj][m][1];
                    u32x4 w; w.x = pk2(v0[0], v0[1]); w.y = pk2(v0[2], v0[3]); w.z = pk2(v1[0], v1[1]); w.w = pk2(v1[2], v1[3]);
                    *(u32x4*)(YO + (size_t)row * DM + cl + bj * 128) = w;
                }
            }
    }
};

__device__ __forceinline__ int w1_src_col(int n) {
    const int t = n >> 8, ct = n & 255;
    if (t < 12) return n;
    if (t < 16) return 3200 + (n - 3072);
    if (t < 24) { const int base = 4224 + (t - 16) * 256, hc = ct >> 6, p = ct & 63; return base + hc * 64 + (p >> 1) + 32 * (p & 1); }
    if (t < 32) return 6272 + (n - 6144);
    return ct < 128 ? 3072 + ct : -1;
}
template <bool MAP> __device__ __forceinline__ void p0_transpose_item(const float* W, int NS, bf16_t* WT, int nblk, LAS float* scr, int item, int lane) {
    const int kb = item / nblk, nb = item % nblk, k0 = 64 * kb, n0 = 32 * nb;
    const int sc = MAP ? w1_src_col(n0 + (lane & 31)) : (n0 + (lane & 31));
#pragma unroll 8
    for (int i = 0; i < 32; ++i) { const int kk = 2 * i + (lane >> 5); scr[kk * 33 + (lane & 31)] = (sc >= 0) ? W[(size_t)(k0 + kk) * NS + sc] : 0.f; }
    asm volatile("s_waitcnt lgkmcnt(0)" ::: "memory");
    const int c = lane & 7;
#pragma unroll
    for (int j = 0; j < 4; ++j) { const int n = (lane >> 3) + 8 * j; const LAS float* s = scr + (8 * c) * 33 + n;
        u32x4 o; o.x = pk2(s[0 * 33], s[1 * 33]); o.y = pk2(s[2 * 33], s[3 * 33]); o.z = pk2(s[4 * 33], s[5 * 33]); o.w = pk2(s[6 * 33], s[7 * 33]);
        *(u32x4*)(WT + (size_t)(n0 + n) * 2048 + k0 + 8 * c) = o; }
    asm volatile("s_waitcnt lgkmcnt(0)" ::: "memory");
}


__device__ __forceinline__ int w1_dst_row(int j) {
    if (j < 3072) return j;
    if (j < 3200) return 8192 + (j - 3072);
    if (j < 4224) return 3072 + (j - 3200);
    if (j < 6272) { const int rel = j - 4224, d = rel & 63, grp = rel >> 6; return 4096 + grp * 64 + ((d < 32) ? 2 * d : 2 * (d - 32) + 1); }
    return 6144 + (j - 6272);
}
template <bool MAP> __device__ __forceinline__ void p0_transpose128(const float* W, int NS, bf16_t* WT, int nblk, LAS float* scr, int item, int lane) {
    const int kb = item / nblk, nb = item % nblk, k0 = 32 * kb, n0 = 128 * nb;
#pragma unroll 4
    for (int i = 0; i < 16; ++i) { const int k = 2 * i + (lane >> 5); *(LAS f32x4*)(scr + k * 132 + 4 * (lane & 31)) = *(const f32x4*)(W + (size_t)(k0 + k) * NS + n0 + 4 * (lane & 31)); }
    asm volatile("s_waitcnt lgkmcnt(0)" ::: "memory");
    const int kq = lane >> 4, nl = lane & 15;
#pragma unroll
    for (int p = 0; p < 8; ++p) { const int n = 16 * p + nl; const LAS float* sp = scr + (8 * kq) * 132 + n;
        u32x4 o; o.x = pk2(sp[0 * 132], sp[1 * 132]); o.y = pk2(sp[2 * 132], sp[3 * 132]); o.z = pk2(sp[4 * 132], sp[5 * 132]); o.w = pk2(sp[6 * 132], sp[7 * 132]);
        const int dr = MAP ? w1_dst_row(n0 + n) : (n0 + n);
        *(u32x4*)(WT + (size_t)dr * 2048 + k0 + 8 * kq) = o; }
    asm volatile("s_waitcnt lgkmcnt(0)" ::: "memory");
}

constexpr int P0_NB1 = NIN / 64, P0_I1 = 32 * P0_NB1, P0_I2 = 32 * 32;
__device__ __forceinline__ void p0_ld(f32x4 (&r)[16], const Args& A, int it, int lane) {
    const bool w1 = it < P0_I1; const float* W = w1 ? A.in[3] : A.in[19]; const int NS = w1 ? NIN : 2048, nblk = w1 ? P0_NB1 : 32, item = w1 ? it : it - P0_I1;
    const int kb = item / nblk, nb = item % nblk;
    const float* p = W + (size_t)(64 * kb + (lane >> 4)) * NS + 64 * nb + 4 * (lane & 15);
#pragma unroll
    for (int i = 0; i < 16; ++i) r[i] = __builtin_nontemporal_load((const f32x4*)(p + (size_t)(4 * i) * NS));
}
__device__ __forceinline__ void p0_emit(const f32x4 (&r)[16], bf16_t* W1T, bf16_t* W2T, LAS float* scr, int it, int lane) {
    const bool w1 = it < P0_I1; const int nblk = w1 ? P0_NB1 : 32, item = w1 ? it : it - P0_I1;
    const int kb = item / nblk, nb = item % nblk, k0 = 64 * kb, n0 = 64 * nb;
#pragma unroll
    for (int i = 0; i < 16; ++i) *(LAS f32x4*)(scr + (4 * i + (lane >> 4)) * 68 + 4 * (lane & 15)) = r[i];
    asm volatile("s_waitcnt lgkmcnt(0)" ::: "memory");
    bf16_t* WT = w1 ? W1T : W2T;
    const int dr = w1 ? w1_dst_row(n0 + lane) : (n0 + lane);
    bf16_t* dst = WT + (size_t)dr * 2048 + k0;
#pragma unroll
    for (int p = 0; p < 8; ++p) { const LAS float* sp = scr + (8 * p) * 68 + lane;
        u32x4 o; o.x = pk2(sp[0 * 68], sp[1 * 68]); o.y = pk2(sp[2 * 68], sp[3 * 68]); o.z = pk2(sp[4 * 68], sp[5 * 68]); o.w = pk2(sp[6 * 68], sp[7 * 68]);
        *(u32x4*)(dst + 8 * p) = o; }
    asm volatile("s_waitcnt lgkmcnt(0)" ::: "memory");
}

constexpr int RW_NCH = 65, RW_TASKS = 128 * RW_NCH, RW_TB = 24832;
constexpr int RW_SEG0 = 5400;
__device__ __forceinline__ unsigned char* rw_block(const Args& A, int task) {
    if (task < RW_SEG0) return (unsigned char*)A.out + (size_t)task * RW_TB;
    return A.ws + WS_TAIL + (size_t)(task - RW_SEG0) * RW_TB;
}
__device__ __forceinline__ int Tk(int r, int hi) { return (r & 3) + 8 * (r >> 2) + 4 * hi; }
__device__ __forceinline__ bf16x8 pack8(const f32x16& x, int s) {
    return __builtin_bit_cast(bf16x8, (u32x4){pk2(x[8 * s], x[8 * s + 1]), pk2(x[8 * s + 2], x[8 * s + 3]), pk2(x[8 * s + 4], x[8 * s + 5]), pk2(x[8 * s + 6], x[8 * s + 7])});
}
__device__ __forceinline__ bf16x8 neg8(bf16x8 v) { u32x4 u = __builtin_bit_cast(u32x4, v); u ^= (u32x4){0x80008000u, 0x80008000u, 0x80008000u, 0x80008000u}; return __builtin_bit_cast(bf16x8, u); }
__device__ __forceinline__ float sum32h(float x) { x += dpp<0xB1>(x); x += dpp<0x4E>(x); x += dpp<0x141>(x); x += dpp<0x140>(x); return swap16_sum(x); }
#define MFMA32(a, b, c) __builtin_amdgcn_mfma_f32_32x32x16_bf16((a), (b), (c), 0, 0, 0)

#define BUFR(p, bytes) __builtin_amdgcn_make_buffer_rsrc((void*)(p), (short)0, (int)(bytes), 0x00020000)
#define SBAR0 do {} while (0)
namespace rwa {
__device__ __forceinline__ unsigned offm(unsigned t, unsigned p) { const unsigned f = (((t >> 1) & 1u) << 2) | ((t >> 2) & 3u); return 128u * t + 16u * ((p >> 3) ^ f) + 2u * (p & 7u); }
__device__ __forceinline__ void st16(LAS unsigned char* p, float x) { *(LAS bf16_t*)p = (bf16_t)(pk2(x, 0.f) & 0xffffu); }

__device__ __forceinline__ void task(const Args& A, int task, LAS unsigned char* wl, int lane_) {
    int lane = lane_; asm volatile("" : "+v"(lane));
    const int n = lane & 31, hi = lane >> 5;
    const int ch = task / RW_NCH, c = task - ch * RW_NCH, b = ch >> 4, h = ch & 15, t0 = 32 * c;
    const size_t rowb = (size_t)b * LP + t0;
    const __amdgpu_buffer_rsrc_t rR = BUFR((const bf16_t*)(A.ws + WS_RKV) + (rowb - 1) * 3072 + h * 64, 34 * 6144);
    const __amdgpu_buffer_rsrc_t rW = BUFR((const bf16_t*)(A.ws + WS_WA) + (rowb - 1) * 128, 34 * 256);
    const __amdgpu_buffer_rsrc_t rL = BUFR((const unsigned char*)(A.ws + WS_LF) + (size_t)h * 16384, 16384);
    unsigned char* ob = rw_block(A, task);
    const __amdgpu_buffer_rsrc_t rO = BUFR(ob, RW_TB);
    const float* mu = A.in[4];
    f32x16 accw[2], acca[2];
#pragma unroll
    for (int i = 0; i < 16; ++i) { accw[0][i] = 0.f; accw[1][i] = 0.f; acca[0][i] = 0.f; acca[1][i] = 0.f; }
    {
        const bool hasp = (t0 + n) > 0;
        const unsigned vo = (unsigned)(n * 256 + 16 * hi);
        u32x4 wcw[4], wca[4], wpw[4], wpa[4], lfw[4][2], lfa[4][2];
#pragma unroll
        for (int s = 0; s < 4; ++s) {
            wcw[s] = __builtin_amdgcn_raw_buffer_load_b128(rW, vo, 256 + 32 * s, 0); wca[s] = __builtin_amdgcn_raw_buffer_load_b128(rW, vo, 256 + 128 + 32 * s, 0);
            wpw[s] = __builtin_amdgcn_raw_buffer_load_b128(rW, vo, 32 * s, 0); wpa[s] = __builtin_amdgcn_raw_buffer_load_b128(rW, vo, 128 + 32 * s, 0); }
#pragma unroll
        for (int s = 0; s < 4; ++s)
#pragma unroll
            for (int nb = 0; nb < 2; ++nb) { lfw[s][nb] = __builtin_amdgcn_raw_buffer_load_b128(rL, (unsigned)lane * 16u, ((0 * 2 + nb) * 4 + s) * 1024, 0);
                                             lfa[s][nb] = __builtin_amdgcn_raw_buffer_load_b128(rL, (unsigned)lane * 16u, ((1 * 2 + nb) * 4 + s) * 1024, 0); }
        asm volatile("" ::: "memory");
#pragma unroll
        for (int s = 0; s < 4; ++s) {
            const u32x4 cw = wcw[s], ca = wca[s];
            u32x4 pw = wpw[s], pa = wpa[s];
            if (!hasp) { pw = (u32x4){0u, 0u, 0u, 0u}; pa = (u32x4){0u, 0u, 0u, 0u}; }
            const f32x4 mw0 = *(const f32x4*)(mu + 3072 + 16 * s + 8 * hi), mw1 = *(const f32x4*)(mu + 3072 + 16 * s + 8 * hi + 4);
            const f32x4 ma0 = *(const f32x4*)(mu + 3136 + 16 * s + 8 * hi), ma1 = *(const f32x4*)(mu + 3136 + 16 * s + 8 * hi + 4);
            const float mwv[8] = {mw0[0], mw0[1], mw0[2], mw0[3], mw1[0], mw1[1], mw1[2], mw1[3]}, mav[8] = {ma0[0], ma0[1], ma0[2], ma0[3], ma1[0], ma1[1], ma1[2], ma1[3]};
            float xw[8], xa[8];
#pragma unroll
            for (int j = 0; j < 4; ++j) {
                const float c0 = bflo(cw[j]), c1 = bfhi(cw[j]), p0 = bflo(pw[j]), p1 = bfhi(pw[j]);
                const float w0_ = c0 + (p0 - c0) * mwv[2 * j], w1_ = c1 + (p1 - c1) * mwv[2 * j + 1];
                xw[2 * j] = 1.f - 2.f * frcp(fexp(2.f * w0_) + 1.f); xw[2 * j + 1] = 1.f - 2.f * frcp(fexp(2.f * w1_) + 1.f);
                const float d0 = bflo(ca[j]), d1 = bfhi(ca[j]), q0 = bflo(pa[j]), q1 = bfhi(pa[j]);
                xa[2 * j] = d0 + (q0 - d0) * mav[2 * j]; xa[2 * j + 1] = d1 + (q1 - d1) * mav[2 * j + 1];
            }
            const bf16x8 Aw = __builtin_bit_cast(bf16x8, (u32x4){pk2(xw[0], xw[1]), pk2(xw[2], xw[3]), pk2(xw[4], xw[5]), pk2(xw[6], xw[7])});
            const bf16x8 Aa = __builtin_bit_cast(bf16x8, (u32x4){pk2(xa[0], xa[1]), pk2(xa[2], xa[3]), pk2(xa[4], xa[5]), pk2(xa[6], xa[7])});
#pragma unroll
            for (int nb = 0; nb < 2; ++nb) {
                accw[nb] = MFMA32(Aw, __builtin_bit_cast(bf16x8, lfw[s][nb]), accw[nb]); acca[nb] = MFMA32(Aa, __builtin_bit_cast(bf16x8, lfa[s][nb]), acca[nb]);
            }
            SBAR0;
        }
    }
    __builtin_amdgcn_s_barrier();
    const f32x2 w0v = *(const f32x2*)(A.in[5] + h * 64 + 2 * n), a0v = *(const f32x2*)(A.in[7] + h * 64 + 2 * n);
    float gC[2]; unsigned aap[2][8];
#pragma unroll
    for (int nb = 0; nb < 2; ++nb) {
        float prod = 1.f;
#pragma unroll
        for (int r = 0; r < 16; ++r) { const bool valid = (t0 + Tk(r, hi)) < LSEQ; const float sg = sigmoidf_(accw[nb][r] + w0v[nb]); const float d = valid ? fexp(-0.6065306597126334f * sg) : 1.f; accw[nb][r] = d; prod *= d; }
        const auto sw = __builtin_amdgcn_permlane32_swap(__float_as_uint(prod), __float_as_uint(prod), false, false);
        gC[nb] = __uint_as_float(sw[0]) * __uint_as_float(sw[1]);
#pragma unroll
        for (int i = 0; i < 8; ++i) aap[nb][i] = pk2(sigmoidf_(acca[nb][2 * i] + a0v[nb]), sigmoidf_(acca[nb][2 * i + 1] + a0v[nb]));
    }
    SBAR0;
    const f32x2 mur = *(const f32x2*)(mu + h * 64 + 2 * n), muk = *(const f32x2*)(mu + 1024 + h * 64 + 2 * n);
    const f32x2 kkw = *(const f32x2*)(A.in[9] + h * 64 + 2 * n), kaw = *(const f32x2*)(A.in[10] + h * 64 + 2 * n), rkw = *(const f32x2*)(A.in[11] + h * 64 + 2 * n);
    const unsigned voR = (unsigned)(hi * 4 * 6144 + 4 * n);
    u32x4 pKKg[2][2], pBc[2][2], pKc[2][2];
    const __amdgpu_buffer_rsrc_t rB = BUFR(ob + 24576, 128);
    float run0 = 1.f, run1 = 1.f;
    unsigned crn[5], ckn[5];
#pragma unroll
    for (int i = 0; i < 5; ++i) { crn[i] = __builtin_amdgcn_raw_buffer_load_b32(rR, voR, i * 6144, 0); ckn[i] = __builtin_amdgcn_raw_buffer_load_b32(rR, voR, i * 6144 + 2048, 0); }
#pragma unroll
    for (int g = 0; g < 4; ++g) {
        int ln = lane; asm volatile("" : "+v"(ln)); const int n2 = ln & 31, hi2 = ln >> 5;
        unsigned crg[5], ckg[5];
#pragma unroll
        for (int i = 0; i < 5; ++i) { crg[i] = crn[i]; ckg[i] = ckn[i]; }
        if (t0 + Tk(4 * g, hi2) == 0) { crg[0] = 0u; ckg[0] = 0u; }
        if (g < 3) {
#pragma unroll
            for (int i = 0; i < 5; ++i) { crn[i] = __builtin_amdgcn_raw_buffer_load_b32(rR, voR, (8 * (g + 1) + i) * 6144, 0); ckn[i] = __builtin_amdgcn_raw_buffer_load_b32(rR, voR, (8 * (g + 1) + i) * 6144 + 2048, 0); }
        }
        float Gi[2][4], Gx[2][4];
#pragma unroll
        for (int nb = 0; nb < 2; ++nb) {
            const float p0 = accw[nb][4 * g], p1 = p0 * accw[nb][4 * g + 1], p2 = p1 * accw[nb][4 * g + 2], p3 = p2 * accw[nb][4 * g + 3];
            const auto sw = __builtin_amdgcn_permlane32_swap(__float_as_uint(p3), __float_as_uint(p3), false, false);
            const float other = hi2 ? __uint_as_float(sw[0]) : __uint_as_float(sw[1]);
            const float run = nb ? run1 : run0;
            const float pre = hi2 ? run * other : run;
            Gi[nb][0] = pre * p0; Gi[nb][1] = pre * p1; Gi[nb][2] = pre * p2; Gi[nb][3] = pre * p3;
            Gx[nb][0] = pre; Gx[nb][1] = pre * p0; Gx[nb][2] = pre * p1; Gx[nb][3] = pre * p2;
            if (nb) run1 = run * p3 * other; else run0 = run * p3 * other;
        }
#pragma unroll
        for (int hp = 0; hp < 2; ++hp) {
            float oKKg[2][2], oBc[2][2], oKc[2][2];
#pragma unroll
            for (int e = 0; e < 2; ++e) {
                const int i4 = 2 * hp + e, r = 4 * g + i4, T = Tk(r, hi2);
                const bool valid = (t0 + T) < LSEQ;
                const unsigned cr_ = crg[i4 + 1], pr = crg[i4], ck_ = ckg[i4 + 1], pk = ckg[i4];
                float rr[2], kr[2];
                { const float c0 = bflo(cr_), c1 = bfhi(cr_), p0 = bflo(pr), p1 = bfhi(pr); rr[0] = valid ? c0 + (p0 - c0) * mur[0] : 0.f; rr[1] = valid ? c1 + (p1 - c1) * mur[1] : 0.f; }
                { const float c0 = bflo(ck_), c1 = bfhi(ck_), p0 = bflo(pk), p1 = bfhi(pk); kr[0] = c0 + (p0 - c0) * muk[0]; kr[1] = c1 + (p1 - c1) * muk[1]; }
                const float a0_ = (r & 1) ? bfhi(aap[0][r >> 1]) : bflo(aap[0][r >> 1]), a1_ = (r & 1) ? bfhi(aap[1][r >> 1]) : bflo(aap[1][r >> 1]);
                float k0 = kr[0] * kkw[0], k1 = kr[1] * kkw[1];
                const float ss = sum32h(k0 * k0 + k1 * k1); const float inv = valid ? __builtin_amdgcn_rsqf(fmaxf(ss, 1e-24f)) : 0.f;
                k0 *= inv; k1 *= inv;
                const float kp0 = valid ? kr[0] * (1.f + (a0_ - 1.f) * kaw[0]) : 0.f, kp1 = valid ? kr[1] * (1.f + (a1_ - 1.f) * kaw[1]) : 0.f;
                const float bs = sum32h(rr[0] * kp0 * rkw[0] + rr[1] * kp1 * rkw[1]);
                if (n2 == 0) __builtin_amdgcn_raw_buffer_store_b32(__float_as_uint(bs), rB, (unsigned)(hi2 * 16), 4 * (i4 + 8 * g), 0);
                const float ig0 = frcp(Gi[0][i4]), ig1 = frcp(Gi[1][i4]);
                const float kkg0 = k0 * Gx[0][i4], kkg1 = k1 * Gx[1][i4], rg0 = rr[0] * Gi[0][i4], rg1 = rr[1] * Gi[1][i4];
                const float bi0 = k0 * a0_ * ig0, bi1 = k1 * a1_ * ig1, ki0 = kp0 * ig0, ki1 = kp1 * ig1;
                LAS unsigned char* q0 = wl + offm(T, n2); LAS unsigned char* q1 = wl + offm(T, 32 + n2);
                st16(q0, kkg0); st16(q1, kkg1); st16(q0 + 4096, rg0); st16(q1 + 4096, rg1); st16(q0 + 8192, bi0); st16(q1 + 8192, bi1); st16(q0 + 12288, ki0); st16(q1 + 12288, ki1);
                oKKg[0][e] = kkg0; oKKg[1][e] = kkg1; oBc[0][e] = bi0 * gC[0]; oBc[1][e] = bi1 * gC[1]; oKc[0][e] = ki0 * gC[0]; oKc[1][e] = ki1 * gC[1];
            }
#pragma unroll
            for (int nb = 0; nb < 2; ++nb) { pKKg[nb][g >> 1][2 * (g & 1) + hp] = pk2(oKKg[nb][0], oKKg[nb][1]); pBc[nb][g >> 1][2 * (g & 1) + hp] = pk2(oBc[nb][0], oBc[nb][1]); pKc[nb][g >> 1][2 * (g & 1) + hp] = pk2(oKc[nb][0], oKc[nb][1]); }
            SBAR0;
        }
    }
    bf16x8 fKKg[2][2], fBc[2][2], fKc[2][2], fV[2][2];
#pragma unroll
    for (int nb = 0; nb < 2; ++nb)
#pragma unroll
        for (int s_ = 0; s_ < 2; ++s_) { fKKg[nb][s_] = __builtin_bit_cast(bf16x8, pKKg[nb][s_]); fBc[nb][s_] = __builtin_bit_cast(bf16x8, pBc[nb][s_]); fKc[nb][s_] = __builtin_bit_cast(bf16x8, pKc[nb][s_]); }
    {
        const unsigned voV = (unsigned)(hi * 4 * 6144 + 4 * n);
        const f32x2 muv = *(const f32x2*)(mu + 2048 + h * 64 + 2 * n);
        unsigned cv[16], pv4[4]; f32x16 x0, x1;
#pragma unroll
        for (int r = 0; r < 16; ++r) { const int T0 = (r & 3) + 8 * (r >> 2); cv[r] = __builtin_amdgcn_raw_buffer_load_b32(rR, voV, (T0 + 1) * 6144 + 4096, 0); }
#pragma unroll
        for (int g = 0; g < 4; ++g) pv4[g] = __builtin_amdgcn_raw_buffer_load_b32(rR, voV, (8 * g) * 6144 + 4096, 0);
        asm volatile("" : "+v"(pv4[0]), "+v"(pv4[1]), "+v"(pv4[2]), "+v"(pv4[3]));
#pragma unroll
        for (int g = 0; g < 4; ++g) if (t0 + Tk(4 * g, hi) == 0) pv4[g] = 0u;
#pragma unroll
        for (int r = 0; r < 16; ++r) { const unsigned pv = (r & 3) ? cv[r - 1] : pv4[r >> 2]; const bool valid = (t0 + Tk(r, hi)) < LSEQ;
            const float c0 = bflo(cv[r]), c1 = bfhi(cv[r]), p0 = bflo(pv), p1 = bfhi(pv);
            x0[r] = valid ? c0 + (p0 - c0) * muv[0] : 0.f; x1[r] = valid ? c1 + (p1 - c1) * muv[1] : 0.f; }
        fV[0][0] = pack8(x0, 0); fV[0][1] = pack8(x0, 1); fV[1][0] = pack8(x1, 0); fV[1][1] = pack8(x1, 1);
    }
    asm volatile("s_waitcnt lgkmcnt(0)" ::: "memory");
    SBAR0;
    __builtin_amdgcn_s_barrier();
    f32x16 Sbb, Sbk, Arb, Ark;
#pragma unroll
    for (int i = 0; i < 16; ++i) { Sbb[i] = 0.f; Sbk[i] = 0.f; Arb[i] = 0.f; Ark[i] = 0.f; }
#pragma unroll
    for (int s = 0; s < 4; ++s) {
        const unsigned o = offm(n, 16 * s + 8 * hi);
        const bf16x8 kg = *(const LAS bf16x8*)(wl + 0 * 4096 + o), rg = *(const LAS bf16x8*)(wl + 1 * 4096 + o), bi = *(const LAS bf16x8*)(wl + 2 * 4096 + o), ki = *(const LAS bf16x8*)(wl + 3 * 4096 + o);
        Sbb = MFMA32(bi, kg, Sbb); Sbk = MFMA32(ki, kg, Sbk); Arb = MFMA32(bi, rg, Arb); Ark = MFMA32(ki, rg, Ark);
        SBAR0;
    }
#pragma unroll
    for (int r = 0; r < 16; ++r) { const int j = Tk(r, hi); if (!(j < n)) { Sbb[r] = 0.f; Sbk[r] = 0.f; } if (!(j <= n)) { Arb[r] = 0.f; Ark[r] = 0.f; } }
    SBAR0;
    f32x16 Yl[2]; bf16x8 fZ[2][2];
    {
        const bf16x8 sk0 = pack8(Sbk, 0), sk1 = pack8(Sbk, 1), ak0 = pack8(Ark, 0), ak1 = pack8(Ark, 1);
#pragma unroll
        for (int vt = 0; vt < 2; ++vt) {
            f32x16 z;
#pragma unroll
            for (int i = 0; i < 16; ++i) z[i] = 0.f;
            const f32x16 zz = MFMA32(sk1, fV[vt][1], MFMA32(sk0, fV[vt][0], z));
            fZ[vt][0] = pack8(zz, 0); fZ[vt][1] = pack8(zz, 1);
            Yl[vt] = MFMA32(ak1, fV[vt][1], MFMA32(ak0, fV[vt][0], z));
        }
    }
#pragma unroll
    for (int i = 0; i < 2; ++i)
#pragma unroll
        for (int s_ = 0; s_ < 2; ++s_) { *(LAS bf16x8*)(wl + 8192 + ((i * 2 + s_) * 64 + lane) * 16) = fKc[i][s_]; *(LAS bf16x8*)(wl + 12288 + ((i * 2 + s_) * 64 + lane) * 16) = fV[i][s_]; }
    const bf16x8 fArb0 = pack8(Arb, 0), fArb1 = pack8(Arb, 1);
    SBAR0;
    __builtin_amdgcn_s_barrier();
    float TH[16];
    {
        LAS float* Mc = (LAS float*)wl;
#pragma unroll
        for (int r = 0; r < 16; ++r) Mc[Tk(r, hi) * 32 + n] = Sbb[r];
        asm volatile("s_waitcnt lgkmcnt(0)" ::: "memory");
#pragma unroll
        for (int i = 0; i < 16; ++i) TH[i] = ((4 * (2 * (i >> 2) + hi) + (i & 3)) == n) ? 1.f : 0.f;
        unsigned mh = (unsigned)(size_t)(Mc + 4 * hi);
        f32x4 mcur[4], mnxt[4];
        mcur[3] = *(const LAS f32x4*)(size_t)(mh + (30 * 32 + 8 * 3) * 4);
        mnxt[0] = mnxt[1] = mnxt[2] = mnxt[3] = mcur[3];
#pragma unroll
        for (int c = 30; c >= 0; --c) {
            if (c > 0) {
#pragma unroll
                for (int qq = (c >> 3); qq < 4; ++qq) mnxt[qq] = *(const LAS f32x4*)(size_t)(mh + ((c - 1) * 32 + 8 * qq) * 4);
            }
            float part = 0.f;
#pragma unroll
            for (int qq = ((c + 1) >> 3); qq < 4; ++qq) part += (TH[4 * qq] * mcur[qq][0] + TH[4 * qq + 1] * mcur[qq][1]) + (TH[4 * qq + 2] * mcur[qq][2] + TH[4 * qq + 3] * mcur[qq][3]);
            float tot = swap32_sum(part);
            asm volatile("" : "+v"(mh), "+v"(tot));
            const int idx = 4 * (c >> 3) + (c & 3), owner = (c >> 2) & 1;
            TH[idx] = (hi == owner) ? ((c == n) ? 1.f : -tot) : TH[idx];
#pragma unroll
            for (int qq = 0; qq < 4; ++qq) mcur[qq] = mnxt[qq];
        }
    }
    bf16x8 fT[2];
#pragma unroll
    for (int s_ = 0; s_ < 2; ++s_) fT[s_] = __builtin_bit_cast(bf16x8, (u32x4){pk2(TH[8 * s_], TH[8 * s_ + 1]), pk2(TH[8 * s_ + 2], TH[8 * s_ + 3]), pk2(TH[8 * s_ + 4], TH[8 * s_ + 5]), pk2(TH[8 * s_ + 6], TH[8 * s_ + 7])});
    SBAR0;
    __builtin_amdgcn_s_barrier();
    bf16x8 fKKt[2][2], fW[2][2];
#pragma unroll
    for (int i = 0; i < 2; ++i) {
        f32x16 z;
#pragma unroll
        for (int q = 0; q < 16; ++q) z[q] = 0.f;
        const f32x16 kkt = MFMA32(fT[1], fKKg[i][1], MFMA32(fT[0], fKKg[i][0], z));
        const f32x16 w = MFMA32(fT[1], fZ[i][1], MFMA32(fT[0], fZ[i][0], z));
        fKKt[i][0] = pack8(kkt, 0); fKKt[i][1] = pack8(kkt, 1); fW[i][0] = neg8(pack8(w, 0)); fW[i][1] = neg8(pack8(w, 1));
    }
    SBAR0;
    const unsigned vo16 = (unsigned)lane * 16u;
#pragma unroll
    for (int i = 0; i < 2; ++i)
#pragma unroll
        for (int s_ = 0; s_ < 2; ++s_) { fKc[i][s_] = *(const LAS bf16x8*)(wl + 8192 + ((i * 2 + s_) * 64 + lane) * 16); fV[i][s_] = *(const LAS bf16x8*)(wl + 12288 + ((i * 2 + s_) * 64 + lane) * 16); }
#pragma unroll
    for (int kt = 0; kt < 2; ++kt)
#pragma unroll
        for (int kp = 0; kp < 2; ++kp) {
            f32x16 z;
#pragma unroll
            for (int q = 0; q < 16; ++q) z[q] = 0.f;
            f32x16 a = MFMA32(fKKt[kp][1], fBc[kt][1], MFMA32(fKKt[kp][0], fBc[kt][0], z));
#pragma unroll
            for (int r = 0; r < 16; ++r) a[r] = ((kt == kp && Tk(r, hi) == n) ? gC[kt] : 0.f) - a[r];
            __builtin_amdgcn_raw_buffer_store_b128(__builtin_bit_cast(u32x4, pack8(a, 0)), rO, vo16, ((kt * 2 + kp) * 2 + 0) * 1024, 0);
            __builtin_amdgcn_raw_buffer_store_b128(__builtin_bit_cast(u32x4, pack8(a, 1)), rO, vo16, ((kt * 2 + kp) * 2 + 1) * 1024, 0);
        }
    SBAR0;
#pragma unroll
    for (int kt = 0; kt < 2; ++kt)
#pragma unroll
        for (int vt = 0; vt < 2; ++vt) {
            f32x16 z;
#pragma unroll
            for (int q = 0; q < 16; ++q) z[q] = 0.f;
            f32x16 a = MFMA32(fKc[kt][1], fV[vt][1], MFMA32(fKc[kt][0], fV[vt][0], z));
            a = MFMA32(fBc[kt][1], fW[vt][1], MFMA32(fBc[kt][0], fW[vt][0], a));
            __builtin_amdgcn_raw_buffer_store_b128(__builtin_bit_cast(u32x4, pack8(a, 0)), rO, vo16, 8192 + ((kt * 2 + vt) * 2 + 0) * 1024, 0);
            __builtin_amdgcn_raw_buffer_store_b128(__builtin_bit_cast(u32x4, pack8(a, 1)), rO, vo16, 8192 + ((kt * 2 + vt) * 2 + 1) * 1024, 0);
        }
    SBAR0;
#pragma unroll
    for (int kp = 0; kp < 2; ++kp) {
        f32x16 z;
#pragma unroll
        for (int q = 0; q < 16; ++q) z[q] = 0.f;
        f32x16 a = MFMA32(fKKt[kp][1], fArb1, MFMA32(fKKt[kp][0], fArb0, z));
#pragma unroll
        for (int g = 0; g < 4; ++g) { const u32x2 rg = *(const LAS u32x2*)(wl + 1 * 4096 + offm(n, kp * 32 + 8 * g + 4 * hi));
            a[4 * g] = bflo(rg.x) - a[4 * g]; a[4 * g + 1] = bfhi(rg.x) - a[4 * g + 1]; a[4 * g + 2] = bflo(rg.y) - a[4 * g + 2]; a[4 * g + 3] = bfhi(rg.y) - a[4 * g + 3]; }
        __builtin_amdgcn_raw_buffer_store_b128(__builtin_bit_cast(u32x4, pack8(a, 0)), rO, vo16, 16384 + (kp * 2 + 0) * 1024, 0);
        __builtin_amdgcn_raw_buffer_store_b128(__builtin_bit_cast(u32x4, pack8(a, 1)), rO, vo16, 16384 + (kp * 2 + 1) * 1024, 0);
    }
    SBAR0;
#pragma unroll
    for (int vt = 0; vt < 2; ++vt) {
        const f32x16 a = MFMA32(fArb1, fW[vt][1], MFMA32(fArb0, fW[vt][0], Yl[vt]));
        __builtin_amdgcn_raw_buffer_store_b128(__builtin_bit_cast(u32x4, pack8(a, 0)), rO, vo16, 20480 + (vt * 2 + 0) * 1024, 0);
        __builtin_amdgcn_raw_buffer_store_b128(__builtin_bit_cast(u32x4, pack8(a, 1)), rO, vo16, 20480 + (vt * 2 + 1) * 1024, 0);
    }
    asm volatile("s_waitcnt lgkmcnt(0)" ::: "memory");
}
}

namespace rwb {
__device__ __forceinline__ f32x16 unpack16(u32x4 a, u32x4 b) {
    f32x16 x; x[0] = bflo(a.x); x[1] = bfhi(a.x); x[2] = bflo(a.y); x[3] = bfhi(a.y); x[4] = bflo(a.z); x[5] = bfhi(a.z); x[6] = bflo(a.w); x[7] = bfhi(a.w);
    x[8] = bflo(b.x); x[9] = bfhi(b.x); x[10] = bflo(b.y); x[11] = bfhi(b.y); x[12] = bflo(b.z); x[13] = bfhi(b.z); x[14] = bflo(b.w); x[15] = bfhi(b.w); return x;
}
struct Frags { u32x4 P[2][2][2]; u32x4 Q[2][2]; u32x4 R[2][2]; u32x4 Y[2]; };
__device__ __forceinline__ void load_frags_pr(Frags& F, __amdgpu_buffer_rsrc_t rb, unsigned vo16) {
#pragma unroll
    for (int kt = 0; kt < 2; ++kt)
#pragma unroll
        for (int kp = 0; kp < 2; ++kp) { F.P[kt][kp][0] = __builtin_amdgcn_raw_buffer_load_b128(rb, vo16, ((kt * 2 + kp) * 2 + 0) * 1024, 0); F.P[kt][kp][1] = __builtin_amdgcn_raw_buffer_load_b128(rb, vo16, ((kt * 2 + kp) * 2 + 1) * 1024, 0); }
#pragma unroll
    for (int kp = 0; kp < 2; ++kp) { F.R[kp][0] = __builtin_amdgcn_raw_buffer_load_b128(rb, vo16, 16384 + (kp * 2 + 0) * 1024, 0); F.R[kp][1] = __builtin_amdgcn_raw_buffer_load_b128(rb, vo16, 16384 + (kp * 2 + 1) * 1024, 0); }
}
template <int VT> __device__ __forceinline__ void load_frags_qy(Frags& F, __amdgpu_buffer_rsrc_t rb, unsigned vo16) {
#pragma unroll
    for (int kt = 0; kt < 2; ++kt) { F.Q[kt][0] = __builtin_amdgcn_raw_buffer_load_b128(rb, vo16, 8192 + ((kt * 2 + VT) * 2 + 0) * 1024, 0); F.Q[kt][1] = __builtin_amdgcn_raw_buffer_load_b128(rb, vo16, 8192 + ((kt * 2 + VT) * 2 + 1) * 1024, 0); }
    F.Y[0] = __builtin_amdgcn_raw_buffer_load_b128(rb, vo16, 20480 + (VT * 2 + 0) * 1024, 0); F.Y[1] = __builtin_amdgcn_raw_buffer_load_b128(rb, vo16, 20480 + (VT * 2 + 1) * 1024, 0);
}
__device__ __forceinline__ void group(const Args& A, int grp, unsigned char* ldsb) {
    const int tid = threadIdx.x, lane = tid & 63, wid = __builtin_amdgcn_readfirstlane(tid >> 6), n = lane & 31, hi = lane >> 5, ci = wid >> 1, vt = wid & 1;
    const int ch = grp * 4 + ci, b = ch >> 4, h = ch & 15, v = 32 * vt + n;
    bf16_t* Yo = (bf16_t*)(A.ws + WS_Y);
    LAS float* ex = (LAS float*)(LAS unsigned char*)ldsb;
    const float gnw = A.in[12][h * 64 + v], gnb = A.in[13][h * 64 + v], muv = A.in[4][2048 + h * 64 + v];
    const unsigned vo16 = (unsigned)lane * 16u;
    f32x16 H[2];
#pragma unroll
    for (int i = 0; i < 16; ++i) { H[0][i] = 0.f; H[1][i] = 0.f; }
    Frags cur, nxt;
    { const __amdgpu_buffer_rsrc_t rb0 = BUFR(rw_block(A, ch * RW_NCH), RW_TB); load_frags_pr(cur, rb0, vo16); if (vt) load_frags_qy<1>(cur, rb0, vo16); else load_frags_qy<0>(cur, rb0, vo16); }
    for (int c = 0; c < RW_NCH; ++c) {
        const int t0 = 32 * c;
        const __amdgpu_buffer_rsrc_t rbc = BUFR(rw_block(A, ch * RW_NCH + c) + 24576, 128);
        const __amdgpu_buffer_rsrc_t rbn = BUFR(rw_block(A, ch * RW_NCH + ((c + 1 < RW_NCH) ? c + 1 : c)), RW_TB);
        load_frags_pr(nxt, rbn, vo16);
        SBAR0;
        bf16x8 Hp[2][2];
        Hp[0][0] = pack8(H[0], 0); Hp[0][1] = pack8(H[0], 1); Hp[1][0] = pack8(H[1], 0); Hp[1][1] = pack8(H[1], 1);
        f32x16 Y = unpack16(cur.Y[0], cur.Y[1]);
#pragma unroll
        for (int kp = 0; kp < 2; ++kp)
#pragma unroll
            for (int s = 0; s < 2; ++s) Y = MFMA32(__builtin_bit_cast(bf16x8, cur.R[kp][s]), Hp[kp][s], Y);
#pragma unroll
        for (int kt = 0; kt < 2; ++kt) {
            f32x16 hn = unpack16(cur.Q[kt][0], cur.Q[kt][1]);
#pragma unroll
            for (int kp = 0; kp < 2; ++kp)
#pragma unroll
                for (int s = 0; s < 2; ++s) hn = MFMA32(__builtin_bit_cast(bf16x8, cur.P[kt][kp][s]), Hp[kp][s], hn);
            H[kt] = hn;
        }
        SBAR0;
        if (vt) load_frags_qy<1>(nxt, rbn, vo16); else load_frags_qy<0>(nxt, rbn, vo16);
        float vs[16], gt[16], bo[16];
        { const __amdgpu_buffer_rsrc_t rV = BUFR((const bf16_t*)(A.ws + WS_RKV) + ((size_t)b * LP + t0 - 1) * 3072 + 2048 + h * 64, 34 * 6144);
          const __amdgpu_buffer_rsrc_t rG = BUFR((const bf16_t*)(A.ws + WS_GR) + ((size_t)b * LP + t0) * 1024 + h * 64, 33 * 2048);
          const unsigned voV = (unsigned)(hi * 4 * 6144 + 2 * v), voG = (unsigned)(hi * 4 * 2048 + 2 * v), voB = (unsigned)(hi * 16);
          float cv[16], pv4[4];
#pragma unroll
          for (int r = 0; r < 16; ++r) { const int T0 = (r & 3) + 8 * (r >> 2); cv[r] = __uint_as_float((unsigned)__builtin_amdgcn_raw_buffer_load_b16(rV, voV, (T0 + 1) * 6144, 0) << 16);
              gt[r] = __uint_as_float((unsigned)__builtin_amdgcn_raw_buffer_load_b16(rG, voG, T0 * 2048, 0) << 16); bo[r] = __uint_as_float(__builtin_amdgcn_raw_buffer_load_b32(rbc, voB, 4 * T0, 0)); }
#pragma unroll
          for (int g = 0; g < 4; ++g) { pv4[g] = __uint_as_float((unsigned)__builtin_amdgcn_raw_buffer_load_b16(rV, voV, (8 * g) * 6144, 0) << 16); if (t0 + Tk(4 * g, hi) == 0) pv4[g] = 0.f; }
#pragma unroll
          for (int r = 0; r < 16; ++r) { const float pv = (r & 3) ? cv[r - 1] : pv4[r >> 2]; vs[r] = cv[r] + (pv - cv[r]) * muv; } }
        SBAR0;
        float s1[16], s2[16];
#pragma unroll
        for (int r = 0; r < 16; ++r) { s1[r] = sum32h(Y[r]); s2[r] = sum32h(Y[r] * Y[r]); }
        LAS float* exw = ex + ((c & 1) * 8 + wid) * 64; LAS float* exp_ = ex + ((c & 1) * 8 + (wid ^ 1)) * 64;
        if (n == 0) {
#pragma unroll
            for (int r = 0; r < 16; ++r) { exw[2 * Tk(r, hi)] = s1[r]; exw[2 * Tk(r, hi) + 1] = s2[r]; } }
        __syncthreads();
#pragma unroll
        for (int r = 0; r < 16; ++r) {
            const int T = Tk(r, hi), t = t0 + T;
            const f32x2 o2 = *(const LAS f32x2*)(exp_ + 2 * T);
            const float mean = (s1[r] + o2[0]) * (1.f / 64.f), var = fmaxf((s2[r] + o2[1]) * (1.f / 64.f) - mean * mean, 0.f);
            float o = (Y[r] - mean) * __builtin_amdgcn_rsqf(var + 64e-5f) * gnw + gnb + bo[r] * vs[r];
            const float g = gt[r]; o *= g * sigmoidf_(g);
            if (t >= NMETA && t < LSEQ) Yo[(size_t)(b * TS + t - NMETA) * DM + h * 64 + v] = (bf16_t)(pk2(o, 0.f) & 0xffffu);
        }
        cur = nxt;
    }
    __syncthreads();
}
}

namespace rwc {
using rwb::unpack16;
__device__ __forceinline__ void hrec(const Args& A, int grp) {
    const int tid = threadIdx.x, lane = tid & 63, wid = __builtin_amdgcn_readfirstlane(tid >> 6), ci = wid >> 1, vt = wid & 1;
    const int ch = grp * 4 + ci;
    const unsigned vo16 = (unsigned)lane * 16u;
    f32x16 H[2];
#pragma unroll
    for (int i = 0; i < 16; ++i) { H[0][i] = 0.f; H[1][i] = 0.f; }
    u32x4 cP[2][2][2], cQ[2][2], nP[2][2][2], nQ[2][2];
#define HREC_LOAD(P_, Q_, rb) do { \
        _Pragma("unroll") for (int kt = 0; kt < 2; ++kt) _Pragma("unroll") for (int kp = 0; kp < 2; ++kp) { P_[kt][kp][0] = __builtin_amdgcn_raw_buffer_load_b128(rb, vo16, ((kt * 2 + kp) * 2 + 0) * 1024, 0); P_[kt][kp][1] = __builtin_amdgcn_raw_buffer_load_b128(rb, vo16, ((kt * 2 + kp) * 2 + 1) * 1024, 0); } \
        _Pragma("unroll") for (int kt = 0; kt < 2; ++kt) { Q_[kt][0] = __builtin_amdgcn_raw_buffer_load_b128(rb, vo16, 8192 + ((kt * 2 + vt) * 2 + 0) * 1024, 0); Q_[kt][1] = __builtin_amdgcn_raw_buffer_load_b128(rb, vo16, 8192 + ((kt * 2 + vt) * 2 + 1) * 1024, 0); } } while (0)
    { const __amdgpu_buffer_rsrc_t rb0 = BUFR(rw_block(A, ch * RW_NCH), RW_TB); HREC_LOAD(cP, cQ, rb0); }
    for (int c = 0; c < RW_NCH; ++c) {
        const __amdgpu_buffer_rsrc_t rbc = BUFR(rw_block(A, ch * RW_NCH + c), RW_TB);
        const __amdgpu_buffer_rsrc_t rbn = BUFR(rw_block(A, ch * RW_NCH + ((c + 1 < RW_NCH) ? c + 1 : c)), RW_TB);
        HREC_LOAD(nP, nQ, rbn);
        bf16x8 Hp[2][2];
        Hp[0][0] = pack8(H[0], 0); Hp[0][1] = pack8(H[0], 1); Hp[1][0] = pack8(H[1], 0); Hp[1][1] = pack8(H[1], 1);
#pragma unroll
        for (int kt = 0; kt < 2; ++kt) {
            f32x16 hn = unpack16(cQ[kt][0], cQ[kt][1]);
#pragma unroll
            for (int kp = 0; kp < 2; ++kp)
#pragma unroll
                for (int s = 0; s < 2; ++s) hn = MFMA32(__builtin_bit_cast(bf16x8, cP[kt][kp][s]), Hp[kp][s], hn);
            H[kt] = hn;
        }
#pragma unroll
        for (int kp = 0; kp < 2; ++kp)
#pragma unroll
            for (int s = 0; s < 2; ++s) __builtin_amdgcn_raw_buffer_store_b128(__builtin_bit_cast(u32x4, Hp[kp][s]), rbc, vo16, 8192 + ((kp * 2 + vt) * 2 + s) * 1024, 0);
#pragma unroll
        for (int kt = 0; kt < 2; ++kt) { cQ[kt][0] = nQ[kt][0]; cQ[kt][1] = nQ[kt][1];
#pragma unroll
            for (int kp = 0; kp < 2; ++kp) { cP[kt][kp][0] = nP[kt][kp][0]; cP[kt][kp][1] = nP[kt][kp][1]; } }
    }
#undef HREC_LOAD
}

__device__ __forceinline__ void ytask(const Args& A, int task, int lane_) {
    int lane = lane_; asm volatile("" : "+v"(lane));
    const int n = lane & 31, hi = lane >> 5;
    const int ch = task / RW_NCH, c = task - ch * RW_NCH, b = ch >> 4, h = ch & 15, t0 = 32 * c;
    const __amdgpu_buffer_rsrc_t rb = BUFR(rw_block(A, task), RW_TB);
    const unsigned vo16 = (unsigned)lane * 16u;
    bf16_t* Yo = (bf16_t*)(A.ws + WS_Y);
    f32x16 Y[2];
    {
        u32x4 R[2][2], Hq[2][2][2], Yl[2][2];
#pragma unroll
        for (int kp = 0; kp < 2; ++kp)
#pragma unroll
            for (int s = 0; s < 2; ++s) { R[kp][s] = __builtin_amdgcn_raw_buffer_load_b128(rb, vo16, 16384 + (kp * 2 + s) * 1024, 0);
#pragma unroll
                for (int vt = 0; vt < 2; ++vt) Hq[kp][vt][s] = __builtin_amdgcn_raw_buffer_load_b128(rb, vo16, 8192 + ((kp * 2 + vt) * 2 + s) * 1024, 0); }
#pragma unroll
        for (int vt = 0; vt < 2; ++vt) { Yl[vt][0] = __builtin_amdgcn_raw_buffer_load_b128(rb, vo16, 20480 + (vt * 2 + 0) * 1024, 0); Yl[vt][1] = __builtin_amdgcn_raw_buffer_load_b128(rb, vo16, 20480 + (vt * 2 + 1) * 1024, 0); }
#pragma unroll
        for (int vt = 0; vt < 2; ++vt) {
            f32x16 y = unpack16(Yl[vt][0], Yl[vt][1]);
#pragma unroll
            for (int kp = 0; kp < 2; ++kp)
#pragma unroll
                for (int s = 0; s < 2; ++s) y = MFMA32(__builtin_bit_cast(bf16x8, R[kp][s]), __builtin_bit_cast(bf16x8, Hq[kp][vt][s]), y);
            Y[vt] = y;
        }
    }
    float vs[2][16], gt[2][16], bo[16];
    {
        const __amdgpu_buffer_rsrc_t rV = BUFR((const bf16_t*)(A.ws + WS_RKV) + ((size_t)b * LP + t0 - 1) * 3072 + 2048 + h * 64, 34 * 6144);
        const __amdgpu_buffer_rsrc_t rG = BUFR((const bf16_t*)(A.ws + WS_GR) + ((size_t)b * LP + t0) * 1024 + h * 64, 33 * 2048);
        const __amdgpu_buffer_rsrc_t rBn = BUFR(rw_block(A, task) + 24576, 128);
#pragma unroll
        for (int r = 0; r < 16; ++r) bo[r] = __uint_as_float(__builtin_amdgcn_raw_buffer_load_b32(rBn, (unsigned)(hi * 16), 4 * ((r & 3) + 8 * (r >> 2)), 0));
        const f32x2 muv = *(const f32x2*)(A.in[4] + 2048 + h * 64 + 2 * n);
        const unsigned voV = (unsigned)(hi * 4 * 6144 + 4 * n), voG = (unsigned)(hi * 4 * 2048 + 4 * n);
        unsigned cv[16], pv4[4];
#pragma unroll
        for (int r = 0; r < 16; ++r) { const int T0 = (r & 3) + 8 * (r >> 2); cv[r] = __builtin_amdgcn_raw_buffer_load_b32(rV, voV, (T0 + 1) * 6144, 0);
            const unsigned g2 = __builtin_amdgcn_raw_buffer_load_b32(rG, voG, T0 * 2048, 0); gt[0][r] = bflo(g2); gt[1][r] = bfhi(g2); }
#pragma unroll
        for (int g = 0; g < 4; ++g) pv4[g] = __builtin_amdgcn_raw_buffer_load_b32(rV, voV, (8 * g) * 6144, 0);
        asm volatile("" : "+v"(pv4[0]), "+v"(pv4[1]), "+v"(pv4[2]), "+v"(pv4[3]));
#pragma unroll
        for (int g = 0; g < 4; ++g) if (t0 + Tk(4 * g, hi) == 0) pv4[g] = 0u;
#pragma unroll
        for (int r = 0; r < 16; ++r) { const unsigned pv = (r & 3) ? cv[r - 1] : pv4[r >> 2]; const float c0 = bflo(cv[r]), c1 = bfhi(cv[r]), p0 = bflo(pv), p1 = bfhi(pv);
            vs[0][r] = c0 + (p0 - c0) * muv[0]; vs[1][r] = c1 + (p1 - c1) * muv[1]; }
    }
    __builtin_amdgcn_s_barrier();
    const f32x2 gnw = *(const f32x2*)(A.in[12] + h * 64 + 2 * n), gnb = *(const f32x2*)(A.in[13] + h * 64 + 2 * n);
#pragma unroll
    for (int r = 0; r < 16; ++r) {
        const int t = t0 + Tk(r, hi);
        const float y0 = Y[0][r], y1 = Y[1][r];
        const float mean = sum32h(y0 + y1) * (1.f / 64.f);
        const float d0 = y0 - mean, d1 = y1 - mean;
        const float var = sum32h(d0 * d0 + d1 * d1) * (1.f / 64.f);
        const float rs = __builtin_amdgcn_rsqf(var + 64e-5f);
        float o0 = d0 * rs * gnw[0] + gnb[0] + bo[r] * vs[0][r], o1 = d1 * rs * gnw[1] + gnb[1] + bo[r] * vs[1][r];
        o0 *= gt[0][r] * sigmoidf_(gt[0][r]); o1 *= gt[1][r] * sigmoidf_(gt[1][r]);
        if (t >= NMETA && t < LSEQ) *(unsigned*)(Yo + (size_t)(b * TS + t - NMETA) * DM + h * 64 + 2 * n) = pk2(o0, o1);
    }
    __builtin_amdgcn_s_barrier();
}
}

namespace att {
constexpr float THR = 8.f;
constexpr int O_K = 0, O_V = 32768, O_WSF = 69632, XP = 132;
__device__ __forceinline__ unsigned off_b(unsigned row, unsigned ch) { return 256u * row + 16u * (ch ^ (((row & 3u) << 2) | ((row >> 2) & 3u))); }

__device__ __forceinline__ void unit(const Args& A, int b, int h, int qb, float lam, unsigned char* ldsb) {
    const int tid = threadIdx.x, lane = tid & 63, wid = __builtin_amdgcn_readfirstlane(tid >> 6), r32 = lane & 31, hh = lane >> 5, qblk = wid >> 1, comp = wid & 1;
    const bf16_t* QD = (const bf16_t*)(A.ws + WS_QD); const bf16_t* KD = (const bf16_t*)(A.ws + WS_KD); const bf16_t* VD = (const bf16_t*)(A.ws + WS_VD); const bf16_t* GD = (const bf16_t*)(A.ws + WS_GD);
    bf16_t* Y = (bf16_t*)(A.ws + WS_Y);
    LAS unsigned char* lds3 = (LAS unsigned char*)ldsb;
    const int qpos0 = NMETA + 128 * qb + 32 * qblk, qpos = qpos0 + r32;
    const int NT = 2 * qb + 3, wlast = (qpos0 + 31) >> 6;
    bf16x8 qf[4];
    { const bf16_t* qp = QD + (size_t)(b * LP + qpos) * 1024 + h * 128 + comp * 64 + 8 * hh;
#pragma unroll
      for (int d0 = 0; d0 < 4; ++d0) qf[d0] = *(const bf16x8*)(qp + 16 * d0); }
    const int srow = tid >> 4, sch = tid & 15;
    const unsigned sdst0 = off_b(srow, sch), sdst1 = off_b(srow + 32, sch);
    const bf16_t* kg = KD + (size_t)(b * LP + srow) * 1024 + h * 128 + sch * 8; const bf16_t* vg = VD + (size_t)(b * LP + srow) * 1024 + h * 128 + sch * 8;
    u32x4 kA0, kA1, vA0, vA1, kB0, kB1, vB0, vB1;
#define ATT_LOAD(X, tl_) do { const size_t o_ = (size_t)(tl_) * 64 * 1024; k##X##0 = *(const u32x4*)(kg + o_); k##X##1 = *(const u32x4*)(kg + o_ + 32 * 1024); v##X##0 = *(const u32x4*)(vg + o_); v##X##1 = *(const u32x4*)(vg + o_ + 32 * 1024); } while (0)
#define ATT_STORE(X, buf) do { *(LAS u32x4*)(lds3 + O_K + (buf) * 16384 + sdst0) = k##X##0; *(LAS u32x4*)(lds3 + O_K + (buf) * 16384 + sdst1) = k##X##1; \
                               *(LAS u32x4*)(lds3 + O_V + (buf) * 16384 + sdst0) = v##X##0; *(LAS u32x4*)(lds3 + O_V + (buf) * 16384 + sdst1) = v##X##1; } while (0)
    const unsigned sw = ((r32 & 3) << 2) | ((r32 >> 2) & 3);
    const unsigned kx = (unsigned)(comp * 8 + hh) ^ sw;
    const unsigned kbase = 256u * r32;
    const unsigned q4 = (lane & 15) >> 2, p4 = lane & 3, blk = (lane >> 4) & 1, cb = 2 * blk + (p4 >> 1);
    float m = 0.f, lsum = 0.f;
    f32x16 NEGM;
#pragma unroll
    for (int i = 0; i < 16; ++i) NEGM[i] = 0.f;
    f32x16 O[4];
#pragma unroll
    for (int d = 0; d < 4; ++d)
#pragma unroll
        for (int i = 0; i < 16; ++i) O[d][i] = 0.f;
    LAS float* wsf = (LAS float*)(lds3 + O_WSF) + wid * 64;
    unsigned valo[4], vahi[4];
#pragma unroll
    for (int d = 0; d < 4; ++d) { valo[d] = 256u * (4 * hh + q4) + 16u * ((((unsigned)d ^ q4) << 2) | (cb ^ (unsigned)hh)) + 8u * (p4 & 1);
                                  vahi[d] = 256u * (8 + 4 * hh + q4) + 16u * ((((unsigned)d ^ q4) << 2) | (cb ^ (2u + (unsigned)hh))) + 8u * (p4 & 1); }
#define MAX3G(r_, a_, b_, c_) asm volatile("s_nop 15\n\tv_max3_f32 %0, %1, %2, %3" : "=v"(r_) : "v"(a_), "v"(b_), "v"(c_))
#define MAX3(r_, a_, b_, c_) asm("v_max3_f32 %0, %1, %2, %3" : "=v"(r_) : "v"(a_), "v"(b_), "v"(c_))
#define ATT_COMPUTE(tl_, cur_) do { const int tl = (tl_); \
            LAS unsigned char* Kb = lds3 + O_K + (cur_) * 16384; LAS unsigned char* Vb = lds3 + O_V + (cur_) * 16384; \
            f32x16 p0 = NEGM, p1 = NEGM; \
            _Pragma("unroll") for (int d0 = 0; d0 < 4; ++d0) { \
                const bf16x8 a0 = *(const LAS bf16x8*)(Kb + kbase + 16u * (kx ^ (2u * d0))); \
                const bf16x8 a1 = *(const LAS bf16x8*)(Kb + 8192 + kbase + 16u * (kx ^ (2u * d0))); \
                p0 = __builtin_amdgcn_mfma_f32_32x32x16_bf16(a0, qf[d0], p0, 0, 0, 0); \
                p1 = __builtin_amdgcn_mfma_f32_32x32x16_bf16(a1, qf[d0], p1, 0, 0, 0); } \
            if (64 * tl + 63 > qpos0) { \
                _Pragma("unroll") for (int r = 0; r < 16; ++r) { const int kp = 64 * tl + (r & 3) + 8 * (r >> 2) + 4 * hh; if (kp > qpos) p0[r] = -INFINITY; if (kp + 32 > qpos) p1[r] = -INFINITY; } } \
            float rm, rm2; MAX3G(rm, p0[0], p1[0], p0[1]); MAX3(rm2, rm, p1[1], p0[2]); MAX3(rm, rm, p1[2], p0[3]); \
            MAX3(rm2, rm2, p1[3], p0[4]); MAX3(rm, rm, p1[4], p0[5]); MAX3(rm2, rm2, p1[5], p0[6]); MAX3(rm, rm, p1[6], p0[7]); \
            MAX3(rm2, rm2, p1[7], p0[8]); MAX3(rm, rm, p1[8], p0[9]); MAX3(rm2, rm2, p1[9], p0[10]); MAX3(rm, rm, p1[10], p0[11]); \
            MAX3(rm2, rm2, p1[11], p0[12]); MAX3(rm, rm, p1[12], p0[13]); MAX3(rm2, rm2, p1[13], p0[14]); MAX3(rm, rm, p1[14], p0[15]); \
            MAX3(rm, rm, rm2, p1[15]); \
            rm = swap32_max(rm); \
            if (tl == 0 || __any(rm > THR)) {            \
                const float dm = (tl == 0) ? rm : fmaxf(rm, 0.f), alpha = (tl == 0) ? 1.f : __builtin_amdgcn_exp2f(-dm);        \
                lsum *= alpha; m += dm; \
                if (hh == 0) wsf[r32] = alpha; \
                asm volatile("s_waitcnt lgkmcnt(0)" ::: "memory"); \
                _Pragma("unroll") for (int g = 0; g < 4; ++g) { const f32x4 a4 = *(const LAS f32x4*)(wsf + 8 * g + 4 * hh); \
                    _Pragma("unroll") for (int d = 0; d < 4; ++d) { O[d][4 * g] *= a4[0]; O[d][4 * g + 1] *= a4[1]; O[d][4 * g + 2] *= a4[2]; O[d][4 * g + 3] *= a4[3]; } } \
                _Pragma("unroll") for (int r = 0; r < 16; ++r) { p0[r] -= dm; p1[r] -= dm; NEGM[r] = -m; } \
            } \
            float ps0 = 0.f, ps1 = 0.f; \
            _Pragma("unroll") for (int r = 0; r < 16; ++r) { p0[r] = __builtin_amdgcn_exp2f(p0[r]); p1[r] = __builtin_amdgcn_exp2f(p1[r]); ps0 += p0[r]; ps1 += p1[r]; } \
            lsum += ps0 + ps1; \
            bf16x8 pw[4]; \
            pw[0] = __builtin_bit_cast(bf16x8, (u32x4){pk2(p0[0], p0[1]), pk2(p0[2], p0[3]), pk2(p0[4], p0[5]), pk2(p0[6], p0[7])}); \
            pw[1] = __builtin_bit_cast(bf16x8, (u32x4){pk2(p0[8], p0[9]), pk2(p0[10], p0[11]), pk2(p0[12], p0[13]), pk2(p0[14], p0[15])}); \
            pw[2] = __builtin_bit_cast(bf16x8, (u32x4){pk2(p1[0], p1[1]), pk2(p1[2], p1[3]), pk2(p1[4], p1[5]), pk2(p1[6], p1[7])}); \
            pw[3] = __builtin_bit_cast(bf16x8, (u32x4){pk2(p1[8], p1[9]), pk2(p1[10], p1[11]), pk2(p1[12], p1[13]), pk2(p1[14], p1[15])}); \
            _Pragma("unroll") for (int s = 0; s < 4; ++s) \
                _Pragma("unroll") for (int d = 0; d < 4; ++d) { \
                    const s16x4 lo = __builtin_amdgcn_ds_read_tr16_b64_v4i16((LAS s16x4*)(Vb + 4096 * s + valo[d])); \
                    const s16x4 hi = __builtin_amdgcn_ds_read_tr16_b64_v4i16((LAS s16x4*)(Vb + 4096 * s + vahi[d])); \
                    const bf16x8 vf = {lo[0], lo[1], lo[2], lo[3], hi[0], hi[1], hi[2], hi[3]}; \
                    O[d] = __builtin_amdgcn_mfma_f32_32x32x16_bf16(pw[s], vf, O[d], 0, 0, 0); } \
        } while (0)

    ATT_LOAD(A, 0); ATT_STORE(A, 0);
    __syncthreads();
    if (NT > 1) ATT_LOAD(A, 1);
    for (int t2 = 0; t2 < NT; t2 += 2) {
        if (t2 + 2 < NT) ATT_LOAD(B, t2 + 2);
        if (t2 <= wlast) ATT_COMPUTE(t2, 0);
        if (t2 + 1 < NT) ATT_STORE(A, 1);
        __syncthreads();
        if (t2 + 1 >= NT) break;
        if (t2 + 3 < NT) ATT_LOAD(A, t2 + 3);
        if (t2 + 1 <= wlast) ATT_COMPUTE(t2 + 1, 1);
        if (t2 + 2 < NT) ATT_STORE(B, 0);
        __syncthreads();
    }
#undef ATT_COMPUTE
#undef MAX3
#undef MAX3G
#undef ATT_LOAD
#undef ATT_STORE
    const float lt = swap32_sum(lsum);
    const float sc = (comp ? lam : 1.f) / lt;
    if (hh == 0) wsf[r32] = sc;
    asm volatile("s_waitcnt lgkmcnt(0)" ::: "memory");
    LAS float* X = (LAS float*)lds3 + qblk * (32 * XP);
    if (comp == 1) {
#pragma unroll
        for (int g = 0; g < 4; ++g) { const f32x4 s4 = *(const LAS f32x4*)(wsf + 8 * g + 4 * hh);
#pragma unroll
            for (int i = 0; i < 4; ++i)
#pragma unroll
                for (int d = 0; d < 4; ++d) X[(8 * g + 4 * hh + i) * XP + 32 * d + r32] = O[d][4 * g + i] * s4[i]; }
    }
    __syncthreads();
    if (comp == 0) {
#pragma unroll
        for (int g = 0; g < 4; ++g) { const f32x4 s4 = *(const LAS f32x4*)(wsf + 8 * g + 4 * hh);
#pragma unroll
            for (int i = 0; i < 4; ++i)
#pragma unroll
                for (int d = 0; d < 4; ++d) { LAS float* xp = X + (8 * g + 4 * hh + i) * XP + 32 * d + r32; *xp = O[d][4 * g + i] * s4[i] - *xp; } }
        asm volatile("s_waitcnt lgkmcnt(0)" ::: "memory");
        const LAS float* xr = X + r32 * XP + 64 * hh;
        f32x4 dv[16]; float ss = 0.f;
#pragma unroll
        for (int i = 0; i < 16; ++i) { dv[i] = *(const LAS f32x4*)(xr + 4 * i); ss += (dv[i][0] * dv[i][0] + dv[i][1] * dv[i][1]) + (dv[i][2] * dv[i][2] + dv[i][3] * dv[i][3]); }
        ss = swap32_sum(ss);
        const float rms = __builtin_amdgcn_rsqf(ss * (1.f / 128.f) + 1e-5f) * 0.8f;
        const bf16_t* gp = GD + (size_t)(b * LP + qpos) * 1024 + h * 128 + 64 * hh; const float* sw_ = A.in[18] + 64 * hh;
        bf16_t* yp = Y + (size_t)(b * TS + qpos - NMETA) * DM + 1024 + h * 128 + 64 * hh;
#pragma unroll
        for (int c8 = 0; c8 < 8; ++c8) {
            const u32x4 gv = *(const u32x4*)(gp + 8 * c8); const f32x4 w0 = *(const f32x4*)(sw_ + 8 * c8), w1 = *(const f32x4*)(sw_ + 8 * c8 + 4);
            const float g0 = bflo(gv.x), g1 = bfhi(gv.x), g2 = bflo(gv.y), g3 = bfhi(gv.y), g4 = bflo(gv.z), g5 = bfhi(gv.z), g6 = bflo(gv.w), g7 = bfhi(gv.w);
            const f32x4 d0 = dv[2 * c8], d1 = dv[2 * c8 + 1];
            u32x4 o;
            o.x = pk2(d0[0] * rms * w0[0] * g0 * sigmoidf_(g0), d0[1] * rms * w0[1] * g1 * sigmoidf_(g1));
            o.y = pk2(d0[2] * rms * w0[2] * g2 * sigmoidf_(g2), d0[3] * rms * w0[3] * g3 * sigmoidf_(g3));
            o.z = pk2(d1[0] * rms * w1[0] * g4 * sigmoidf_(g4), d1[1] * rms * w1[1] * g5 * sigmoidf_(g5));
            o.w = pk2(d1[2] * rms * w1[2] * g6 * sigmoidf_(g6), d1[3] * rms * w1[3] * g7 * sigmoidf_(g7));
            *(u32x4*)(yp + 8 * c8) = o;
        }
    }
    __syncthreads();
}
}

#define XB_TMO      128
#define XB_XCNT(j)  (256  + 64 * (j))
#define XB_XSUB(j)  (1280 + 64 * (j))
#define XB_XGEN(j)  (2304 + 64 * (j))
#define XB_TOP      3328
#define XB_TOPGEN   3392
#define XCD_BAR_WORDS 3456
#define XB_SPIN_CAP (1u << 18)

__device__ __forceinline__ unsigned xb_ld(unsigned* p)              { return __hip_atomic_load(p, __ATOMIC_RELAXED, __HIP_MEMORY_SCOPE_AGENT); }
__device__ __forceinline__ unsigned xb_add(unsigned* p, unsigned v) { return __hip_atomic_fetch_add(p, v, __ATOMIC_RELAXED, __HIP_MEMORY_SCOPE_AGENT); }
__device__ __forceinline__ unsigned xb_xcc_id() { return (unsigned)__builtin_amdgcn_s_getreg((3 << 11) | 20) & 0xFu; }
#define XB_SPIN(cond, bar) do { unsigned _sp = 0; while (cond) { __builtin_amdgcn_s_sleep(1); \
    if ((++_sp & 255u) == 0u) { if (xb_ld(&(bar)[XB_TMO])) break; if (_sp > XB_SPIN_CAP) { atomicAdd(&(bar)[XB_TMO], 1u); break; } } } } while (0)

struct XcdBarrier {
    unsigned* bar; unsigned x;
    volatile LAS unsigned* st;
};

__device__ __forceinline__ XcdBarrier xcd_barrier_post(unsigned* bar, volatile LAS unsigned* st) {
    XcdBarrier b; b.bar = bar; b.x = xb_xcc_id(); b.st = st;
    if (threadIdx.x == 0) (void)xb_add(&bar[XB_XCNT(b.x)], 1u);
    return b;
}
__device__ __forceinline__ void xcd_barrier_complete(unsigned* bar, unsigned x, unsigned& nloc, unsigned& nx) {
    const unsigned G = gridDim.x * gridDim.y * gridDim.z;
    unsigned sum, cnt, mine, sp = 0u;
    for (;;) {
        sum = 0u; cnt = 0u; mine = 0u;
#pragma unroll
        for (unsigned j = 0; j < 16; ++j) { const unsigned c = xb_ld(&bar[XB_XCNT(j)]); sum += c; cnt += (c > 0u) ? 1u : 0u; mine = (j == x) ? c : mine; }
        if (sum == G) break;
        __builtin_amdgcn_s_sleep(1);
        if ((++sp & 255u) == 0u) { if (xb_ld(&bar[XB_TMO])) break; if (sp > XB_SPIN_CAP) { atomicAdd(&bar[XB_TMO], 1u); break; } }
    }
    nloc = mine > 0u ? mine : 1u; nx = cnt > 0u ? cnt : 1u;
}

__device__ __forceinline__ void xcd_barrier(const XcdBarrier& b) {
    asm volatile("s_waitcnt vmcnt(0)" ::: "memory");
    __syncthreads();
    if (threadIdx.x == 0) {
        unsigned* bar = b.bar;
        __builtin_amdgcn_s_waitcnt(0);
        unsigned nloc = b.st[0], nx = b.st[1];
        if (nloc == 0u) { xcd_barrier_complete(bar, b.x, nloc, nx); b.st[0] = nloc; b.st[1] = nx; }
        const unsigned old = xb_add(&bar[XB_XSUB(b.x)], 1u);
        const unsigned gen = old / nloc;
        if (old + 1u == (gen + 1u) * nloc) {
            __builtin_amdgcn_fence(__ATOMIC_RELEASE, "agent");
            asm volatile("s_waitcnt vmcnt(0)" ::: "memory");
            const unsigned og = xb_add(&bar[XB_TOP], 1u);
            const unsigned tg = og / nx;
            if (og + 1u == (tg + 1u) * nx) xb_add(&bar[XB_TOPGEN], 1u);
            else XB_SPIN(xb_ld(&bar[XB_TOPGEN]) == tg, bar);
            __builtin_amdgcn_fence(__ATOMIC_ACQUIRE, "agent");
            xb_add(&bar[XB_XGEN(b.x)], 1u);
            asm volatile("s_waitcnt vmcnt(0)" ::: "memory");
        } else {
            XB_SPIN(xb_ld(&bar[XB_XGEN(b.x)]) == gen, bar);
            __builtin_amdgcn_fence(__ATOMIC_ACQUIRE, "agent");
            asm volatile("s_waitcnt vmcnt(0)" ::: "memory");
        }
    }
    __syncthreads();
}


__global__ void __launch_bounds__(512, 2) hymba_fwd(Args A) {
    extern __shared__ __attribute__((aligned(16))) unsigned char lds[];
    const int tid = threadIdx.x, lane = tid & 63, wave = __builtin_amdgcn_readfirstlane(tid >> 6);
    const int G = gridDim.x, bx = blockIdx.x;
    const int lo = A.ph_lo, hi = A.ph_hi;
    unsigned char* ws = A.ws;
    bf16_t* W1T = (bf16_t*)(ws + WS_W1T); bf16_t* W2T = (bf16_t*)(ws + WS_W2T); bf16_t* XN = (bf16_t*)(ws + WS_XN);
    float* ROPE = (float*)(ws + WS_ROPE); float* SSQ = (float*)(ws + WS_SSQ);
#define IN_PH(k) (lo <= (k) && (k) < hi)
    volatile LAS unsigned* bst = (volatile LAS unsigned*)((LAS unsigned char*)lds + LDS_BARW);
    if (tid < 2) bst[tid] = 0u;
    __syncthreads();
    XcdBarrier gbar; gbar.bar = (unsigned*)(ws + WS_CTL) + CW_BAR; gbar.x = 0; gbar.st = nullptr;
    if (A.coop) gbar = xcd_barrier_post((unsigned*)(ws + WS_CTL) + CW_BAR, bst);
#define GRID_SYNC(k) do { if (A.coop && IN_PH(k) && IN_PH((k) + 1)) { xcd_barrier(gbar); } } while (0)

    if (IN_PH(0)) {
        const int gw = bx * 8 + wave, NGW = G * 8;
        LAS float* scr = (LAS float*)((LAS unsigned char*)lds + wave * 17408);
        constexpr int I_1 = P0_I1, I_2 = P0_I2;
        if (gw < I_1 + I_2) {
            f32x4 cur[16]; p0_ld(cur, A, gw, lane);
            for (int it = gw; it < I_1 + I_2; it += NGW) {
                f32x4 nxt[16]; { const int nx = it + NGW; p0_ld(nxt, A, nx < I_1 + I_2 ? nx : it, lane); }
                p0_emit(cur, W1T, W2T, scr, it, lane);
#pragma unroll
                for (int i = 0; i < 16; ++i) cur[i] = nxt[i];
            }
        }
        for (int e = bx * 512 + tid; e < 128 * 2048 / 8; e += G * 512) *(u32x4*)(W1T + (size_t)8320 * 2048 + (size_t)e * 8) = (u32x4){0u, 0u, 0u, 0u};
        { const f32x4* wv = (const f32x4*)A.in[2] + lane; f32x4 pw[8];
#pragma unroll
          for (int j = 0; j < 8; ++j) pw[j] = wv[64 * j];
          constexpr int NREAL = MR + NMETA;
#define XN_SRC(row) ((const f32x4*)(((row) < MR) ? A.in[0] + (size_t)(row) * DM : A.in[1] + (size_t)((row) - MR) * DM) + lane)
          f32x4 v[8];
          { const f32x4* xr = XN_SRC(gw);
#pragma unroll
            for (int j = 0; j < 8; ++j) v[j] = __builtin_nontemporal_load(xr + 64 * j); }
          for (int mrow = gw; mrow < NREAL; mrow += NGW) {
              f32x4 nv[8]; { const int nx = mrow + NGW; const int nr = nx < NREAL ? nx : mrow; const f32x4* xr = XN_SRC(nr);
#pragma unroll
                for (int j = 0; j < 8; ++j) nv[j] = __builtin_nontemporal_load(xr + 64 * j); }
              unsigned long long* o8 = (unsigned long long*)(XN + (size_t)mrow * DM) + lane;
              float s = 0.f;
#pragma unroll
              for (int j = 0; j < 8; ++j) s += (v[j][0] * v[j][0] + v[j][1] * v[j][1]) + (v[j][2] * v[j][2] + v[j][3] * v[j][3]);
              const float rstd = __builtin_amdgcn_rsqf(wave_sum(s) * (1.f / DM) + 1e-6f);
#pragma unroll
              for (int j = 0; j < 8; ++j) { const f32x4 y = v[j] * rstd * pw[j]; o8[64 * j] = (unsigned long long)pk2(y[0], y[1]) | ((unsigned long long)pk2(y[2], y[3]) << 32); }
#pragma unroll
              for (int j = 0; j < 8; ++j) v[j] = nv[j];
          }
#undef XN_SRC
          for (int mrow = NREAL + gw; mrow < MP; mrow += NGW) {
              unsigned long long* o8 = (unsigned long long*)(XN + (size_t)mrow * DM) + lane;
#pragma unroll
              for (int j = 0; j < 8; ++j) o8[64 * j] = 0ull;
          } }
        for (int e = bx * 512 + tid; e < LSEQ * 32; e += G * 512) {
            const int pos = e >> 5, i = e & 31; const double rev = (double)pos * (double)A.inv_freq[i] * 0.15915494309189535; const float f = (float)(rev - floor(rev));
            ROPE[2 * e] = __builtin_amdgcn_cosf(f); ROPE[2 * e + 1] = __builtin_amdgcn_sinf(f); }
        { u32x4* LF = (u32x4*)(ws + WS_LF);
          for (int e = bx * 512 + tid; e < 16 * 2 * 2 * 4 * 64; e += G * 512) {
              const int l = e & 63, s_ = (e >> 6) & 3, nb = (e >> 8) & 1, mat = (e >> 9) & 1, hd = e >> 10; const float* up = mat ? A.in[8] : A.in[6];
              const float* p = up + (size_t)(16 * s_ + 8 * (l >> 5)) * 1024 + hd * 64 + 2 * (l & 31) + nb;
              LF[e] = (u32x4){pk2(p[0], p[1024]), pk2(p[2048], p[3072]), pk2(p[4096], p[5120]), pk2(p[6144], p[7168])}; } }
        { bf16_t* KD = (bf16_t*)(ws + WS_KD); bf16_t* VD = (bf16_t*)(ws + WS_VD); constexpr int PADC = (LP - LSEQ) * 1024 / 8;
          for (int e = bx * 512 + tid; e < NB * PADC * 2; e += G * 512) { const int which = e / (NB * PADC), r = e % (NB * PADC), b = r / PADC, c = r % PADC;
              *(u32x4*)((which ? VD : KD) + (size_t)(b * LP + LSEQ) * 1024 + (size_t)c * 8) = (u32x4){0u, 0u, 0u, 0u}; } }
    }
    GRID_SYNC(0);

    if (IN_PH(1)) {
        pg8::Gemm g{XN, W1T, MP, N1, DM}; pg8::StaticOrder S; S.init(MP, N1, G, bx);
        EpiProj E{(bf16_t*)(ws + WS_RKV), (bf16_t*)(ws + WS_GR), (bf16_t*)(ws + WS_WA), (bf16_t*)(ws + WS_QD), (bf16_t*)(ws + WS_KD), (bf16_t*)(ws + WS_VD), (bf16_t*)(ws + WS_GD), ROPE};
        pg8::gemm_phase<EpiProj, pg8::StaticOrder, true, true>((PG8_LAS unsigned char*)lds, g, S, E);
    }
    GRID_SYNC(1);

    if (IN_PH(2)) {
        const int gw = bx * 8 + wave, NGW = G * 8;
        LAS unsigned char* wl = (LAS unsigned char*)lds + wave * 18432;
        const int full_ = RW_TASKS / NGW;
        for (int it_ = 0; it_ < full_; ++it_) { rwa::task(A, gw + it_ * NGW, wl, lane); __builtin_amdgcn_s_barrier(); }
        {
            const int left_ = RW_TASKS - full_ * NGW;
            for (int base_ = 0; base_ < left_; base_ += G) {
                const int t_ = full_ * NGW + base_ + bx;
                if (wave == 0 && base_ + bx < left_) rwa::task(A, t_, wl, lane);
                else { __builtin_amdgcn_s_barrier(); __builtin_amdgcn_s_barrier(); __builtin_amdgcn_s_barrier(); __builtin_amdgcn_s_barrier(); }
                __builtin_amdgcn_s_barrier();
            }
        }
    }
    GRID_SYNC(2);

    if (IN_PH(3)) {
        float lam;
        { const float a = A.in[14][lane] * A.in[15][lane], c = A.in[16][lane] * A.in[17][lane];
          lam = fexp(wave_sum(a)) - fexp(wave_sum(c)) + 0.2f; }
        unsigned* qctr = (unsigned*)(ws + WS_CTL);
        volatile LAS int* qw = (volatile LAS int*)((LAS unsigned char*)lds + LDS_QW);
        constexpr int NRG = 32, NITEMS = NRG + 1024;
#define Q_FETCH(dst) do { __syncthreads(); if (tid == 0) *qw = (int)atomicAdd(qctr, 1u); __syncthreads(); dst = *qw; } while (0)
        int item; Q_FETCH(item);
        while (item < NRG) { rwc::hrec(A, item); Q_FETCH(item); }
        while (item < NITEMS) { const int a = item - NRG, qb = 15 - (a >> 6), bh = a & 63; att::unit(A, bh >> 3, bh & 7, qb, lam, lds); Q_FETCH(item); }
#undef Q_FETCH
    }
    GRID_SYNC(3);

    if (IN_PH(4)) {
        const int gw = bx * 8 + wave, NGW = G * 8;
        const int full_ = RW_TASKS / NGW;
        for (int it_ = 0; it_ < full_; ++it_) rwc::ytask(A, gw + it_ * NGW, lane);
        { const int left_ = RW_TASKS - full_ * NGW;
          for (int base_ = 0; base_ < left_; base_ += G) {
              if (wave == 0 && base_ + bx < left_) rwc::ytask(A, full_ * NGW + base_ + bx, lane);
              else { __builtin_amdgcn_s_barrier(); __builtin_amdgcn_s_barrier(); }
          } }
    }
    GRID_SYNC(4);

    if (IN_PH(5)) {
        pg8::Gemm g{(const bf16_t*)(ws + WS_Y), W2T, MR, DM, DM}; pg8::StaticOrder S; S.init(MR, DM, G, bx);
        EpiY E{XN  , SSQ};
        pg8::gemm_phase<EpiY, pg8::StaticOrder, true, true>((PG8_LAS unsigned char*)lds, g, S, E);
    }
    GRID_SYNC(5);

    if (IN_PH(6)) {
        const int gw = bx * 8 + wave, NGW = G * 8;
        const f32x4* wv = (const f32x4*)A.in[20] + lane; f32x4 pw[8];
#pragma unroll
        for (int j = 0; j < 8; ++j) pw[j] = wv[64 * j];
        const bf16_t* YO = XN;
        u32x2 yv[8];
        { const u32x2* yr = (const u32x2*)(YO + (size_t)gw * DM) + lane;
#pragma unroll
          for (int j = 0; j < 8; ++j) yv[j] = yr[64 * j]; }
        for (int row = gw; row < MR; row += NGW) {
            const f32x4* xr = (const f32x4*)(A.in[0] + (size_t)row * DM) + lane;
            f32x4 xv[8];
#pragma unroll
            for (int j = 0; j < 8; ++j) xv[j] = __builtin_nontemporal_load(xr + 64 * j);
            u32x2 nyv[8];
            { const int nx = row + NGW; const u32x2* yr = (const u32x2*)(YO + (size_t)(nx < MR ? nx : row) * DM) + lane;
#pragma unroll
              for (int j = 0; j < 8; ++j) nyv[j] = yr[64 * j]; }
            float ssq = 0.f;
#pragma unroll
            for (int j = 0; j < 8; ++j) { const float e0 = bflo(yv[j].x), e1 = bfhi(yv[j].x), e2 = bflo(yv[j].y), e3 = bfhi(yv[j].y); ssq += (e0 * e0 + e1 * e1) + (e2 * e2 + e3 * e3); }
            const float rstd = __builtin_amdgcn_rsqf(wave_sum(ssq) * (1.f / DM) + 1e-6f);
            f32x4* orow = (f32x4*)(A.out + (size_t)row * DM) + lane;
#pragma unroll
            for (int j = 0; j < 8; ++j) { const f32x4 y = {bflo(yv[j].x), bfhi(yv[j].x), bflo(yv[j].y), bfhi(yv[j].y)};
                orow[64 * j] = xv[j] + y * rstd * pw[j]; }
#pragma unroll
            for (int j = 0; j < 8; ++j) yv[j] = nyv[j];
        }
    }
#undef IN_PH
#undef GRID_SYNC
}

extern "C" void kernel_launch(void* const* d_in, const int* in_sizes, int n_in, void* d_out, int out_size, void* d_ws, size_t ws_size, hipStream_t stream) {
    static int grid = 0;
    if (grid == 0) {
        if (n_in != 21 || in_sizes[0] != MR * DM || out_size != MR * DM || ws_size < WS_END) { fprintf(stderr, "kernel_launch: unexpected shapes (n_in %d, in0 %d, out %d, ws %zu); nothing launched\n", n_in, n_in > 0 ? in_sizes[0] : -1, out_size, ws_size); grid = -1; return; }
        int dev = 0, cus = 0, per_cu = 0;
        if (hipGetDevice(&dev) != hipSuccess || hipDeviceGetAttribute(&cus, hipDeviceAttributeMultiprocessorCount, dev) != hipSuccess) { grid = -1; return; }
        if (hipFuncSetAttribute((const void*)hymba_fwd, hipFuncAttributeMaxDynamicSharedMemorySize, LDS_BYTES) != hipSuccess) { fprintf(stderr, "kernel_launch: hipFuncSetAttribute failed\n"); grid = -1; return; }
        if (hipOccupancyMaxActiveBlocksPerMultiprocessor(&per_cu, (const void*)hymba_fwd, 512, LDS_BYTES) != hipSuccess || per_cu < 1) { fprintf(stderr, "kernel_launch: occupancy query reports %d\n", per_cu); per_cu = 1; }
        (void)hipGetLastError();
        grid = cus;
    }
    if (grid < 0) return;
    (void)hipMemsetAsync((char*)d_ws + WS_CTL, 0, CTL_ZERO_BYTES, stream);
    Args a{};
    for (int i = 0; i < 21; ++i) a.in[i] = (const float*)d_in[i];
    a.out = (float*)d_out; a.ws = (unsigned char*)d_ws;
    for (int i = 0; i < 32; ++i) a.inv_freq[i] = (float)pow(10000.0, -(double)(2 * i) / 64.0);
#if MK_N_LAUNCHES == 1
    a.ph_lo = 0; a.ph_hi = NPH; a.coop = 1;
    void* kargs[] = {&a};
    (void)kargs;
    hipLaunchKernelGGL(hymba_fwd, dim3(grid), dim3(512), LDS_BYTES, stream, a);
#else
    for (int p = 0; p < NPH; ++p) { a.ph_lo = p; a.ph_hi = p + 1; a.coop = 0; hipLaunchKernelGGL(hymba_fwd, dim3(grid), dim3(512), LDS_BYTES, stream, a); }
#endif
}
```

```cpp
#include <hip/hip_runtime.h>
#include <hip/hip_cooperative_groups.h>
#include <cstdio>
#include <cstdint>
#include <cmath>
namespace cg = cooperative_groups;

#ifndef REP_PH
#define REP_PH -1
#endif
#ifndef MK_N_LAUNCHES
#define MK_N_LAUNCHES 1
#endif

constexpr int NB = 8, TS = 2048, NMETA = 16, LSEQ = TS + NMETA, LP = 2112, DM = 2048;
constexpr int MR = NB * TS;
constexpr int MP = 16640;
constexpr int N1 = 8448;
constexpr int NIN = 8320;
constexpr int NPH = 7;

namespace pg8 {
#define PG8_LAS __attribute__((address_space(3)))
typedef unsigned short bf16_t;
typedef short bf16x8 __attribute__((ext_vector_type(8)));
typedef float f32x4 __attribute__((ext_vector_type(4)));
typedef unsigned u32x4 __attribute__((ext_vector_type(4)));
constexpr int BM = 256, BK = 64, HALF = 128, HTB = HALF * BK * 2, STAGE_BYTES = 8 * HTB, NXCD = 8, WGM = 8;

__host__ __device__ __forceinline__ int lds_byte(int r, int c) { const int st = (r >> 4) * 2 + (c >> 5), rr = r & 15, cc = c & 31, ob = rr * 64 + cc * 2; return st * 1024 + (ob ^ (((ob >> 9) & 1) << 5)); }
__host__ __device__ __forceinline__ void stage_rc(int b, int& R, int& C) { const int st = b / 1024, sb = b % 1024, swz = sb ^ (((sb >> 9) & 1) << 5); R = (st >> 1) * 16 + swz / 64; C = (st & 1) * 32 + (swz % 64) / 2; }
__host__ __device__ __forceinline__ int perm32(int rho) { const int n = rho >> 4, i = rho & 15; return 8 * (i >> 2) + 4 * n + (i & 3); }

struct Unit { int pm, pn; };
struct Gemm { const bf16_t* A; const bf16_t* Bt; int M, N, K; };

struct StaticOrder {
    int nM, nN, nwg, G, c;
    __host__ __device__ void init(int M, int N, int G_, int c_) { nM = M / BM; nN = N / BM; nwg = nM * nN; G = G_; c = c_; }
    __host__ __device__ bool next(int i, Unit& u) const {
        const long L = (long)i * G + c; if (L >= nwg) return false;
        int wgid = (int)L; { const int q = nwg / NXCD, r = nwg % NXCD, xcd = wgid % NXCD, off = wgid / NXCD; wgid = (xcd < r ? xcd * (q + 1) : r * (q + 1) + (xcd - r) * q) + off; }
        const int nig = WGM * nN, gid = wgid / nig, fm = gid * WGM, gsz = (nM - fm) < WGM ? (nM - fm) : WGM;
        u.pm = fm + ((wgid % nig) % gsz); u.pn = (wgid % nig) / gsz; return true;
    }
    __device__ __forceinline__ void a_ready(const Unit&) const {}
    __device__ __forceinline__ void done(const Unit&) const {}
};

__device__ __forceinline__ unsigned cvt_pk_bf16(float lo, float hi) { unsigned r; asm volatile("v_cvt_pk_bf16_f32 %0, %1, %2" : "=v"(r) : "v"(lo), "v"(hi)); return r; }

template <class Epi, class Sched, bool ALIGN_EPI = false, bool SP2 = false>
__device__ __forceinline__ void gemm_phase(PG8_LAS unsigned char* lds, const Gemm g, const Sched& S, const Epi& E) {
    const int tid = threadIdx.x, wid = __builtin_amdgcn_readfirstlane(tid >> 6), lane = tid & 63, wr = wid >> 2, wc = wid & 3, fr = lane & 15, fq = lane >> 4;
    const int K = g.K, nt = K / BK;
    unsigned voffA[2], voffB[2];
#pragma unroll
    for (int i = 0; i < 2; ++i) { int R, C; stage_rc(tid * 16 + i * 8192, R, C); const int Rb = Epi::PERM ? ((R & ~31) + perm32(R & 31)) : R;
        voffA[i] = (unsigned)(R * K + C) * 2u; voffB[i] = (unsigned)(Rb * K + C) * 2u; }
    const size_t kstep = (size_t)(BK * 2);
    const size_t hstep = (size_t)HALF * K * 2;
    const size_t tstep = 2 * hstep;
    const unsigned ldsw = (unsigned)wid * 1024u;
    const int aoff = lds_byte(wr * 64 + fr, fq * 8), boff = lds_byte(wc * 32 + fr, fq * 8);
#define PG8_SA(b, h) (((b) * 2 + (h)) * HTB)
#define PG8_SB(b, h) ((4 + (b) * 2 + (h)) * HTB)
#define PG8_STAGE(bufoff, gbase, voff) do { _Pragma("unroll") for (int _i = 0; _i < 2; ++_i) \
        __builtin_amdgcn_global_load_lds((const unsigned*)((const char*)(gbase) + (voff)[_i]), (PG8_LAS unsigned*)(lds + (bufoff) + ldsw + _i * 8192), 16, 0, 0); } while (0)
#define PG8_LDA(dst, b, h) do { _Pragma("unroll") for (int m = 0; m < 4; ++m) _Pragma("unroll") for (int k = 0; k < 2; ++k) dst[m][k] = *(const PG8_LAS bf16x8*)(lds + PG8_SA(b, h) + aoff + m * 2048 + k * 1024); } while (0)
#define PG8_LDB(dst, b, h) do { _Pragma("unroll") for (int n = 0; n < 2; ++n) _Pragma("unroll") for (int k = 0; k < 2; ++k) dst[n][k] = *(const PG8_LAS bf16x8*)(lds + PG8_SB(b, h) + boff + n * 2048 + k * 1024); } while (0)
#define PG8_MMA(ai, bj, At, Bt) do { __builtin_amdgcn_s_setprio(1); _Pragma("unroll") for (int m = 0; m < 4; ++m) _Pragma("unroll") for (int n = 0; n < 2; ++n) _Pragma("unroll") for (int k = 0; k < 2; ++k) \
        acc[ai][bj][m][n] = __builtin_amdgcn_mfma_f32_16x16x32_bf16(Bt[n][k], At[m][k], acc[ai][bj][m][n], 0, 0, 0); __builtin_amdgcn_s_setprio(0); } while (0)
#define PG8_WAIT_V(n) asm volatile("s_waitcnt vmcnt(" #n ")" ::: "memory")
#define PG8_WAIT_L(n) asm volatile("s_waitcnt lgkmcnt(" #n ")" ::: "memory")
#define PG8_BAR __builtin_amdgcn_s_barrier()
#define PG8_SCHED __builtin_amdgcn_sched_barrier(0)
    Unit cur, nxt; int ui = 0;
    if (!S.next(0, cur)) return;
    f32x4 acc[2][2][4][2];
#pragma unroll
    for (int a = 0; a < 2; ++a)
#pragma unroll
        for (int b = 0; b < 2; ++b)
#pragma unroll
            for (int m = 0; m < 4; ++m)
#pragma unroll
                for (int n = 0; n < 2; ++n) acc[a][b][m][n] = (f32x4){0.f, 0.f, 0.f, 0.f};
    bf16x8 At[4][2], B0[2][2], B1[2][2];
    const char* cA = (const char*)g.A + (size_t)cur.pm * tstep; const char* cB = (const char*)g.Bt + (size_t)cur.pn * tstep;
    S.a_ready(cur);
    if constexpr (SP2) {
        PG8_STAGE(PG8_SB(0, 0), cB, voffB); PG8_STAGE(PG8_SB(0, 1), cB + hstep, voffB); PG8_STAGE(PG8_SA(0, 0), cA, voffA); PG8_STAGE(PG8_SA(0, 1), cA + hstep, voffA);
        if (wr == 1) PG8_BAR;
        PG8_WAIT_V(2); PG8_BAR;
        PG8_STAGE(PG8_SB(1, 0), cB + kstep, voffB); PG8_STAGE(PG8_SA(1, 0), cA + kstep, voffA); PG8_STAGE(PG8_SB(1, 1), cB + hstep + kstep, voffB);
        PG8_WAIT_V(6); PG8_BAR;
    } else {
        PG8_STAGE(PG8_SB(0, 0), cB, voffB); PG8_STAGE(PG8_SA(0, 0), cA, voffA); PG8_STAGE(PG8_SB(0, 1), cB + hstep, voffB); PG8_STAGE(PG8_SA(0, 1), cA + hstep, voffA);
        if (wr == 1) PG8_BAR;
        PG8_WAIT_V(4); PG8_BAR;
        PG8_STAGE(PG8_SB(1, 0), cB + kstep, voffB); PG8_STAGE(PG8_SA(1, 0), cA + kstep, voffA); PG8_STAGE(PG8_SB(1, 1), cB + hstep + kstep, voffB);
        PG8_WAIT_V(6); PG8_BAR;
    }
    for (;;) {
        const bool has_next = S.next(ui + 1, nxt);
        const char* nA = has_next ? (const char*)g.A + (size_t)nxt.pm * tstep : cA; const char* nB = has_next ? (const char*)g.Bt + (size_t)nxt.pn * tstep : cB;
        for (int t = 0; t < nt; t += 2) {
            const bool last = (t == nt - 2);
            const char* a1 = cA + (size_t)(t + 1) * kstep;
            const char* a2 = last ? nA : cA + (size_t)(t + 2) * kstep; const char* b2 = last ? nB : cB + (size_t)(t + 2) * kstep;
            const char* a3 = a2 + kstep; const char* b3 = b2 + kstep;
            if (last && has_next) S.a_ready(nxt);
            if constexpr (SP2) {
            PG8_LDB(B0, 0, 0); PG8_LDB(B1, 0, 1); PG8_SCHED; PG8_LDA(At, 0, 0); PG8_STAGE(PG8_SA(1, 1), a1 + hstep, voffA);
            PG8_WAIT_V(8); PG8_WAIT_L(0); PG8_BAR; PG8_MMA(0, 0, At, B0); PG8_MMA(0, 1, At, B1); PG8_BAR; PG8_SCHED;
            PG8_LDA(At, 0, 1); PG8_STAGE(PG8_SB(0, 0), b2, voffB); PG8_STAGE(PG8_SB(0, 1), b2 + hstep, voffB); PG8_STAGE(PG8_SA(0, 0), a2, voffA);
            PG8_WAIT_V(8); PG8_WAIT_L(0); PG8_BAR; PG8_MMA(1, 0, At, B0); PG8_MMA(1, 1, At, B1); PG8_BAR; PG8_SCHED;
            PG8_LDB(B0, 1, 0); PG8_LDB(B1, 1, 1); PG8_SCHED; PG8_LDA(At, 1, 0); PG8_STAGE(PG8_SA(0, 1), a2 + hstep, voffA);
            PG8_WAIT_V(8); PG8_WAIT_L(0); PG8_BAR; PG8_MMA(0, 0, At, B0); PG8_MMA(0, 1, At, B1); PG8_BAR; PG8_SCHED;
            PG8_LDA(At, 1, 1); PG8_STAGE(PG8_SB(1, 0), b3, voffB); PG8_STAGE(PG8_SB(1, 1), b3 + hstep, voffB); PG8_STAGE(PG8_SA(1, 0), a3, voffA);
            PG8_WAIT_V(8); PG8_WAIT_L(0); PG8_BAR; PG8_MMA(1, 0, At, B0); PG8_MMA(1, 1, At, B1); PG8_BAR; PG8_SCHED;
            } else {
            PG8_LDB(B0, 0, 0); PG8_SCHED; PG8_LDA(At, 0, 0); PG8_STAGE(PG8_SA(1, 1), a1 + hstep, voffA);
            PG8_WAIT_L(8); PG8_BAR; PG8_WAIT_L(0); PG8_MMA(0, 0, At, B0); PG8_BAR; PG8_SCHED;
            PG8_LDB(B1, 0, 1); PG8_STAGE(PG8_SB(0, 0), b2, voffB);
            PG8_BAR; PG8_WAIT_L(0); PG8_MMA(0, 1, At, B1); PG8_BAR;
            PG8_LDA(At, 0, 1); PG8_STAGE(PG8_SA(0, 0), a2, voffA);
            PG8_BAR; PG8_WAIT_L(0); PG8_MMA(1, 0, At, B0); PG8_BAR; PG8_SCHED;
            PG8_STAGE(PG8_SB(0, 1), b2 + hstep, voffB);
            PG8_WAIT_V(6); PG8_BAR; PG8_MMA(1, 1, At, B1); PG8_BAR;
            PG8_LDB(B0, 1, 0); PG8_SCHED; PG8_LDA(At, 1, 0); PG8_STAGE(PG8_SA(0, 1), a2 + hstep, voffA);
            PG8_WAIT_L(8); PG8_BAR; PG8_WAIT_L(0); PG8_MMA(0, 0, At, B0); PG8_BAR; PG8_SCHED;
            PG8_LDB(B1, 1, 1); PG8_STAGE(PG8_SB(1, 0), b3, voffB);
            PG8_BAR; PG8_WAIT_L(0); PG8_MMA(0, 1, At, B1); PG8_BAR;
            PG8_LDA(At, 1, 1); PG8_STAGE(PG8_SA(1, 0), a3, voffA);
            PG8_BAR; PG8_WAIT_L(0); PG8_MMA(1, 0, At, B0); PG8_BAR; PG8_SCHED;
            PG8_STAGE(PG8_SB(1, 1), b3 + hstep, voffB);
            PG8_WAIT_V(6); PG8_BAR; PG8_MMA(1, 1, At, B1); PG8_BAR;
            }
        }
        if constexpr (ALIGN_EPI) { if (wr == 0) PG8_BAR; }
        if constexpr (!Epi::AFTER_DRAIN) { E(acc, cur, wr, wc, fr, fq); S.done(cur); }
        if (!has_next) break;
#pragma unroll
        for (int a = 0; a < 2; ++a)
#pragma unroll
            for (int b = 0; b < 2; ++b)
#pragma unroll
                for (int m = 0; m < 4; ++m)
#pragma unroll
                    for (int n = 0; n < 2; ++n) acc[a][b][m][n] = (f32x4){0.f, 0.f, 0.f, 0.f};
        cur = nxt; cA = nA; cB = nB; ++ui;
        if constexpr (ALIGN_EPI) { if (wr == 1) PG8_BAR; }
    }
    PG8_WAIT_V(0);
    if constexpr (!ALIGN_EPI) { if (wr == 0) PG8_BAR; }
    PG8_BAR;
    if constexpr (Epi::AFTER_DRAIN) { E.fused(acc, cur, wr, wc, fr, fq, lds, wid, lane); S.done(cur); }
#undef PG8_SA
#undef PG8_SB
#undef PG8_STAGE
#undef PG8_LDA
#undef PG8_LDB
#undef PG8_MMA
#undef PG8_WAIT_V
#undef PG8_WAIT_L
#undef PG8_BAR
#undef PG8_SCHED
}
}

#define LAS __attribute__((address_space(3)))
typedef unsigned short bf16_t;
typedef short bf16x8 __attribute__((ext_vector_type(8)));
typedef short s16x4 __attribute__((ext_vector_type(4)));
typedef float f32x4 __attribute__((ext_vector_type(4)));
typedef float f32x2 __attribute__((ext_vector_type(2)));
typedef float f32x16 __attribute__((ext_vector_type(16)));
typedef unsigned u32x4 __attribute__((ext_vector_type(4)));
typedef unsigned u32x2 __attribute__((ext_vector_type(2)));
typedef __bf16 bf16x2_t __attribute__((ext_vector_type(2)));

__device__ __forceinline__ unsigned pk2(float lo, float hi) { f32x2 v = {lo, hi}; bf16x2_t b = __builtin_convertvector(v, bf16x2_t); return __builtin_bit_cast(unsigned, b); }
__device__ __forceinline__ float bflo(unsigned u) { return __uint_as_float(u << 16); }
__device__ __forceinline__ float bfhi(unsigned u) { return __uint_as_float(u & 0xffff0000u); }
__device__ __forceinline__ float fexp(float x) { return __builtin_amdgcn_exp2f(x * 1.4426950408889634f); }
__device__ __forceinline__ float frcp(float x) { return __builtin_amdgcn_rcpf(x); }
__device__ __forceinline__ float sigmoidf_(float x) { return frcp(1.f + fexp(-x)); }
template <int CTRL> __device__ __forceinline__ float dpp(float x) { return __builtin_bit_cast(float, __builtin_amdgcn_update_dpp(0, __builtin_bit_cast(int, x), CTRL, 0xf, 0xf, true)); }
__device__ __forceinline__ float swap32_sum(float x) { auto rr = __builtin_amdgcn_permlane32_swap(__float_as_uint(x), __float_as_uint(x), false, false); return __uint_as_float(rr[0]) + __uint_as_float(rr[1]); }
__device__ __forceinline__ float swap32_max(float x) { auto rr = __builtin_amdgcn_permlane32_swap(__float_as_uint(x), __float_as_uint(x), false, false); return fmaxf(__uint_as_float(rr[0]), __uint_as_float(rr[1])); }
__device__ __forceinline__ float swap16_sum(float x) { auto rr = __builtin_amdgcn_permlane16_swap(__float_as_uint(x), __float_as_uint(x), false, false); return __uint_as_float(rr[0]) + __uint_as_float(rr[1]); }
__device__ __forceinline__ float sum8(float x) { x += dpp<0xB1>(x); x += dpp<0x4E>(x); x += dpp<0x141>(x); return x; }
__device__ __forceinline__ float wave_sum(float x) { x += dpp<0xB1>(x); x += dpp<0x4E>(x); x += dpp<0x141>(x); x += dpp<0x140>(x); x = swap16_sum(x); x = swap32_sum(x); return x; }

constexpr size_t MiB = 1u << 20;
constexpr size_t WS_CTL = 0, CTL_ZERO_BYTES = 65536;
constexpr int CW_BAR = 4096, LDS_BARW = 147424;
constexpr size_t WS_ROPE = 1 * MiB;
constexpr size_t WS_LF = 1 * MiB + 640 * 1024;
constexpr size_t WS_W1T = 2 * MiB;
constexpr size_t WS_W2T = 35 * MiB;
constexpr size_t WS_XN = 43 * MiB;
constexpr size_t WS_RKV = 108 * MiB;
constexpr size_t WS_GR = 207 * MiB;
constexpr size_t WS_WA = 240 * MiB;
constexpr size_t WS_QD = 245 * MiB, WS_KD = 278 * MiB, WS_VD = 311 * MiB, WS_GD = 344 * MiB;
constexpr size_t WS_Y = 377 * MiB;
constexpr size_t WS_SSQ = 451 * MiB;
constexpr size_t WS_TAIL = 441 * MiB;
constexpr size_t WS_END = 512 * MiB;
constexpr int LDS_BYTES = 147456;
constexpr int LDS_QW = 147440;

struct Args {
    const float* in[21]; float* out; unsigned char* ws; float inv_freq[32]; int ph_lo, ph_hi, coop, pad;
};

constexpr float C2 = 0.125f * 1.4426950408889634f;
struct EpiProj {
    static constexpr bool PERM = true, AFTER_DRAIN = false;
    bf16_t *RKV, *GR, *WA, *QD, *KD, *VD, *GD; const float* rope;
    __device__ __forceinline__ void operator()(const f32x4 (&acc)[2][2][4][2], const pg8::Unit& u, int wr, int wc, int fr, int fq) const {
        const int pn = u.pn; bf16_t* base; int ld, colt, kind = 0;
        if (pn < 12) { base = RKV; ld = 3072; colt = pn * 256; }
        else if (pn < 16) { base = GR; ld = 1024; colt = (pn - 12) * 256; }
        else if (pn < 20) { base = QD; ld = 1024; colt = (pn - 16) * 256; kind = 1; }
        else if (pn < 24) { base = KD; ld = 1024; colt = (pn - 20) * 256; kind = 2; }
        else if (pn < 28) { base = VD; ld = 1024; colt = (pn - 24) * 256; }
        else if (pn < 32) { base = GD; ld = 1024; colt = (pn - 28) * 256; }
        else { base = WA; ld = 128; colt = 0; kind = 3; }
        const bool meta = (u.pm == 64);
        const int pos0 = meta ? 0 : (NMETA + (u.pm & 7) * 256);
        const int brow0 = meta ? 0 : (u.pm >> 3) * LP;
        const int cl = wc * 32 + 8 * fq;
        const int i0 = ((wc & 1) * 16 + 4 * fq);
        const float qs = (kind == 1) ? C2 : 1.f;
#pragma unroll
        for (int ai = 0; ai < 2; ++ai)
#pragma unroll
            for (int m = 0; m < 4; ++m) {
                const int rt = ai * 128 + wr * 64 + m * 16 + fr;
                if (meta && rt >= NMETA) continue;
                const int pos = pos0 + rt;
#pragma unroll
                for (int bj = 0; bj < 2; ++bj) {
                    if (kind == 3 && bj == 1) continue;
                    f32x4 v0 = acc[ai][bj][m][0], v1 = acc[ai][bj][m][1];
                    if (kind == 1 || kind == 2) {
                        const f32x4 cs0 = *(const f32x4*)(rope + ((size_t)pos * 32 + i0) * 2), cs1 = *(const f32x4*)(rope + ((size_t)pos * 32 + i0) * 2 + 4);
                        f32x4 o0, o1;
                        o0[0] = (v0[0] * cs0[0] - v0[1] * cs0[1]) * qs; o0[1] = (v0[1] * cs0[0] + v0[0] * cs0[1]) * qs;
                        o0[2] = (v0[2] * cs0[2] - v0[3] * cs0[3]) * qs; o0[3] = (v0[3] * cs0[2] + v0[2] * cs0[3]) * qs;
                        o1[0] = (v1[0] * cs1[0] - v1[1] * cs1[1]) * qs; o1[1] = (v1[1] * cs1[0] + v1[0] * cs1[1]) * qs;
                        o1[2] = (v1[2] * cs1[2] - v1[3] * cs1[3]) * qs; o1[3] = (v1[3] * cs1[2] + v1[2] * cs1[3]) * qs;
                        v0 = o0; v1 = o1;
                    }
                    u32x4 w; w.x = pk2(v0[0], v0[1]); w.y = pk2(v0[2], v0[3]); w.z = pk2(v1[0], v1[1]); w.w = pk2(v1[2], v1[3]);
                    const int col = colt + bj * 128 + cl;
                    if (!meta) { *(u32x4*)(base + (size_t)(brow0 + pos) * ld + col) = w; }
                    else {
#pragma unroll
                        for (int b = 0; b < NB; ++b) *(u32x4*)(base + (size_t)(b * LP + pos) * ld + col) = w;
                    }
                }
            }
    }
};

struct EpiY {
    static constexpr bool PERM = true, AFTER_DRAIN = false;
    bf16_t* YO; float* SSQ;
    __device__ __forceinline__ void operator()(const f32x4 (&acc)[2][2][4][2], const pg8::Unit& u, int wr, int wc, int fr, int fq) const {
        const int cl = u.pn * 256 + wc * 32 + 8 * fq;
#pragma unroll
        for (int ai = 0; ai < 2; ++ai)
#pragma unroll
            for (int m = 0; m < 4; ++m) {
                const int row = u.pm * 256 + ai * 128 + wr * 64 + m * 16 + fr;
#pragma unroll
                for (int bj = 0; bj < 2; ++bj) {
                    const f32x4 v0 = acc[ai][bj][m][0], v1 = acc[ai][bj][m][1];
                    u32x4 w; w.x = pk2(v0[0], v0[1]); w.y = pk2(v0[2], v0[3]); w.z = pk2(v1[0], v1[1]); w.w = pk2(v1[2], v1[3]);
                    *(u32x4*)(YO + (size_t)row * DM + cl + bj * 128) = w;
                }
            }
    }
};

__device__ __forceinline__ int w1_src_col(int n) {
    const int t = n >> 8, ct = n & 255;
    if (t < 12) return n;
    if (t < 16) return 3200 + (n - 3072);
    if (t < 24) { const int base = 4224 + (t - 16) * 256, hc = ct >> 6, p = ct & 63; return base + hc * 64 + (p >> 1) + 32 * (p & 1); }
    if (t < 32) return 6272 + (n - 6144);
    return ct < 128 ? 3072 + ct : -1;
}
template <bool MAP> __device__ __forceinline__ void p0_transpose_item(const float* W, int NS, bf16_t* WT, int nblk, LAS float* scr, int item, int lane) {
    const int kb = item / nblk, nb = item % nblk, k0 = 64 * kb, n0 = 32 * nb;
    const int sc = MAP ? w1_src_col(n0 + (lane & 31)) : (n0 + (lane & 31));
#pragma unroll 8
    for (int i = 0; i < 32; ++i) { const int kk = 2 * i + (lane >> 5); scr[kk * 33 + (lane & 31)] = (sc >= 0) ? W[(size_t)(k0 + kk) * NS + sc] : 0.f; }
    asm volatile("s_waitcnt lgkmcnt(0)" ::: "memory");
    const int c = lane & 7;
#pragma unroll
    for (int j = 0; j < 4; ++j) { const int n = (lane >> 3) + 8 * j; const LAS float* s = scr + (8 * c) * 33 + n;
        u32x4 o; o.x = pk2(s[0 * 33], s[1 * 33]); o.y = pk2(s[2 * 33], s[3 * 33]); o.z = pk2(s[4 * 33], s[5 * 33]); o.w = pk2(s[6 * 33], s[7 * 33]);
        *(u32x4*)(WT + (size_t)(n0 + n) * 2048 + k0 + 8 * c) = o; }
    asm volatile("s_waitcnt lgkmcnt(0)" ::: "memory");
}


__device__ __forceinline__ int w1_dst_row(int j) {
    if (j < 3072) return j;
    if (j < 3200) return 8192 + (j - 3072);
    if (j < 4224) return 3072 + (j - 3200);
    if (j < 6272) { const int rel = j - 4224, d = rel & 63, grp = rel >> 6; return 4096 + grp * 64 + ((d < 32) ? 2 * d : 2 * (d - 32) + 1); }
    return 6144 + (j - 6272);
}
template <bool MAP> __device__ __forceinline__ void p0_transpose128(const float* W, int NS, bf16_t* WT, int nblk, LAS float* scr, int item, int lane) {
    const int kb = item / nblk, nb = item % nblk, k0 = 32 * kb, n0 = 128 * nb;
#pragma unroll 4
    for (int i = 0; i < 16; ++i) { const int k = 2 * i + (lane >> 5); *(LAS f32x4*)(scr + k * 132 + 4 * (lane & 31)) = *(const f32x4*)(W + (size_t)(k0 + k) * NS + n0 + 4 * (lane & 31)); }
    asm volatile("s_waitcnt lgkmcnt(0)" ::: "memory");
    const int kq = lane >> 4, nl = lane & 15;
#pragma unroll
    for (int p = 0; p < 8; ++p) { const int n = 16 * p + nl; const LAS float* sp = scr + (8 * kq) * 132 + n;
        u32x4 o; o.x = pk2(sp[0 * 132], sp[1 * 132]); o.y = pk2(sp[2 * 132], sp[3 * 132]); o.z = pk2(sp[4 * 132], sp[5 * 132]); o.w = pk2(sp[6 * 132], sp[7 * 132]);
        const int dr = MAP ? w1_dst_row(n0 + n) : (n0 + n);
        *(u32x4*)(WT + (size_t)dr * 2048 + k0 + 8 * kq) = o; }
    asm volatile("s_waitcnt lgkmcnt(0)" ::: "memory");
}

constexpr int P0_NB1 = NIN / 64, P0_I1 = 32 * P0_NB1, P0_I2 = 32 * 32;
__device__ __forceinline__ void p0_ld(f32x4 (&r)[16], const Args& A, int it, int lane) {
    const bool w1 = it < P0_I1; const float* W = w1 ? A.in[3] : A.in[19]; const int NS = w1 ? NIN : 2048, nblk = w1 ? P0_NB1 : 32, item = w1 ? it : it - P0_I1;
    const int kb = item / nblk, nb = item % nblk;
    const float* p = W + (size_t)(64 * kb + (lane >> 4)) * NS + 64 * nb + 4 * (lane & 15);
#pragma unroll
    for (int i = 0; i < 16; ++i) r[i] = __builtin_nontemporal_load((const f32x4*)(p + (size_t)(4 * i) * NS));
}
__device__ __forceinline__ void p0_emit(const f32x4 (&r)[16], bf16_t* W1T, bf16_t* W2T, LAS float* scr, int it, int lane) {
    const bool w1 = it < P0_I1; const int nblk = w1 ? P0_NB1 : 32, item = w1 ? it : it - P0_I1;
    const int kb = item / nblk, nb = item % nblk, k0 = 64 * kb, n0 = 64 * nb;
#pragma unroll
    for (int i = 0; i < 16; ++i) *(LAS f32x4*)(scr + (4 * i + (lane >> 4)) * 68 + 4 * (lane & 15)) = r[i];
    asm volatile("s_waitcnt lgkmcnt(0)" ::: "memory");
    bf16_t* WT = w1 ? W1T : W2T;
    const int dr = w1 ? w1_dst_row(n0 + lane) : (n0 + lane);
    bf16_t* dst = WT + (size_t)dr * 2048 + k0;
#pragma unroll
    for (int p = 0; p < 8; ++p) { const LAS float* sp = scr + (8 * p) * 68 + lane;
        u32x4 o; o.x = pk2(sp[0 * 68], sp[1 * 68]); o.y = pk2(sp[2 * 68], sp[3 * 68]); o.z = pk2(sp[4 * 68], sp[5 * 68]); o.w = pk2(sp[6 * 68], sp[7 * 68]);
        *(u32x4*)(dst + 8 * p) = o; }
    asm volatile("s_waitcnt lgkmcnt(0)" ::: "memory");
}

constexpr int RW_NCH = 65, RW_TASKS = 128 * RW_NCH, RW_TB = 24832;
constexpr int RW_SEG0 = 5400;
__device__ __forceinline__ unsigned char* rw_block(const Args& A, int task) {
    if (task < RW_SEG0) return (unsigned char*)A.out + (size_t)task * RW_TB;
    return A.ws + WS_TAIL + (size_t)(task - RW_SEG0) * RW_TB;
}
__device__ __forceinline__ int Tk(int r, int hi) { return (r & 3) + 8 * (r >> 2) + 4 * hi; }
__device__ __forceinline__ bf16x8 pack8(const f32x16& x, int s) {
    return __builtin_bit_cast(bf16x8, (u32x4){pk2(x[8 * s], x[8 * s + 1]), pk2(x[8 * s + 2], x[8 * s + 3]), pk2(x[8 * s + 4], x[8 * s + 5]), pk2(x[8 * s + 6], x[8 * s + 7])});
}
__device__ __forceinline__ bf16x8 neg8(bf16x8 v) { u32x4 u = __builtin_bit_cast(u32x4, v); u ^= (u32x4){0x80008000u, 0x80008000u, 0x80008000u, 0x80008000u}; return __builtin_bit_cast(bf16x8, u); }
__device__ __forceinline__ float sum32h(float x) { x += dpp<0xB1>(x); x += dpp<0x4E>(x); x += dpp<0x141>(x); x += dpp<0x140>(x); return swap16_sum(x); }
#define MFMA32(a, b, c) __builtin_amdgcn_mfma_f32_32x32x16_bf16((a), (b), (c), 0, 0, 0)

#define BUFR(p, bytes) __builtin_amdgcn_make_buffer_rsrc((void*)(p), (short)0, (int)(bytes), 0x00020000)
#define SBAR0 do {} while (0)
namespace rwa {
__device__ __forceinline__ unsigned offm(unsigned t, unsigned p) { const unsigned f = (((t >> 1) & 1u) << 2) | ((t >> 2) & 3u); return 128u * t + 16u * ((p >> 3) ^ f) + 2u * (p & 7u); }
__device__ __forceinline__ void st16(LAS unsigned char* p, float x) { *(LAS bf16_t*)p = (bf16_t)(pk2(x, 0.f) & 0xffffu); }

__device__ __forceinline__ void task(const Args& A, int task, LAS unsigned char* wl, int lane_) {
    int lane = lane_; asm volatile("" : "+v"(lane));
    const int n = lane & 31, hi = lane >> 5;
    const int ch = task / RW_NCH, c = task - ch * RW_NCH, b = ch >> 4, h = ch & 15, t0 = 32 * c;
    const size_t rowb = (size_t)b * LP + t0;
    const __amdgpu_buffer_rsrc_t rR = BUFR((const bf16_t*)(A.ws + WS_RKV) + (rowb - 1) * 3072 + h * 64, 34 * 6144);
    const __amdgpu_buffer_rsrc_t rW = BUFR((const bf16_t*)(A.ws + WS_WA) + (rowb - 1) * 128, 34 * 256);
    const __amdgpu_buffer_rsrc_t rL = BUFR((const unsigned char*)(A.ws + WS_LF) + (size_t)h * 16384, 16384);
    unsigned char* ob = rw_block(A, task);
    const __amdgpu_buffer_rsrc_t rO = BUFR(ob, RW_TB);
    const __amdgpu_buffer_rsrc_t rPQ = BUFR(ob, (c == RW_NCH - 1) ? 0 : RW_TB);
    const float* mu = A.in[4];
    f32x16 accw[2], acca[2];
#pragma unroll
    for (int i = 0; i < 16; ++i) { accw[0][i] = 0.f; accw[1][i] = 0.f; acca[0][i] = 0.f; acca[1][i] = 0.f; }
    {
        const bool hasp = (t0 + n) > 0;
        const unsigned vo = (unsigned)(n * 256 + 16 * hi);
        u32x4 wcw[4], wca[4], wpw[4], wpa[4], lfw[4][2], lfa[4][2];
#pragma unroll
        for (int s = 0; s < 4; ++s) {
            wcw[s] = __builtin_amdgcn_raw_buffer_load_b128(rW, vo, 256 + 32 * s, 0); wca[s] = __builtin_amdgcn_raw_buffer_load_b128(rW, vo, 256 + 128 + 32 * s, 0);
            wpw[s] = __builtin_amdgcn_raw_buffer_load_b128(rW, vo, 32 * s, 0); wpa[s] = __builtin_amdgcn_raw_buffer_load_b128(rW, vo, 128 + 32 * s, 0); }
#pragma unroll
        for (int s = 0; s < 4; ++s)
#pragma unroll
            for (int nb = 0; nb < 2; ++nb) { lfw[s][nb] = __builtin_amdgcn_raw_buffer_load_b128(rL, (unsigned)lane * 16u, ((0 * 2 + nb) * 4 + s) * 1024, 0);
                                             lfa[s][nb] = __builtin_amdgcn_raw_buffer_load_b128(rL, (unsigned)lane * 16u, ((1 * 2 + nb) * 4 + s) * 1024, 0); }
        asm volatile("" ::: "memory");
#pragma unroll
        for (int s = 0; s < 4; ++s) {
            const u32x4 cw = wcw[s], ca = wca[s];
            u32x4 pw = wpw[s], pa = wpa[s];
            if (!hasp) { pw = (u32x4){0u, 0u, 0u, 0u}; pa = (u32x4){0u, 0u, 0u, 0u}; }
            const f32x4 mw0 = *(const f32x4*)(mu + 3072 + 16 * s + 8 * hi), mw1 = *(const f32x4*)(mu + 3072 + 16 * s + 8 * hi + 4);
            const f32x4 ma0 = *(const f32x4*)(mu + 3136 + 16 * s + 8 * hi), ma1 = *(const f32x4*)(mu + 3136 + 16 * s + 8 * hi + 4);
            const float mwv[8] = {mw0[0], mw0[1], mw0[2], mw0[3], mw1[0], mw1[1], mw1[2], mw1[3]}, mav[8] = {ma0[0], ma0[1], ma0[2], ma0[3], ma1[0], ma1[1], ma1[2], ma1[3]};
            float xw[8], xa[8];
#pragma unroll
            for (int j = 0; j < 4; ++j) {
                const float c0 = bflo(cw[j]), c1 = bfhi(cw[j]), p0 = bflo(pw[j]), p1 = bfhi(pw[j]);
                const float w0_ = c0 + (p0 - c0) * mwv[2 * j], w1_ = c1 + (p1 - c1) * mwv[2 * j + 1];
                xw[2 * j] = 1.f - 2.f * frcp(fexp(2.f * w0_) + 1.f); xw[2 * j + 1] = 1.f - 2.f * frcp(fexp(2.f * w1_) + 1.f);
                const float d0 = bflo(ca[j]), d1 = bfhi(ca[j]), q0 = bflo(pa[j]), q1 = bfhi(pa[j]);
                xa[2 * j] = d0 + (q0 - d0) * mav[2 * j]; xa[2 * j + 1] = d1 + (q1 - d1) * mav[2 * j + 1];
            }
            const bf16x8 Aw = __builtin_bit_cast(bf16x8, (u32x4){pk2(xw[0], xw[1]), pk2(xw[2], xw[3]), pk2(xw[4], xw[5]), pk2(xw[6], xw[7])});
            const bf16x8 Aa = __builtin_bit_cast(bf16x8, (u32x4){pk2(xa[0], xa[1]), pk2(xa[2], xa[3]), pk2(xa[4], xa[5]), pk2(xa[6], xa[7])});
#pragma unroll
            for (int nb = 0; nb < 2; ++nb) {
                accw[nb] = MFMA32(Aw, __builtin_bit_cast(bf16x8, lfw[s][nb]), accw[nb]); acca[nb] = MFMA32(Aa, __builtin_bit_cast(bf16x8, lfa[s][nb]), acca[nb]);
            }
            SBAR0;
        }
    }
    __builtin_amdgcn_s_barrier();
    const f32x2 w0v = *(const f32x2*)(A.in[5] + h * 64 + 2 * n), a0v = *(const f32x2*)(A.in[7] + h * 64 + 2 * n);
    float gC[2]; unsigned aap[2][8];
#pragma unroll
    for (int nb = 0; nb < 2; ++nb) {
        float prod = 1.f;
#pragma unroll
        for (int r = 0; r < 16; ++r) { const bool valid = (t0 + Tk(r, hi)) < LSEQ; const float sg = sigmoidf_(accw[nb][r] + w0v[nb]); const float d = valid ? fexp(-0.6065306597126334f * sg) : 1.f; accw[nb][r] = d; prod *= d; }
        const auto sw = __builtin_amdgcn_permlane32_swap(__float_as_uint(prod), __float_as_uint(prod), false, false);
        gC[nb] = __uint_as_float(sw[0]) * __uint_as_float(sw[1]);
#pragma unroll
        for (int i = 0; i < 8; ++i) aap[nb][i] = pk2(sigmoidf_(acca[nb][2 * i] + a0v[nb]), sigmoidf_(acca[nb][2 * i + 1] + a0v[nb]));
    }
    SBAR0;
    const f32x2 mur = *(const f32x2*)(mu + h * 64 + 2 * n), muk = *(const f32x2*)(mu + 1024 + h * 64 + 2 * n);
    const f32x2 kkw = *(const f32x2*)(A.in[9] + h * 64 + 2 * n), kaw = *(const f32x2*)(A.in[10] + h * 64 + 2 * n), rkw = *(const f32x2*)(A.in[11] + h * 64 + 2 * n);
    const unsigned voR = (unsigned)(hi * 4 * 6144 + 4 * n);
    u32x4 pKKg[2][2], pBc[2][2], pKc[2][2];
    const __amdgpu_buffer_rsrc_t rB = BUFR(ob + 24576, 128);
    float run0 = 1.f, run1 = 1.f;
    unsigned crn[5], ckn[5];
#pragma unroll
    for (int i = 0; i < 5; ++i) { crn[i] = __builtin_amdgcn_raw_buffer_load_b32(rR, voR, i * 6144, 0); ckn[i] = __builtin_amdgcn_raw_buffer_load_b32(rR, voR, i * 6144 + 2048, 0); }
#pragma unroll
    for (int g = 0; g < 4; ++g) {
        int ln = lane; asm volatile("" : "+v"(ln)); const int n2 = ln & 31, hi2 = ln >> 5;
        unsigned crg[5], ckg[5];
#pragma unroll
        for (int i = 0; i < 5; ++i) { crg[i] = crn[i]; ckg[i] = ckn[i]; }
        if (t0 + Tk(4 * g, hi2) == 0) { crg[0] = 0u; ckg[0] = 0u; }
        if (g < 3) {
#pragma unroll
            for (int i = 0; i < 5; ++i) { crn[i] = __builtin_amdgcn_raw_buffer_load_b32(rR, voR, (8 * (g + 1) + i) * 6144, 0); ckn[i] = __builtin_amdgcn_raw_buffer_load_b32(rR, voR, (8 * (g + 1) + i) * 6144 + 2048, 0); }
        }
        float Gi[2][4], Gx[2][4];
#pragma unroll
        for (int nb = 0; nb < 2; ++nb) {
            const float p0 = accw[nb][4 * g], p1 = p0 * accw[nb][4 * g + 1], p2 = p1 * accw[nb][4 * g + 2], p3 = p2 * accw[nb][4 * g + 3];
            const auto sw = __builtin_amdgcn_permlane32_swap(__float_as_uint(p3), __float_as_uint(p3), false, false);
            const float other = hi2 ? __uint_as_float(sw[0]) : __uint_as_float(sw[1]);
            const float run = nb ? run1 : run0;
            const float pre = hi2 ? run * other : run;
            Gi[nb][0] = pre * p0; Gi[nb][1] = pre * p1; Gi[nb][2] = pre * p2; Gi[nb][3] = pre * p3;
            Gx[nb][0] = pre; Gx[nb][1] = pre * p0; Gx[nb][2] = pre * p1; Gx[nb][3] = pre * p2;
            if (nb) run1 = run * p3 * other; else run0 = run * p3 * other;
        }
#pragma unroll
        for (int hp = 0; hp < 2; ++hp) {
            float oKKg[2][2], oBc[2][2], oKc[2][2];
#pragma unroll
            for (int e = 0; e < 2; ++e) {
                const int i4 = 2 * hp + e, r = 4 * g + i4, T = Tk(r, hi2);
                const bool valid = (t0 + T) < LSEQ;
                const unsigned cr_ = crg[i4 + 1], pr = crg[i4], ck_ = ckg[i4 + 1], pk = ckg[i4];
                float rr[2], kr[2];
                { const float c0 = bflo(cr_), c1 = bfhi(cr_), p0 = bflo(pr), p1 = bfhi(pr); rr[0] = valid ? c0 + (p0 - c0) * mur[0] : 0.f; rr[1] = valid ? c1 + (p1 - c1) * mur[1] : 0.f; }
                { const float c0 = bflo(ck_), c1 = bfhi(ck_), p0 = bflo(pk), p1 = bfhi(pk); kr[0] = c0 + (p0 - c0) * muk[0]; kr[1] = c1 + (p1 - c1) * muk[1]; }
                const float a0_ = (r & 1) ? bfhi(aap[0][r >> 1]) : bflo(aap[0][r >> 1]), a1_ = (r & 1) ? bfhi(aap[1][r >> 1]) : bflo(aap[1][r >> 1]);
                float k0 = kr[0] * kkw[0], k1 = kr[1] * kkw[1];
                const float ss = sum32h(k0 * k0 + k1 * k1); const float inv = valid ? __builtin_amdgcn_rsqf(fmaxf(ss, 1e-24f)) : 0.f;
                k0 *= inv; k1 *= inv;
                const float kp0 = valid ? kr[0] * (1.f + (a0_ - 1.f) * kaw[0]) : 0.f, kp1 = valid ? kr[1] * (1.f + (a1_ - 1.f) * kaw[1]) : 0.f;
                const float bs = sum32h(rr[0] * kp0 * rkw[0] + rr[1] * kp1 * rkw[1]);
                if (n2 == 0) __builtin_amdgcn_raw_buffer_store_b32(__float_as_uint(bs), rB, (unsigned)(hi2 * 16), 4 * (i4 + 8 * g), 0);
                const float ig0 = frcp(Gi[0][i4]), ig1 = frcp(Gi[1][i4]);
                const float kkg0 = k0 * Gx[0][i4], kkg1 = k1 * Gx[1][i4], rg0 = rr[0] * Gi[0][i4], rg1 = rr[1] * Gi[1][i4];
                const float bi0 = k0 * a0_ * ig0, bi1 = k1 * a1_ * ig1, ki0 = kp0 * ig0, ki1 = kp1 * ig1;
                LAS unsigned char* q0 = wl + offm(T, n2); LAS unsigned char* q1 = wl + offm(T, 32 + n2);
                st16(q0, kkg0); st16(q1, kkg1); st16(q0 + 4096, rg0); st16(q1 + 4096, rg1); st16(q0 + 8192, bi0); st16(q1 + 8192, bi1); st16(q0 + 12288, ki0); st16(q1 + 12288, ki1);
                oKKg[0][e] = kkg0; oKKg[1][e] = kkg1; oBc[0][e] = bi0 * gC[0]; oBc[1][e] = bi1 * gC[1]; oKc[0][e] = ki0 * gC[0]; oKc[1][e] = ki1 * gC[1];
            }
#pragma unroll
            for (int nb = 0; nb < 2; ++nb) { pKKg[nb][g >> 1][2 * (g & 1) + hp] = pk2(oKKg[nb][0], oKKg[nb][1]); pBc[nb][g >> 1][2 * (g & 1) + hp] = pk2(oBc[nb][0], oBc[nb][1]); pKc[nb][g >> 1][2 * (g & 1) + hp] = pk2(oKc[nb][0], oKc[nb][1]); }
            SBAR0;
        }
    }
    bf16x8 fKKg[2][2], fBc[2][2], fKc[2][2], fV[2][2];
#pragma unroll
    for (int nb = 0; nb < 2; ++nb)
#pragma unroll
        for (int s_ = 0; s_ < 2; ++s_) { fKKg[nb][s_] = __builtin_bit_cast(bf16x8, pKKg[nb][s_]); fBc[nb][s_] = __builtin_bit_cast(bf16x8, pBc[nb][s_]); fKc[nb][s_] = __builtin_bit_cast(bf16x8, pKc[nb][s_]); }
    {
        const unsigned voV = (unsigned)(hi * 4 * 6144 + 4 * n);
        const f32x2 muv = *(const f32x2*)(mu + 2048 + h * 64 + 2 * n);
        unsigned cv[16], pv4[4]; f32x16 x0, x1;
#pragma unroll
        for (int r = 0; r < 16; ++r) { const int T0 = (r & 3) + 8 * (r >> 2); cv[r] = __builtin_amdgcn_raw_buffer_load_b32(rR, voV, (T0 + 1) * 6144 + 4096, 0); }
#pragma unroll
        for (int g = 0; g < 4; ++g) pv4[g] = __builtin_amdgcn_raw_buffer_load_b32(rR, voV, (8 * g) * 6144 + 4096, 0);
        asm volatile("" : "+v"(pv4[0]), "+v"(pv4[1]), "+v"(pv4[2]), "+v"(pv4[3]));
#pragma unroll
        for (int g = 0; g < 4; ++g) if (t0 + Tk(4 * g, hi) == 0) pv4[g] = 0u;
#pragma unroll
        for (int r = 0; r < 16; ++r) { const unsigned pv = (r & 3) ? cv[r - 1] : pv4[r >> 2]; const bool valid = (t0 + Tk(r, hi)) < LSEQ;
            const float c0 = bflo(cv[r]), c1 = bfhi(cv[r]), p0 = bflo(pv), p1 = bfhi(pv);
            x0[r] = valid ? c0 + (p0 - c0) * muv[0] : 0.f; x1[r] = valid ? c1 + (p1 - c1) * muv[1] : 0.f; }
        fV[0][0] = pack8(x0, 0); fV[0][1] = pack8(x0, 1); fV[1][0] = pack8(x1, 0); fV[1][1] = pack8(x1, 1);
    }
    asm volatile("s_waitcnt lgkmcnt(0)" ::: "memory");
    SBAR0;
    __builtin_amdgcn_s_barrier();
    f32x16 Sbb, Sbk, Arb, Ark;
#pragma unroll
    for (int i = 0; i < 16; ++i) { Sbb[i] = 0.f; Sbk[i] = 0.f; Arb[i] = 0.f; Ark[i] = 0.f; }
#pragma unroll
    for (int s = 0; s < 4; ++s) {
        const unsigned o = offm(n, 16 * s + 8 * hi);
        const bf16x8 kg = *(const LAS bf16x8*)(wl + 0 * 4096 + o), rg = *(const LAS bf16x8*)(wl + 1 * 4096 + o), bi = *(const LAS bf16x8*)(wl + 2 * 4096 + o), ki = *(const LAS bf16x8*)(wl + 3 * 4096 + o);
        Sbb = MFMA32(bi, kg, Sbb); Sbk = MFMA32(ki, kg, Sbk); Arb = MFMA32(bi, rg, Arb); Ark = MFMA32(ki, rg, Ark);
        SBAR0;
    }
#pragma unroll
    for (int r = 0; r < 16; ++r) { const int j = Tk(r, hi); if (!(j < n)) { Sbb[r] = 0.f; Sbk[r] = 0.f; } if (!(j <= n)) { Arb[r] = 0.f; Ark[r] = 0.f; } }
    SBAR0;
    f32x16 Yl[2]; bf16x8 fZ[2][2];
    {
        const bf16x8 sk0 = pack8(Sbk, 0), sk1 = pack8(Sbk, 1), ak0 = pack8(Ark, 0), ak1 = pack8(Ark, 1);
#pragma unroll
        for (int vt = 0; vt < 2; ++vt) {
            f32x16 z;
#pragma unroll
            for (int i = 0; i < 16; ++i) z[i] = 0.f;
            const f32x16 zz = MFMA32(sk1, fV[vt][1], MFMA32(sk0, fV[vt][0], z));
            fZ[vt][0] = pack8(zz, 0); fZ[vt][1] = pack8(zz, 1);
            Yl[vt] = MFMA32(ak1, fV[vt][1], MFMA32(ak0, fV[vt][0], z));
        }
    }
#pragma unroll
    for (int i = 0; i < 2; ++i)
#pragma unroll
        for (int s_ = 0; s_ < 2; ++s_) { *(LAS bf16x8*)(wl + 8192 + ((i * 2 + s_) * 64 + lane) * 16) = fKc[i][s_]; *(LAS bf16x8*)(wl + 12288 + ((i * 2 + s_) * 64 + lane) * 16) = fV[i][s_]; }
    const bf16x8 fArb0 = pack8(Arb, 0), fArb1 = pack8(Arb, 1);
    SBAR0;
    __builtin_amdgcn_s_barrier();
    float TH[16];
    {
        LAS float* Mc = (LAS float*)wl;
#pragma unroll
        for (int r = 0; r < 16; ++r) Mc[Tk(r, hi) * 32 + n] = Sbb[r];
        asm volatile("s_waitcnt lgkmcnt(0)" ::: "memory");
#pragma unroll
        for (int i = 0; i < 16; ++i) TH[i] = ((4 * (2 * (i >> 2) + hi) + (i & 3)) == n) ? 1.f : 0.f;
        unsigned mh = (unsigned)(size_t)(Mc + 4 * hi);
        f32x4 mcur[4], mnxt[4];
        mcur[3] = *(const LAS f32x4*)(size_t)(mh + (30 * 32 + 8 * 3) * 4);
        mnxt[0] = mnxt[1] = mnxt[2] = mnxt[3] = mcur[3];
#pragma unroll
        for (int c = 30; c >= 0; --c) {
            if (c > 0) {
#pragma unroll
                for (int qq = (c >> 3); qq < 4; ++qq) mnxt[qq] = *(const LAS f32x4*)(size_t)(mh + ((c - 1) * 32 + 8 * qq) * 4);
            }
            float part = 0.f;
#pragma unroll
            for (int qq = ((c + 1) >> 3); qq < 4; ++qq) part += (TH[4 * qq] * mcur[qq][0] + TH[4 * qq + 1] * mcur[qq][1]) + (TH[4 * qq + 2] * mcur[qq][2] + TH[4 * qq + 3] * mcur[qq][3]);
            float tot = swap32_sum(part);
            asm volatile("" : "+v"(mh), "+v"(tot));
            const int idx = 4 * (c >> 3) + (c & 3), owner = (c >> 2) & 1;
            TH[idx] = (hi == owner) ? ((c == n) ? 1.f : -tot) : TH[idx];
#pragma unroll
            for (int qq = 0; qq < 4; ++qq) mcur[qq] = mnxt[qq];
        }
    }
    bf16x8 fT[2];
#pragma unroll
    for (int s_ = 0; s_ < 2; ++s_) fT[s_] = __builtin_bit_cast(bf16x8, (u32x4){pk2(TH[8 * s_], TH[8 * s_ + 1]), pk2(TH[8 * s_ + 2], TH[8 * s_ + 3]), pk2(TH[8 * s_ + 4], TH[8 * s_ + 5]), pk2(TH[8 * s_ + 6], TH[8 * s_ + 7])});
    SBAR0;
    __builtin_amdgcn_s_barrier();
    bf16x8 fKKt[2][2], fW[2][2];
#pragma unroll
    for (int i = 0; i < 2; ++i) {
        f32x16 z;
#pragma unroll
        for (int q = 0; q < 16; ++q) z[q] = 0.f;
        const f32x16 kkt = MFMA32(fT[1], fKKg[i][1], MFMA32(fT[0], fKKg[i][0], z));
        const f32x16 w = MFMA32(fT[1], fZ[i][1], MFMA32(fT[0], fZ[i][0], z));
        fKKt[i][0] = pack8(kkt, 0); fKKt[i][1] = pack8(kkt, 1); fW[i][0] = neg8(pack8(w, 0)); fW[i][1] = neg8(pack8(w, 1));
    }
    SBAR0;
    const unsigned vo16 = (unsigned)lane * 16u;
#pragma unroll
    for (int i = 0; i < 2; ++i)
#pragma unroll
        for (int s_ = 0; s_ < 2; ++s_) { fKc[i][s_] = *(const LAS bf16x8*)(wl + 8192 + ((i * 2 + s_) * 64 + lane) * 16); fV[i][s_] = *(const LAS bf16x8*)(wl + 12288 + ((i * 2 + s_) * 64 + lane) * 16); }
#pragma unroll
    for (int kt = 0; kt < 2; ++kt)
#pragma unroll
        for (int kp = 0; kp < 2; ++kp) {
            f32x16 z;
#pragma unroll
            for (int q = 0; q < 16; ++q) z[q] = 0.f;
            f32x16 a = MFMA32(fKKt[kp][1], fBc[kt][1], MFMA32(fKKt[kp][0], fBc[kt][0], z));
#pragma unroll
            for (int r = 0; r < 16; ++r) a[r] = ((kt == kp && Tk(r, hi) == n) ? gC[kt] : 0.f) - a[r];
            __builtin_amdgcn_raw_buffer_store_b128(__builtin_bit_cast(u32x4, pack8(a, 0)), rPQ, vo16, ((kt * 2 + kp) * 2 + 0) * 1024, 0);
            __builtin_amdgcn_raw_buffer_store_b128(__builtin_bit_cast(u32x4, pack8(a, 1)), rPQ, vo16, ((kt * 2 + kp) * 2 + 1) * 1024, 0);
        }
    SBAR0;
#pragma unroll
    for (int kt = 0; kt < 2; ++kt)
#pragma unroll
        for (int vt = 0; vt < 2; ++vt) {
            f32x16 z;
#pragma unroll
            for (int q = 0; q < 16; ++q) z[q] = 0.f;
            f32x16 a = MFMA32(fKc[kt][1], fV[vt][1], MFMA32(fKc[kt][0], fV[vt][0], z));
            a = MFMA32(fBc[kt][1], fW[vt][1], MFMA32(fBc[kt][0], fW[vt][0], a));
            __builtin_amdgcn_raw_buffer_store_b128(__builtin_bit_cast(u32x4, pack8(a, 0)), rPQ, vo16, 8192 + ((kt * 2 + vt) * 2 + 0) * 1024, 0);
            __builtin_amdgcn_raw_buffer_store_b128(__builtin_bit_cast(u32x4, pack8(a, 1)), rPQ, vo16, 8192 + ((kt * 2 + vt) * 2 + 1) * 1024, 0);
        }
    SBAR0;
#pragma unroll
    for (int kp = 0; kp < 2; ++kp) {
        f32x16 z;
#pragma unroll
        for (int q = 0; q < 16; ++q) z[q] = 0.f;
        f32x16 a = MFMA32(fKKt[kp][1], fArb1, MFMA32(fKKt[kp][0], fArb0, z));
#pragma unroll
        for (int g = 0; g < 4; ++g) { const u32x2 rg = *(const LAS u32x2*)(wl + 1 * 4096 + offm(n, kp * 32 + 8 * g + 4 * hi));
            a[4 * g] = bflo(rg.x) - a[4 * g]; a[4 * g + 1] = bfhi(rg.x) - a[4 * g + 1]; a[4 * g + 2] = bflo(rg.y) - a[4 * g + 2]; a[4 * g + 3] = bfhi(rg.y) - a[4 * g + 3]; }
        __builtin_amdgcn_raw_buffer_store_b128(__builtin_bit_cast(u32x4, pack8(a, 0)), rO, vo16, 16384 + (kp * 2 + 0) * 1024, 0);
        __builtin_amdgcn_raw_buffer_store_b128(__builtin_bit_cast(u32x4, pack8(a, 1)), rO, vo16, 16384 + (kp * 2 + 1) * 1024, 0);
    }
    SBAR0;
#pragma unroll
    for (int vt = 0; vt < 2; ++vt) {
        const f32x16 a = MFMA32(fArb1, fW[vt][1], MFMA32(fArb0, fW[vt][0], Yl[vt]));
        __builtin_amdgcn_raw_buffer_store_b128(__builtin_bit_cast(u32x4, pack8(a, 0)), rO, vo16, 20480 + (vt * 2 + 0) * 1024, 0);
        __builtin_amdgcn_raw_buffer_store_b128(__builtin_bit_cast(u32x4, pack8(a, 1)), rO, vo16, 20480 + (vt * 2 + 1) * 1024, 0);
    }
    asm volatile("s_waitcnt lgkmcnt(0)" ::: "memory");
}
}

namespace rwb {
__device__ __forceinline__ f32x16 unpack16(u32x4 a, u32x4 b) {
    f32x16 x; x[0] = bflo(a.x); x[1] = bfhi(a.x); x[2] = bflo(a.y); x[3] = bfhi(a.y); x[4] = bflo(a.z); x[5] = bfhi(a.z); x[6] = bflo(a.w); x[7] = bfhi(a.w);
    x[8] = bflo(b.x); x[9] = bfhi(b.x); x[10] = bflo(b.y); x[11] = bfhi(b.y); x[12] = bflo(b.z); x[13] = bfhi(b.z); x[14] = bflo(b.w); x[15] = bfhi(b.w); return x;
}
struct Frags { u32x4 P[2][2][2]; u32x4 Q[2][2]; u32x4 R[2][2]; u32x4 Y[2]; };
__device__ __forceinline__ void load_frags_pr(Frags& F, __amdgpu_buffer_rsrc_t rb, unsigned vo16) {
#pragma unroll
    for (int kt = 0; kt < 2; ++kt)
#pragma unroll
        for (int kp = 0; kp < 2; ++kp) { F.P[kt][kp][0] = __builtin_amdgcn_raw_buffer_load_b128(rb, vo16, ((kt * 2 + kp) * 2 + 0) * 1024, 0); F.P[kt][kp][1] = __builtin_amdgcn_raw_buffer_load_b128(rb, vo16, ((kt * 2 + kp) * 2 + 1) * 1024, 0); }
#pragma unroll
    for (int kp = 0; kp < 2; ++kp) { F.R[kp][0] = __builtin_amdgcn_raw_buffer_load_b128(rb, vo16, 16384 + (kp * 2 + 0) * 1024, 0); F.R[kp][1] = __builtin_amdgcn_raw_buffer_load_b128(rb, vo16, 16384 + (kp * 2 + 1) * 1024, 0); }
}
template <int VT> __device__ __forceinline__ void load_frags_qy(Frags& F, __amdgpu_buffer_rsrc_t rb, unsigned vo16) {
#pragma unroll
    for (int kt = 0; kt < 2; ++kt) { F.Q[kt][0] = __builtin_amdgcn_raw_buffer_load_b128(rb, vo16, 8192 + ((kt * 2 + VT) * 2 + 0) * 1024, 0); F.Q[kt][1] = __builtin_amdgcn_raw_buffer_load_b128(rb, vo16, 8192 + ((kt * 2 + VT) * 2 + 1) * 1024, 0); }
    F.Y[0] = __builtin_amdgcn_raw_buffer_load_b128(rb, vo16, 20480 + (VT * 2 + 0) * 1024, 0); F.Y[1] = __builtin_amdgcn_raw_buffer_load_b128(rb, vo16, 20480 + (VT * 2 + 1) * 1024, 0);
}
__device__ __forceinline__ void group(const Args& A, int grp, unsigned char* ldsb) {
    const int tid = threadIdx.x, lane = tid & 63, wid = __builtin_amdgcn_readfirstlane(tid >> 6), n = lane & 31, hi = lane >> 5, ci = wid >> 1, vt = wid & 1;
    const int ch = grp * 4 + ci, b = ch >> 4, h = ch & 15, v = 32 * vt + n;
    bf16_t* Yo = (bf16_t*)(A.ws + WS_Y);
    LAS float* ex = (LAS float*)(LAS unsigned char*)ldsb;
    const float gnw = A.in[12][h * 64 + v], gnb = A.in[13][h * 64 + v], muv = A.in[4][2048 + h * 64 + v];
    const unsigned vo16 = (unsigned)lane * 16u;
    f32x16 H[2];
#pragma unroll
    for (int i = 0; i < 16; ++i) { H[0][i] = 0.f; H[1][i] = 0.f; }
    Frags cur, nxt;
    { const __amdgpu_buffer_rsrc_t rb0 = BUFR(rw_block(A, ch * RW_NCH), RW_TB); load_frags_pr(cur, rb0, vo16); if (vt) load_frags_qy<1>(cur, rb0, vo16); else load_frags_qy<0>(cur, rb0, vo16); }
    for (int c = 0; c < RW_NCH; ++c) {
        const int t0 = 32 * c;
        const __amdgpu_buffer_rsrc_t rbc = BUFR(rw_block(A, ch * RW_NCH + c) + 24576, 128);
        const __amdgpu_buffer_rsrc_t rbn = BUFR(rw_block(A, ch * RW_NCH + ((c + 1 < RW_NCH) ? c + 1 : c)), RW_TB);
        load_frags_pr(nxt, rbn, vo16);
        SBAR0;
        bf16x8 Hp[2][2];
        Hp[0][0] = pack8(H[0], 0); Hp[0][1] = pack8(H[0], 1); Hp[1][0] = pack8(H[1], 0); Hp[1][1] = pack8(H[1], 1);
        f32x16 Y = unpack16(cur.Y[0], cur.Y[1]);
#pragma unroll
        for (int kp = 0; kp < 2; ++kp)
#pragma unroll
            for (int s = 0; s < 2; ++s) Y = MFMA32(__builtin_bit_cast(bf16x8, cur.R[kp][s]), Hp[kp][s], Y);
#pragma unroll
        for (int kt = 0; kt < 2; ++kt) {
            f32x16 hn = unpack16(cur.Q[kt][0], cur.Q[kt][1]);
#pragma unroll
            for (int kp = 0; kp < 2; ++kp)
#pragma unroll
                for (int s = 0; s < 2; ++s) hn = MFMA32(__builtin_bit_cast(bf16x8, cur.P[kt][kp][s]), Hp[kp][s], hn);
            H[kt] = hn;
        }
        SBAR0;
        if (vt) load_frags_qy<1>(nxt, rbn, vo16); else load_frags_qy<0>(nxt, rbn, vo16);
        float vs[16], gt[16], bo[16];
        { const __amdgpu_buffer_rsrc_t rV = BUFR((const bf16_t*)(A.ws + WS_RKV) + ((size_t)b * LP + t0 - 1) * 3072 + 2048 + h * 64, 34 * 6144);
          const __amdgpu_buffer_rsrc_t rG = BUFR((const bf16_t*)(A.ws + WS_GR) + ((size_t)b * LP + t0) * 1024 + h * 64, 33 * 2048);
          const unsigned voV = (unsigned)(hi * 4 * 6144 + 2 * v), voG = (unsigned)(hi * 4 * 2048 + 2 * v), voB = (unsigned)(hi * 16);
          float cv[16], pv4[4];
#pragma unroll
          for (int r = 0; r < 16; ++r) { const int T0 = (r & 3) + 8 * (r >> 2); cv[r] = __uint_as_float((unsigned)__builtin_amdgcn_raw_buffer_load_b16(rV, voV, (T0 + 1) * 6144, 0) << 16);
              gt[r] = __uint_as_float((unsigned)__builtin_amdgcn_raw_buffer_load_b16(rG, voG, T0 * 2048, 0) << 16); bo[r] = __uint_as_float(__builtin_amdgcn_raw_buffer_load_b32(rbc, voB, 4 * T0, 0)); }
#pragma unroll
          for (int g = 0; g < 4; ++g) { pv4[g] = __uint_as_float((unsigned)__builtin_amdgcn_raw_buffer_load_b16(rV, voV, (8 * g) * 6144, 0) << 16); if (t0 + Tk(4 * g, hi) == 0) pv4[g] = 0.f; }
#pragma unroll
          for (int r = 0; r < 16; ++r) { const float pv = (r & 3) ? cv[r - 1] : pv4[r >> 2]; vs[r] = cv[r] + (pv - cv[r]) * muv; } }
        SBAR0;
        float s1[16], s2[16];
#pragma unroll
        for (int r = 0; r < 16; ++r) { s1[r] = sum32h(Y[r]); s2[r] = sum32h(Y[r] * Y[r]); }
        LAS float* exw = ex + ((c & 1) * 8 + wid) * 64; LAS float* exp_ = ex + ((c & 1) * 8 + (wid ^ 1)) * 64;
        if (n == 0) {
#pragma unroll
            for (int r = 0; r < 16; ++r) { exw[2 * Tk(r, hi)] = s1[r]; exw[2 * Tk(r, hi) + 1] = s2[r]; } }
        __syncthreads();
#pragma unroll
        for (int r = 0; r < 16; ++r) {
            const int T = Tk(r, hi), t = t0 + T;
            const f32x2 o2 = *(const LAS f32x2*)(exp_ + 2 * T);
            const float mean = (s1[r] + o2[0]) * (1.f / 64.f), var = fmaxf((s2[r] + o2[1]) * (1.f / 64.f) - mean * mean, 0.f);
            float o = (Y[r] - mean) * __builtin_amdgcn_rsqf(var + 64e-5f) * gnw + gnb + bo[r] * vs[r];
            const float g = gt[r]; o *= g * sigmoidf_(g);
            if (t >= NMETA && t < LSEQ) Yo[(size_t)(b * TS + t - NMETA) * DM + h * 64 + v] = (bf16_t)(pk2(o, 0.f) & 0xffffu);
        }
        cur = nxt;
    }
    __syncthreads();
}
}

namespace rwc {
using rwb::unpack16;
__device__ __forceinline__ void hrec(const Args& A, int grp) {
    const int tid = threadIdx.x, lane = tid & 63, wid = __builtin_amdgcn_readfirstlane(tid >> 6), ci = wid >> 1, vt = wid & 1;
    const int ch = grp * 4 + ci;
    const unsigned vo16 = (unsigned)lane * 16u;
    f32x16 H[2];
#pragma unroll
    for (int i = 0; i < 16; ++i) { H[0][i] = 0.f; H[1][i] = 0.f; }
    u32x4 cP[2][2][2], cQ[2][2], nP[2][2][2], nQ[2][2];
#define HREC_LOAD(P_, Q_, rb) do { \
        _Pragma("unroll") for (int kt = 0; kt < 2; ++kt) _Pragma("unroll") for (int kp = 0; kp < 2; ++kp) { P_[kt][kp][0] = __builtin_amdgcn_raw_buffer_load_b128(rb, vo16, ((kt * 2 + kp) * 2 + 0) * 1024, 0); P_[kt][kp][1] = __builtin_amdgcn_raw_buffer_load_b128(rb, vo16, ((kt * 2 + kp) * 2 + 1) * 1024, 0); } \
        _Pragma("unroll") for (int kt = 0; kt < 2; ++kt) { Q_[kt][0] = __builtin_amdgcn_raw_buffer_load_b128(rb, vo16, 8192 + ((kt * 2 + vt) * 2 + 0) * 1024, 0); Q_[kt][1] = __builtin_amdgcn_raw_buffer_load_b128(rb, vo16, 8192 + ((kt * 2 + vt) * 2 + 1) * 1024, 0); } } while (0)
    { const __amdgpu_buffer_rsrc_t rb0 = BUFR(rw_block(A, ch * RW_NCH), RW_TB); HREC_LOAD(cP, cQ, rb0); }
    for (int c = 0; c < RW_NCH; ++c) {
        const __amdgpu_buffer_rsrc_t rbc = BUFR(rw_block(A, ch * RW_NCH + c), RW_TB);
        const __amdgpu_buffer_rsrc_t rbn = BUFR(rw_block(A, ch * RW_NCH + ((c + 1 < RW_NCH) ? c + 1 : c)), RW_TB);
        HREC_LOAD(nP, nQ, rbn);
        bf16x8 Hp[2][2];
        Hp[0][0] = pack8(H[0], 0); Hp[0][1] = pack8(H[0], 1); Hp[1][0] = pack8(H[1], 0); Hp[1][1] = pack8(H[1], 1);
#pragma unroll
        for (int kt = 0; kt < 2; ++kt) {
            f32x16 hn = unpack16(cQ[kt][0], cQ[kt][1]);
#pragma unroll
            for (int kp = 0; kp < 2; ++kp)
#pragma unroll
                for (int s = 0; s < 2; ++s) hn = MFMA32(__builtin_bit_cast(bf16x8, cP[kt][kp][s]), Hp[kp][s], hn);
            H[kt] = hn;
        }
#pragma unroll
        for (int kp = 0; kp < 2; ++kp)
#pragma unroll
            for (int s = 0; s < 2; ++s) __builtin_amdgcn_raw_buffer_store_b128(__builtin_bit_cast(u32x4, Hp[kp][s]), rbc, vo16, 8192 + ((kp * 2 + vt) * 2 + s) * 1024, 0);
#pragma unroll
        for (int kt = 0; kt < 2; ++kt) { cQ[kt][0] = nQ[kt][0]; cQ[kt][1] = nQ[kt][1];
#pragma unroll
            for (int kp = 0; kp < 2; ++kp) { cP[kt][kp][0] = nP[kt][kp][0]; cP[kt][kp][1] = nP[kt][kp][1]; } }
    }
#undef HREC_LOAD
}

__device__ __forceinline__ void ytask(const Args& A, int task, int lane_) {
    int lane = lane_; asm volatile("" : "+v"(lane));
    const int n = lane & 31, hi = lane >> 5;
    const int ch = task / RW_NCH, c = task - ch * RW_NCH, b = ch >> 4, h = ch & 15, t0 = 32 * c;
    const __amdgpu_buffer_rsrc_t rb = BUFR(rw_block(A, task), RW_TB);
    const unsigned vo16 = (unsigned)lane * 16u;
    bf16_t* Yo = (bf16_t*)(A.ws + WS_Y);
    f32x16 Y[2];
    {
        u32x4 R[2][2], Hq[2][2][2], Yl[2][2];
#pragma unroll
        for (int kp = 0; kp < 2; ++kp)
#pragma unroll
            for (int s = 0; s < 2; ++s) { R[kp][s] = __builtin_amdgcn_raw_buffer_load_b128(rb, vo16, 16384 + (kp * 2 + s) * 1024, 0);
#pragma unroll
                for (int vt = 0; vt < 2; ++vt) Hq[kp][vt][s] = __builtin_amdgcn_raw_buffer_load_b128(rb, vo16, 8192 + ((kp * 2 + vt) * 2 + s) * 1024, 0); }
#pragma unroll
        for (int vt = 0; vt < 2; ++vt) { Yl[vt][0] = __builtin_amdgcn_raw_buffer_load_b128(rb, vo16, 20480 + (vt * 2 + 0) * 1024, 0); Yl[vt][1] = __builtin_amdgcn_raw_buffer_load_b128(rb, vo16, 20480 + (vt * 2 + 1) * 1024, 0); }
#pragma unroll
        for (int vt = 0; vt < 2; ++vt) {
            f32x16 y = unpack16(Yl[vt][0], Yl[vt][1]);
#pragma unroll
            for (int kp = 0; kp < 2; ++kp)
#pragma unroll
                for (int s = 0; s < 2; ++s) y = MFMA32(__builtin_bit_cast(bf16x8, R[kp][s]), __builtin_bit_cast(bf16x8, Hq[kp][vt][s]), y);
            Y[vt] = y;
        }
    }
    float vs[2][16], gt[2][16], bo[16];
    {
        const __amdgpu_buffer_rsrc_t rV = BUFR((const bf16_t*)(A.ws + WS_RKV) + ((size_t)b * LP + t0 - 1) * 3072 + 2048 + h * 64, 34 * 6144);
        const __amdgpu_buffer_rsrc_t rG = BUFR((const bf16_t*)(A.ws + WS_GR) + ((size_t)b * LP + t0) * 1024 + h * 64, 33 * 2048);
        const __amdgpu_buffer_rsrc_t rBn = BUFR(rw_block(A, task) + 24576, 128);
#pragma unroll
        for (int r = 0; r < 16; ++r) bo[r] = __uint_as_float(__builtin_amdgcn_raw_buffer_load_b32(rBn, (unsigned)(hi * 16), 4 * ((r & 3) + 8 * (r >> 2)), 0));
        const f32x2 muv = *(const f32x2*)(A.in[4] + 2048 + h * 64 + 2 * n);
        const unsigned voV = (unsigned)(hi * 4 * 6144 + 4 * n), voG = (unsigned)(hi * 4 * 2048 + 4 * n);
        unsigned cv[16], pv4[4];
#pragma unroll
        for (int r = 0; r < 16; ++r) { const int T0 = (r & 3) + 8 * (r >> 2); cv[r] = __builtin_amdgcn_raw_buffer_load_b32(rV, voV, (T0 + 1) * 6144, 0);
            const unsigned g2 = __builtin_amdgcn_raw_buffer_load_b32(rG, voG, T0 * 2048, 0); gt[0][r] = bflo(g2); gt[1][r] = bfhi(g2); }
#pragma unroll
        for (int g = 0; g < 4; ++g) pv4[g] = __builtin_amdgcn_raw_buffer_load_b32(rV, voV, (8 * g) * 6144, 0);
        asm volatile("" : "+v"(pv4[0]), "+v"(pv4[1]), "+v"(pv4[2]), "+v"(pv4[3]));
#pragma unroll
        for (int g = 0; g < 4; ++g) if (t0 + Tk(4 * g, hi) == 0) pv4[g] = 0u;
#pragma unroll
        for (int r = 0; r < 16; ++r) { const unsigned pv = (r & 3) ? cv[r - 1] : pv4[r >> 2]; const float c0 = bflo(cv[r]), c1 = bfhi(cv[r]), p0 = bflo(pv), p1 = bfhi(pv);
            vs[0][r] = c0 + (p0 - c0) * muv[0]; vs[1][r] = c1 + (p1 - c1) * muv[1]; }
    }
    __builtin_amdgcn_s_barrier();
    const f32x2 gnw = *(const f32x2*)(A.in[12] + h * 64 + 2 * n), gnb = *(const f32x2*)(A.in[13] + h * 64 + 2 * n);
#pragma unroll
    for (int r = 0; r < 16; ++r) {
        const int t = t0 + Tk(r, hi);
        const float y0 = Y[0][r], y1 = Y[1][r];
        const float mean = sum32h(y0 + y1) * (1.f / 64.f);
        const float d0 = y0 - mean, d1 = y1 - mean;
        const float var = sum32h(d0 * d0 + d1 * d1) * (1.f / 64.f);
        const float rs = __builtin_amdgcn_rsqf(var + 64e-5f);
        float o0 = d0 * rs * gnw[0] + gnb[0] + bo[r] * vs[0][r], o1 = d1 * rs * gnw[1] + gnb[1] + bo[r] * vs[1][r];
        o0 *= gt[0][r] * sigmoidf_(gt[0][r]); o1 *= gt[1][r] * sigmoidf_(gt[1][r]);
        if (t >= NMETA && t < LSEQ) *(unsigned*)(Yo + (size_t)(b * TS + t - NMETA) * DM + h * 64 + 2 * n) = pk2(o0, o1);
    }
    __builtin_amdgcn_s_barrier();
}
}

namespace att {
constexpr float THR = 8.f;
constexpr int O_K = 0, O_V = 32768, O_WSF = 69632, XP = 132;
__device__ __forceinline__ unsigned off_b(unsigned row, unsigned ch) { return 256u * row + 16u * (ch ^ (((row & 3u) << 2) | ((row >> 2) & 3u))); }

__device__ __forceinline__ void unit(const Args& A, int b, int h, int qb, float lam, unsigned char* ldsb) {
    const int tid = threadIdx.x, lane = tid & 63, wid = __builtin_amdgcn_readfirstlane(tid >> 6), r32 = lane & 31, hh = lane >> 5, qblk = wid >> 1, comp = wid & 1;
    const bf16_t* QD = (const bf16_t*)(A.ws + WS_QD); const bf16_t* KD = (const bf16_t*)(A.ws + WS_KD); const bf16_t* VD = (const bf16_t*)(A.ws + WS_VD); const bf16_t* GD = (const bf16_t*)(A.ws + WS_GD);
    bf16_t* Y = (bf16_t*)(A.ws + WS_Y);
    LAS unsigned char* lds3 = (LAS unsigned char*)ldsb;
    const int qpos0 = NMETA + 128 * qb + 32 * qblk, qpos = qpos0 + r32;
    const int NT = 2 * qb + 3, wlast = (qpos0 + 31) >> 6;
    bf16x8 qf[4];
    { const bf16_t* qp = QD + (size_t)(b * LP + qpos) * 1024 + h * 128 + comp * 64 + 8 * hh;
#pragma unroll
      for (int d0 = 0; d0 < 4; ++d0) qf[d0] = *(const bf16x8*)(qp + 16 * d0); }
    const int srow = tid >> 4, sch = tid & 15;
    const unsigned sdst0 = off_b(srow, sch), sdst1 = off_b(srow + 32, sch);
    const bf16_t* kg = KD + (size_t)(b * LP + srow) * 1024 + h * 128 + sch * 8; const bf16_t* vg = VD + (size_t)(b * LP + srow) * 1024 + h * 128 + sch * 8;
    u32x4 kA0, kA1, vA0, vA1, kB0, kB1, vB0, vB1;
#define ATT_LOAD(X, tl_) do { const size_t o_ = (size_t)(tl_) * 64 * 1024; k##X##0 = *(const u32x4*)(kg + o_); k##X##1 = *(const u32x4*)(kg + o_ + 32 * 1024); v##X##0 = *(const u32x4*)(vg + o_); v##X##1 = *(const u32x4*)(vg + o_ + 32 * 1024); } while (0)
#define ATT_STORE(X, buf) do { *(LAS u32x4*)(lds3 + O_K + (buf) * 16384 + sdst0) = k##X##0; *(LAS u32x4*)(lds3 + O_K + (buf) * 16384 + sdst1) = k##X##1; \
                               *(LAS u32x4*)(lds3 + O_V + (buf) * 16384 + sdst0) = v##X##0; *(LAS u32x4*)(lds3 + O_V + (buf) * 16384 + sdst1) = v##X##1; } while (0)
    const unsigned sw = ((r32 & 3) << 2) | ((r32 >> 2) & 3);
    const unsigned kx = (unsigned)(comp * 8 + hh) ^ sw;
    const unsigned kbase = 256u * r32;
    const unsigned q4 = (lane & 15) >> 2, p4 = lane & 3, blk = (lane >> 4) & 1, cb = 2 * blk + (p4 >> 1);
    float m = 0.f, lsum = 0.f;
    f32x16 NEGM;
#pragma unroll
    for (int i = 0; i < 16; ++i) NEGM[i] = 0.f;
    f32x16 O[4];
#pragma unroll
    for (int d = 0; d < 4; ++d)
#pragma unroll
        for (int i = 0; i < 16; ++i) O[d][i] = 0.f;
    LAS float* wsf = (LAS float*)(lds3 + O_WSF) + wid * 64;
    unsigned valo[4], vahi[4];
#pragma unroll
    for (int d = 0; d < 4; ++d) { valo[d] = 256u * (4 * hh + q4) + 16u * ((((unsigned)d ^ q4) << 2) | (cb ^ (unsigned)hh)) + 8u * (p4 & 1);
                                  vahi[d] = 256u * (8 + 4 * hh + q4) + 16u * ((((unsigned)d ^ q4) << 2) | (cb ^ (2u + (unsigned)hh))) + 8u * (p4 & 1); }
#define MAX3G(r_, a_, b_, c_) asm volatile("s_nop 15\n\tv_max3_f32 %0, %1, %2, %3" : "=v"(r_) : "v"(a_), "v"(b_), "v"(c_))
#define MAX3(r_, a_, b_, c_) asm("v_max3_f32 %0, %1, %2, %3" : "=v"(r_) : "v"(a_), "v"(b_), "v"(c_))
#define ATT_COMPUTE(tl_, cur_) do { const int tl = (tl_); \
            LAS unsigned char* Kb = lds3 + O_K + (cur_) * 16384; LAS unsigned char* Vb = lds3 + O_V + (cur_) * 16384; \
            f32x16 p0 = NEGM, p1 = NEGM; \
            _Pragma("unroll") for (int d0 = 0; d0 < 4; ++d0) { \
                const bf16x8 a0 = *(const LAS bf16x8*)(Kb + kbase + 16u * (kx ^ (2u * d0))); \
                const bf16x8 a1 = *(const LAS bf16x8*)(Kb + 8192 + kbase + 16u * (kx ^ (2u * d0))); \
                p0 = __builtin_amdgcn_mfma_f32_32x32x16_bf16(a0, qf[d0], p0, 0, 0, 0); \
                p1 = __builtin_amdgcn_mfma_f32_32x32x16_bf16(a1, qf[d0], p1, 0, 0, 0); } \
            if (64 * tl + 63 > qpos0) { \
                _Pragma("unroll") for (int r = 0; r < 16; ++r) { const int kp = 64 * tl + (r & 3) + 8 * (r >> 2) + 4 * hh; if (kp > qpos) p0[r] = -INFINITY; if (kp + 32 > qpos) p1[r] = -INFINITY; } } \
            float rm, rm2; MAX3G(rm, p0[0], p1[0], p0[1]); MAX3(rm2, rm, p1[1], p0[2]); MAX3(rm, rm, p1[2], p0[3]); \
            MAX3(rm2, rm2, p1[3], p0[4]); MAX3(rm, rm, p1[4], p0[5]); MAX3(rm2, rm2, p1[5], p0[6]); MAX3(rm, rm, p1[6], p0[7]); \
            MAX3(rm2, rm2, p1[7], p0[8]); MAX3(rm, rm, p1[8], p0[9]); MAX3(rm2, rm2, p1[9], p0[10]); MAX3(rm, rm, p1[10], p0[11]); \
            MAX3(rm2, rm2, p1[11], p0[12]); MAX3(rm, rm, p1[12], p0[13]); MAX3(rm2, rm2, p1[13], p0[14]); MAX3(rm, rm, p1[14], p0[15]); \
            MAX3(rm, rm, rm2, p1[15]); \
            rm = swap32_max(rm); \
            if (tl == 0 || __any(rm > THR)) {            \
                const float dm = (tl == 0) ? rm : fmaxf(rm, 0.f), alpha = (tl == 0) ? 1.f : __builtin_amdgcn_exp2f(-dm);        \
                lsum *= alpha; m += dm; \
                if (hh == 0) wsf[r32] = alpha; \
                asm volatile("s_waitcnt lgkmcnt(0)" ::: "memory"); \
                _Pragma("unroll") for (int g = 0; g < 4; ++g) { const f32x4 a4 = *(const LAS f32x4*)(wsf + 8 * g + 4 * hh); \
                    _Pragma("unroll") for (int d = 0; d < 4; ++d) { O[d][4 * g] *= a4[0]; O[d][4 * g + 1] *= a4[1]; O[d][4 * g + 2] *= a4[2]; O[d][4 * g + 3] *= a4[3]; } } \
                _Pragma("unroll") for (int r = 0; r < 16; ++r) { p0[r] -= dm; p1[r] -= dm; NEGM[r] = -m; } \
            } \
            float ps0 = 0.f, ps1 = 0.f; \
            _Pragma("unroll") for (int r = 0; r < 16; ++r) { p0[r] = __builtin_amdgcn_exp2f(p0[r]); p1[r] = __builtin_amdgcn_exp2f(p1[r]); ps0 += p0[r]; ps1 += p1[r]; } \
            lsum += ps0 + ps1; \
            bf16x8 pw[4]; \
            pw[0] = __builtin_bit_cast(bf16x8, (u32x4){pk2(p0[0], p0[1]), pk2(p0[2], p0[3]), pk2(p0[4], p0[5]), pk2(p0[6], p0[7])}); \
            pw[1] = __builtin_bit_cast(bf16x8, (u32x4){pk2(p0[8], p0[9]), pk2(p0[10], p0[11]), pk2(p0[12], p0[13]), pk2(p0[14], p0[15])}); \
            pw[2] = __builtin_bit_cast(bf16x8, (u32x4){pk2(p1[0], p1[1]), pk2(p1[2], p1[3]), pk2(p1[4], p1[5]), pk2(p1[6], p1[7])}); \
            pw[3] = __builtin_bit_cast(bf16x8, (u32x4){pk2(p1[8], p1[9]), pk2(p1[10], p1[11]), pk2(p1[12], p1[13]), pk2(p1[14], p1[15])}); \
            _Pragma("unroll") for (int s = 0; s < 4; ++s) \
                _Pragma("unroll") for (int d = 0; d < 4; ++d) { \
                    const s16x4 lo = __builtin_amdgcn_ds_read_tr16_b64_v4i16((LAS s16x4*)(Vb + 4096 * s + valo[d])); \
                    const s16x4 hi = __builtin_amdgcn_ds_read_tr16_b64_v4i16((LAS s16x4*)(Vb + 4096 * s + vahi[d])); \
                    const bf16x8 vf = {lo[0], lo[1], lo[2], lo[3], hi[0], hi[1], hi[2], hi[3]}; \
                    O[d] = __builtin_amdgcn_mfma_f32_32x32x16_bf16(pw[s], vf, O[d], 0, 0, 0); } \
        } while (0)

    ATT_LOAD(A, 0); ATT_STORE(A, 0);
    __syncthreads();
    if (NT > 1) ATT_LOAD(A, 1);
    for (int t2 = 0; t2 < NT; t2 += 2) {
        if (t2 + 2 < NT) ATT_LOAD(B, t2 + 2);
        if (t2 <= wlast) ATT_COMPUTE(t2, 0);
        if (t2 + 1 < NT) ATT_STORE(A, 1);
        __syncthreads();
        if (t2 + 1 >= NT) break;
        if (t2 + 3 < NT) ATT_LOAD(A, t2 + 3);
        if (t2 + 1 <= wlast) ATT_COMPUTE(t2 + 1, 1);
        if (t2 + 2 < NT) ATT_STORE(B, 0);
        __syncthreads();
    }
#undef ATT_COMPUTE
#undef MAX3
#undef MAX3G
#undef ATT_LOAD
#undef ATT_STORE
    const float lt = swap32_sum(lsum);
    const float sc = (comp ? lam : 1.f) / lt;
    if (hh == 0) wsf[r32] = sc;
    asm volatile("s_waitcnt lgkmcnt(0)" ::: "memory");
    LAS float* X = (LAS float*)lds3 + qblk * (32 * XP);
    if (comp == 1) {
#pragma unroll
        for (int g = 0; g < 4; ++g) { const f32x4 s4 = *(const LAS f32x4*)(wsf + 8 * g + 4 * hh);
#pragma unroll
            for (int i = 0; i < 4; ++i)
#pragma unroll
                for (int d = 0; d < 4; ++d) X[(8 * g + 4 * hh + i) * XP + 32 * d + r32] = O[d][4 * g + i] * s4[i]; }
    }
    __syncthreads();
    if (comp == 0) {
#pragma unroll
        for (int g = 0; g < 4; ++g) { const f32x4 s4 = *(const LAS f32x4*)(wsf + 8 * g + 4 * hh);
#pragma unroll
            for (int i = 0; i < 4; ++i)
#pragma unroll
                for (int d = 0; d < 4; ++d) { LAS float* xp = X + (8 * g + 4 * hh + i) * XP + 32 * d + r32; *xp = O[d][4 * g + i] * s4[i] - *xp; } }
        asm volatile("s_waitcnt lgkmcnt(0)" ::: "memory");
        const LAS float* xr = X + r32 * XP + 64 * hh;
        f32x4 dv[16]; float ss = 0.f;
#pragma unroll
        for (int i = 0; i < 16; ++i) { dv[i] = *(const LAS f32x4*)(xr + 4 * i); ss += (dv[i][0] * dv[i][0] + dv[i][1] * dv[i][1]) + (dv[i][2] * dv[i][2] + dv[i][3] * dv[i][3]); }
        ss = swap32_sum(ss);
        const float rms = __builtin_amdgcn_rsqf(ss * (1.f / 128.f) + 1e-5f) * 0.8f;
        const bf16_t* gp = GD + (size_t)(b * LP + qpos) * 1024 + h * 128 + 64 * hh; const float* sw_ = A.in[18] + 64 * hh;
        bf16_t* yp = Y + (size_t)(b * TS + qpos - NMETA) * DM + 1024 + h * 128 + 64 * hh;
#pragma unroll
        for (int c8 = 0; c8 < 8; ++c8) {
            const u32x4 gv = *(const u32x4*)(gp + 8 * c8); const f32x4 w0 = *(const f32x4*)(sw_ + 8 * c8), w1 = *(const f32x4*)(sw_ + 8 * c8 + 4);
            const float g0 = bflo(gv.x), g1 = bfhi(gv.x), g2 = bflo(gv.y), g3 = bfhi(gv.y), g4 = bflo(gv.z), g5 = bfhi(gv.z), g6 = bflo(gv.w), g7 = bfhi(gv.w);
            const f32x4 d0 = dv[2 * c8], d1 = dv[2 * c8 + 1];
            u32x4 o;
            o.x = pk2(d0[0] * rms * w0[0] * g0 * sigmoidf_(g0), d0[1] * rms * w0[1] * g1 * sigmoidf_(g1));
            o.y = pk2(d0[2] * rms * w0[2] * g2 * sigmoidf_(g2), d0[3] * rms * w0[3] * g3 * sigmoidf_(g3));
            o.z = pk2(d1[0] * rms * w1[0] * g4 * sigmoidf_(g4), d1[1] * rms * w1[1] * g5 * sigmoidf_(g5));
            o.w = pk2(d1[2] * rms * w1[2] * g6 * sigmoidf_(g6), d1[3] * rms * w1[3] * g7 * sigmoidf_(g7));
            *(u32x4*)(yp + 8 * c8) = o;
        }
    }
    __syncthreads();
}
}

#define XB_TMO      128
#define XB_XCNT(j)  (256  + 64 * (j))
#define XB_XSUB(j)  (1280 + 64 * (j))
#define XB_XGEN(j)  (2304 + 64 * (j))
#define XB_TOP      3328
#define XB_TOPGEN   3392
#define XCD_BAR_WORDS 3456
#define XB_SPIN_CAP (1u << 18)

__device__ __forceinline__ unsigned xb_ld(unsigned* p)              { return __hip_atomic_load(p, __ATOMIC_RELAXED, __HIP_MEMORY_SCOPE_AGENT); }
__device__ __forceinline__ unsigned xb_add(unsigned* p, unsigned v) { return __hip_atomic_fetch_add(p, v, __ATOMIC_RELAXED, __HIP_MEMORY_SCOPE_AGENT); }
__device__ __forceinline__ unsigned xb_xcc_id() { return (unsigned)__builtin_amdgcn_s_getreg((3 << 11) | 20) & 0xFu; }
#define XB_SPIN(cond, bar) do { unsigned _sp = 0; while (cond) { __builtin_amdgcn_s_sleep(1); \
    if ((++_sp & 255u) == 0u) { if (xb_ld(&(bar)[XB_TMO])) break; if (_sp > XB_SPIN_CAP) { atomicAdd(&(bar)[XB_TMO], 1u); break; } } } } while (0)

struct XcdBarrier {
    unsigned* bar; unsigned x;
    volatile LAS unsigned* st;
};

__device__ __forceinline__ XcdBarrier xcd_barrier_post(unsigned* bar, volatile LAS unsigned* st) {
    XcdBarrier b; b.bar = bar; b.x = xb_xcc_id(); b.st = st;
    if (threadIdx.x == 0) (void)xb_add(&bar[XB_XCNT(b.x)], 1u);
    return b;
}
__device__ __forceinline__ void xcd_barrier_complete(unsigned* bar, unsigned x, unsigned& nloc, unsigned& nx) {
    const unsigned G = gridDim.x * gridDim.y * gridDim.z;
    unsigned sum, cnt, mine, sp = 0u;
    for (;;) {
        sum = 0u; cnt = 0u; mine = 0u;
#pragma unroll
        for (unsigned j = 0; j < 16; ++j) { const unsigned c = xb_ld(&bar[XB_XCNT(j)]); sum += c; cnt += (c > 0u) ? 1u : 0u; mine = (j == x) ? c : mine; }
        if (sum == G) break;
        __builtin_amdgcn_s_sleep(1);
        if ((++sp & 255u) == 0u) { if (xb_ld(&bar[XB_TMO])) break; if (sp > XB_SPIN_CAP) { atomicAdd(&bar[XB_TMO], 1u); break; } }
    }
    nloc = mine > 0u ? mine : 1u; nx = cnt > 0u ? cnt : 1u;
}

__device__ __forceinline__ void xcd_barrier(const XcdBarrier& b) {
    asm volatile("s_waitcnt vmcnt(0)" ::: "memory");
    __syncthreads();
    if (threadIdx.x == 0) {
        unsigned* bar = b.bar;
        __builtin_amdgcn_s_waitcnt(0);
        unsigned nloc = b.st[0], nx = b.st[1];
        if (nloc == 0u) { xcd_barrier_complete(bar, b.x, nloc, nx); b.st[0] = nloc; b.st[1] = nx; }
        const unsigned old = xb_add(&bar[XB_XSUB(b.x)], 1u);
        const unsigned gen = old / nloc;
        if (old + 1u == (gen + 1u) * nloc) {
            __builtin_amdgcn_fence(__ATOMIC_RELEASE, "agent");
            asm volatile("s_waitcnt vmcnt(0)" ::: "memory");
            const unsigned og = xb_add(&bar[XB_TOP], 1u);
            const unsigned tg = og / nx;
            if (og + 1u == (tg + 1u) * nx) xb_add(&bar[XB_TOPGEN], 1u);
            else XB_SPIN(xb_ld(&bar[XB_TOPGEN]) == tg, bar);
            __builtin_amdgcn_fence(__ATOMIC_ACQUIRE, "agent");
            xb_add(&bar[XB_XGEN(b.x)], 1u);
            asm volatile("s_waitcnt vmcnt(0)" ::: "memory");
        } else {
            XB_SPIN(xb_ld(&bar[XB_XGEN(b.x)]) == gen, bar);
            __builtin_amdgcn_fence(__ATOMIC_ACQUIRE, "agent");
            asm volatile("s_waitcnt vmcnt(0)" ::: "memory");
        }
    }
    __syncthreads();
}


__global__ void __launch_bounds__(512, 2) hymba_fwd(Args A) {
    extern __shared__ __attribute__((aligned(16))) unsigned char lds[];
    const int tid = threadIdx.x, lane = tid & 63, wave = __builtin_amdgcn_readfirstlane(tid >> 6);
    const int G = gridDim.x, bx = blockIdx.x;
    const int lo = A.ph_lo, hi = A.ph_hi;
    unsigned char* ws = A.ws;
    bf16_t* W1T = (bf16_t*)(ws + WS_W1T); bf16_t* W2T = (bf16_t*)(ws + WS_W2T); bf16_t* XN = (bf16_t*)(ws + WS_XN);
    float* ROPE = (float*)(ws + WS_ROPE); float* SSQ = (float*)(ws + WS_SSQ);
#define IN_PH(k) (lo <= (k) && (k) < hi)
    volatile LAS unsigned* bst = (volatile LAS unsigned*)((LAS unsigned char*)lds + LDS_BARW);
    if (tid < 2) bst[tid] = 0u;
    __syncthreads();
    XcdBarrier gbar; gbar.bar = (unsigned*)(ws + WS_CTL) + CW_BAR; gbar.x = 0; gbar.st = nullptr;
    if (A.coop) gbar = xcd_barrier_post((unsigned*)(ws + WS_CTL) + CW_BAR, bst);
#define GRID_SYNC(k) do { if (A.coop && IN_PH(k) && IN_PH((k) + 1)) { xcd_barrier(gbar); } } while (0)

    if (IN_PH(0)) {
        const int gw = bx * 8 + wave, NGW = G * 8;
        LAS float* scr = (LAS float*)((LAS unsigned char*)lds + wave * 17408);
        constexpr int I_1 = P0_I1, I_2 = P0_I2;
        if (gw < I_1 + I_2) {
            f32x4 cur[16]; p0_ld(cur, A, gw, lane);
            for (int it = gw; it < I_1 + I_2; it += NGW) {
                f32x4 nxt[16]; { const int nx = it + NGW; p0_ld(nxt, A, nx < I_1 + I_2 ? nx : it, lane); }
                p0_emit(cur, W1T, W2T, scr, it, lane);
#pragma unroll
                for (int i = 0; i < 16; ++i) cur[i] = nxt[i];
            }
        }
        for (int e = bx * 512 + tid; e < 128 * 2048 / 8; e += G * 512) *(u32x4*)(W1T + (size_t)8320 * 2048 + (size_t)e * 8) = (u32x4){0u, 0u, 0u, 0u};
        { const f32x4* wv = (const f32x4*)A.in[2] + lane; f32x4 pw[8];
#pragma unroll
          for (int j = 0; j < 8; ++j) pw[j] = wv[64 * j];
          constexpr int NREAL = MR + NMETA;
#define XN_SRC(row) ((const f32x4*)(((row) < MR) ? A.in[0] + (size_t)(row) * DM : A.in[1] + (size_t)((row) - MR) * DM) + lane)
          f32x4 v[8];
          { const f32x4* xr = XN_SRC(gw);
#pragma unroll
            for (int j = 0; j < 8; ++j) v[j] = __builtin_nontemporal_load(xr + 64 * j); }
          for (int mrow = gw; mrow < NREAL; mrow += NGW) {
              f32x4 nv[8]; { const int nx = mrow + NGW; const int nr = nx < NREAL ? nx : mrow; const f32x4* xr = XN_SRC(nr);
#pragma unroll
                for (int j = 0; j < 8; ++j) nv[j] = __builtin_nontemporal_load(xr + 64 * j); }
              unsigned long long* o8 = (unsigned long long*)(XN + (size_t)mrow * DM) + lane;
              float s = 0.f;
#pragma unroll
              for (int j = 0; j < 8; ++j) s += (v[j][0] * v[j][0] + v[j][1] * v[j][1]) + (v[j][2] * v[j][2] + v[j][3] * v[j][3]);
              const float rstd = __builtin_amdgcn_rsqf(wave_sum(s) * (1.f / DM) + 1e-6f);
#pragma unroll
              for (int j = 0; j < 8; ++j) { const f32x4 y = v[j] * rstd * pw[j]; o8[64 * j] = (unsigned long long)pk2(y[0], y[1]) | ((unsigned long long)pk2(y[2], y[3]) << 32); }
#pragma unroll
              for (int j = 0; j < 8; ++j) v[j] = nv[j];
          }
#undef XN_SRC
          for (int mrow = NREAL + gw; mrow < MP; mrow += NGW) {
              unsigned long long* o8 = (unsigned long long*)(XN + (size_t)mrow * DM) + lane;
#pragma unroll
              for (int j = 0; j < 8; ++j) o8[64 * j] = 0ull;
          } }
        for (int e = bx * 512 + tid; e < LSEQ * 32; e += G * 512) {
            const int pos = e >> 5, i = e & 31; const double rev = (double)pos * (double)A.inv_freq[i] * 0.15915494309189535; const float f = (float)(rev - floor(rev));
            ROPE[2 * e] = __builtin_amdgcn_cosf(f); ROPE[2 * e + 1] = __builtin_amdgcn_sinf(f); }
        { u32x4* LF = (u32x4*)(ws + WS_LF);
          for (int e = bx * 512 + tid; e < 16 * 2 * 2 * 4 * 64; e += G * 512) {
              const int l = e & 63, s_ = (e >> 6) & 3, nb = (e >> 8) & 1, mat = (e >> 9) & 1, hd = e >> 10; const float* up = mat ? A.in[8] : A.in[6];
              const float* p = up + (size_t)(16 * s_ + 8 * (l >> 5)) * 1024 + hd * 64 + 2 * (l & 31) + nb;
              LF[e] = (u32x4){pk2(p[0], p[1024]), pk2(p[2048], p[3072]), pk2(p[4096], p[5120]), pk2(p[6144], p[7168])}; } }
        { bf16_t* KD = (bf16_t*)(ws + WS_KD); bf16_t* VD = (bf16_t*)(ws + WS_VD); constexpr int PADC = (LP - LSEQ) * 1024 / 8;
          for (int e = bx * 512 + tid; e < NB * PADC * 2; e += G * 512) { const int which = e / (NB * PADC), r = e % (NB * PADC), b = r / PADC, c = r % PADC;
              *(u32x4*)((which ? VD : KD) + (size_t)(b * LP + LSEQ) * 1024 + (size_t)c * 8) = (u32x4){0u, 0u, 0u, 0u}; } }
    }
    GRID_SYNC(0);

    if (IN_PH(1)) {
        pg8::Gemm g{XN, W1T, MP, N1, DM}; pg8::StaticOrder S; S.init(MP, N1, G, bx);
        EpiProj E{(bf16_t*)(ws + WS_RKV), (bf16_t*)(ws + WS_GR), (bf16_t*)(ws + WS_WA), (bf16_t*)(ws + WS_QD), (bf16_t*)(ws + WS_KD), (bf16_t*)(ws + WS_VD), (bf16_t*)(ws + WS_GD), ROPE};
        pg8::gemm_phase<EpiProj, pg8::StaticOrder, true, true>((PG8_LAS unsigned char*)lds, g, S, E);
    }
    GRID_SYNC(1);

    if (IN_PH(2)) {
        const int gw = bx * 8 + wave, NGW = G * 8;
        LAS unsigned char* wl = (LAS unsigned char*)lds + wave * 18432;
        for (int sl = gw; sl < 128 * (RW_NCH - 1); sl += NGW) { rwa::task(A, (sl >> 6) * RW_NCH + (sl & 63), wl, lane); __builtin_amdgcn_s_barrier(); }
    }
    GRID_SYNC(2);

    if (IN_PH(3)) {
        float lam;
        { const float a = A.in[14][lane] * A.in[15][lane], c = A.in[16][lane] * A.in[17][lane];
          lam = fexp(wave_sum(a)) - fexp(wave_sum(c)) + 0.2f; }
        unsigned* qctr = (unsigned*)(ws + WS_CTL);
        volatile LAS int* qw = (volatile LAS int*)((LAS unsigned char*)lds + LDS_QW);
        constexpr int NRG = 32, NTL = 16, NITEMS = NRG + NTL + 1024;
#define Q_FETCH(dst) do { __syncthreads(); if (tid == 0) *qw = (int)atomicAdd(qctr, 1u); __syncthreads(); dst = *qw; } while (0)
        int item; Q_FETCH(item);
        while (item < NRG) { rwc::hrec(A, item); Q_FETCH(item); }
        while (item < NRG + NTL) { rwa::task(A, ((item - NRG) * 8 + wave) * RW_NCH + (RW_NCH - 1), (LAS unsigned char*)lds + wave * 18432, lane); __builtin_amdgcn_s_barrier(); Q_FETCH(item); }
        while (item < NITEMS) { const int a = item - NRG - NTL, qb = 15 - (a >> 6), bh = a & 63; att::unit(A, bh >> 3, bh & 7, qb, lam, lds); Q_FETCH(item); }
#undef Q_FETCH
    }
    GRID_SYNC(3);

    if (IN_PH(4)) {
        const int gw = bx * 8 + wave, NGW = G * 8;
        const int full_ = RW_TASKS / NGW;
        for (int it_ = 0; it_ < full_; ++it_) rwc::ytask(A, gw + it_ * NGW, lane);
        { const int left_ = RW_TASKS - full_ * NGW;
          for (int base_ = 0; base_ < left_; base_ += G) {
              if (wave == 0 && base_ + bx < left_) rwc::ytask(A, full_ * NGW + base_ + bx, lane);
              else { __builtin_amdgcn_s_barrier(); __builtin_amdgcn_s_barrier(); }
          } }
    }
    GRID_SYNC(4);

    if (IN_PH(5)) {
        pg8::Gemm g{(const bf16_t*)(ws + WS_Y), W2T, MR, DM, DM}; pg8::StaticOrder S; S.init(MR, DM, G, bx);
        EpiY E{XN  , SSQ};
        pg8::gemm_phase<EpiY, pg8::StaticOrder, true, true>((PG8_LAS unsigned char*)lds, g, S, E);
    }
    GRID_SYNC(5);

    if (IN_PH(6)) {
        const int gw = bx * 8 + wave, NGW = G * 8;
        const f32x4* wv = (const f32x4*)A.in[20] + lane; f32x4 pw[8];
#pragma unroll
        for (int j = 0; j < 8; ++j) pw[j] = wv[64 * j];
        const bf16_t* YO = XN;
        u32x2 yv[8];
        { const u32x2* yr = (const u32x2*)(YO + (size_t)gw * DM) + lane;
#pragma unroll
          for (int j = 0; j < 8; ++j) yv[j] = yr[64 * j]; }
        for (int row = gw; row < MR; row += NGW) {
            const f32x4* xr = (const f32x4*)(A.in[0] + (size_t)row * DM) + lane;
            f32x4 xv[8];
#pragma unroll
            for (int j = 0; j < 8; ++j) xv[j] = __builtin_nontemporal_load(xr + 64 * j);
            u32x2 nyv[8];
            { const int nx = row + NGW; const u32x2* yr = (const u32x2*)(YO + (size_t)(nx < MR ? nx : row) * DM) + lane;
#pragma unroll
              for (int j = 0; j < 8; ++j) nyv[j] = yr[64 * j]; }
            float ssq = 0.f;
#pragma unroll
            for (int j = 0; j < 8; ++j) { const float e0 = bflo(yv[j].x), e1 = bfhi(yv[j].x), e2 = bflo(yv[j].y), e3 = bfhi(yv[j].y); ssq += (e0 * e0 + e1 * e1) + (e2 * e2 + e3 * e3); }
            const float rstd = __builtin_amdgcn_rsqf(wave_sum(ssq) * (1.f / DM) + 1e-6f);
            f32x4* orow = (f32x4*)(A.out + (size_t)row * DM) + lane;
#pragma unroll
            for (int j = 0; j < 8; ++j) { const f32x4 y = {bflo(yv[j].x), bfhi(yv[j].x), bflo(yv[j].y), bfhi(yv[j].y)};
                orow[64 * j] = xv[j] + y * rstd * pw[j]; }
#pragma unroll
            for (int j = 0; j < 8; ++j) yv[j] = nyv[j];
        }
    }
#undef IN_PH
#undef GRID_SYNC
}

extern "C" void kernel_launch(void* const* d_in, const int* in_sizes, int n_in, void* d_out, int out_size, void* d_ws, size_t ws_size, hipStream_t stream) {
    static int grid = 0;
    if (grid == 0) {
        if (n_in != 21 || in_sizes[0] != MR * DM || out_size != MR * DM || ws_size < WS_END) { fprintf(stderr, "kernel_launch: unexpected shapes (n_in %d, in0 %d, out %d, ws %zu); nothing launched\n", n_in, n_in > 0 ? in_sizes[0] : -1, out_size, ws_size); grid = -1; return; }
        int dev = 0, cus = 0, per_cu = 0;
        if (hipGetDevice(&dev) != hipSuccess || hipDeviceGetAttribute(&cus, hipDeviceAttributeMultiprocessorCount, dev) != hipSuccess) { grid = -1; return; }
        if (hipFuncSetAttribute((const void*)hymba_fwd, hipFuncAttributeMaxDynamicSharedMemorySize, LDS_BYTES) != hipSuccess) { fprintf(stderr, "kernel_launch: hipFuncSetAttribute failed\n"); grid = -1; return; }
        if (hipOccupancyMaxActiveBlocksPerMultiprocessor(&per_cu, (const void*)hymba_fwd, 512, LDS_BYTES) != hipSuccess || per_cu < 1) { fprintf(stderr, "kernel_launch: occupancy query reports %d\n", per_cu); per_cu = 1; }
        (void)hipGetLastError();
        grid = cus;
    }
    if (grid < 0) return;
    (void)hipMemsetAsync((char*)d_ws + WS_CTL, 0, CTL_ZERO_BYTES, stream);
    Args a{};
    for (int i = 0; i < 21; ++i) a.in[i] = (const float*)d_in[i];
    a.out = (float*)d_out; a.ws = (unsigned char*)d_ws;
    for (int i = 0; i < 32; ++i) a.inv_freq[i] = (float)pow(10000.0, -(double)(2 * i) / 64.0);
#if MK_N_LAUNCHES == 1
    a.ph_lo = 0; a.ph_hi = NPH; a.coop = 1;
    void* kargs[] = {&a};
    (void)kargs;
    hipLaunchKernelGGL(hymba_fwd, dim3(grid), dim3(512), LDS_BYTES, stream, a);
#else
    for (int p = 0; p < NPH; ++p) { a.ph_lo = p; a.ph_hi = p + 1; a.coop = 0; hipLaunchKernelGGL(hymba_fwd, dim3(grid), dim3(512), LDS_BYTES, stream, a); }
#endif
}
```

```cpp
#include <hip/hip_runtime.h>
#include <hip/hip_cooperative_groups.h>
#include <cstdio>
#include <cstdint>
#include <cmath>
namespace cg = cooperative_groups;

#ifndef REP_PH
#define REP_PH -1
#endif
#ifndef MK_N_LAUNCHES
#define MK_N_LAUNCHES 1
#endif

constexpr int NB = 8, TS = 2048, NMETA = 16, LSEQ = TS + NMETA, LP = 2112, DM = 2048;
constexpr int MR = NB * TS;
constexpr int MP = 16640;
constexpr int N1 = 8448;
constexpr int NIN = 8320;
constexpr int NPH = 7;

namespace pg8 {
#define PG8_LAS __attribute__((address_space(3)))
typedef unsigned short bf16_t;
typedef short bf16x8 __attribute__((ext_vector_type(8)));
typedef float f32x4 __attribute__((ext_vector_type(4)));
typedef unsigned u32x4 __attribute__((ext_vector_type(4)));
constexpr int BM = 256, BK = 64, HALF = 128, HTB = HALF * BK * 2, STAGE_BYTES = 8 * HTB, NXCD = 8, WGM = 8;

__host__ __device__ __forceinline__ int lds_byte(int r, int c) { const int st = (r >> 4) * 2 + (c >> 5), rr = r & 15, cc = c & 31, ob = rr * 64 + cc * 2; return st * 1024 + (ob ^ (((ob >> 9) & 1) << 5)); }
__host__ __device__ __forceinline__ void stage_rc(int b, int& R, int& C) { const int st = b / 1024, sb = b % 1024, swz = sb ^ (((sb >> 9) & 1) << 5); R = (st >> 1) * 16 + swz / 64; C = (st & 1) * 32 + (swz % 64) / 2; }
__host__ __device__ __forceinline__ int perm32(int rho) { const int n = rho >> 4, i = rho & 15; return 8 * (i >> 2) + 4 * n + (i & 3); }

struct Unit { int pm, pn; };
struct Gemm { const bf16_t* A; const bf16_t* Bt; int M, N, K; };

struct StaticOrder {
    int nM, nN, nwg, G, c;
    __host__ __device__ void init(int M, int N, int G_, int c_) { nM = M / BM; nN = N / BM; nwg = nM * nN; G = G_; c = c_; }
    __host__ __device__ bool next(int i, Unit& u) const {
        const long L = (long)i * G + c; if (L >= nwg) return false;
        int wgid = (int)L; { const int q = nwg / NXCD, r = nwg % NXCD, xcd = wgid % NXCD, off = wgid / NXCD; wgid = (xcd < r ? xcd * (q + 1) : r * (q + 1) + (xcd - r) * q) + off; }
        const int nig = WGM * nN, gid = wgid / nig, fm = gid * WGM, gsz = (nM - fm) < WGM ? (nM - fm) : WGM;
        u.pm = fm + ((wgid % nig) % gsz); u.pn = (wgid % nig) / gsz; return true;
    }
    __device__ __forceinline__ void a_ready(const Unit&) const {}
    __device__ __forceinline__ void done(const Unit&) const {}
};

__device__ __forceinline__ unsigned cvt_pk_bf16(float lo, float hi) { unsigned r; asm volatile("v_cvt_pk_bf16_f32 %0, %1, %2" : "=v"(r) : "v"(lo), "v"(hi)); return r; }

template <class Epi, class Sched, bool ALIGN_EPI = false, bool SP2 = false>
__device__ __forceinline__ void gemm_phase(PG8_LAS unsigned char* lds, const Gemm g, const Sched& S, const Epi& E) {
    const int tid = threadIdx.x, wid = __builtin_amdgcn_readfirstlane(tid >> 6), lane = tid & 63, wr = wid >> 2, wc = wid & 3, fr = lane & 15, fq = lane >> 4;
    const int K = g.K, nt = K / BK;
    unsigned voffA[2], voffB[2];
#pragma unroll
    for (int i = 0; i < 2; ++i) { int R, C; stage_rc(tid * 16 + i * 8192, R, C); const int Rb = Epi::PERM ? ((R & ~31) + perm32(R & 31)) : R;
        voffA[i] = (unsigned)(R * K + C) * 2u; voffB[i] = (unsigned)(Rb * K + C) * 2u; }
    const size_t kstep = (size_t)(BK * 2);
    const size_t hstep = (size_t)HALF * K * 2;
    const size_t tstep = 2 * hstep;
    const unsigned ldsw = (unsigned)wid * 1024u;
    const int aoff = lds_byte(wr * 64 + fr, fq * 8), boff = lds_byte(wc * 32 + fr, fq * 8);
#define PG8_SA(b, h) (((b) * 2 + (h)) * HTB)
#define PG8_SB(b, h) ((4 + (b) * 2 + (h)) * HTB)
#define PG8_STAGE(bufoff, gbase, voff) do { _Pragma("unroll") for (int _i = 0; _i < 2; ++_i) \
        __builtin_amdgcn_global_load_lds((const unsigned*)((const char*)(gbase) + (voff)[_i]), (PG8_LAS unsigned*)(lds + (bufoff) + ldsw + _i * 8192), 16, 0, 0); } while (0)
#define PG8_LDA(dst, b, h) do { _Pragma("unroll") for (int m = 0; m < 4; ++m) _Pragma("unroll") for (int k = 0; k < 2; ++k) dst[m][k] = *(const PG8_LAS bf16x8*)(lds + PG8_SA(b, h) + aoff + m * 2048 + k * 1024); } while (0)
#define PG8_LDB(dst, b, h) do { _Pragma("unroll") for (int n = 0; n < 2; ++n) _Pragma("unroll") for (int k = 0; k < 2; ++k) dst[n][k] = *(const PG8_LAS bf16x8*)(lds + PG8_SB(b, h) + boff + n * 2048 + k * 1024); } while (0)
#define PG8_MMA(ai, bj, At, Bt) do { __builtin_amdgcn_s_setprio(1); _Pragma("unroll") for (int m = 0; m < 4; ++m) _Pragma("unroll") for (int n = 0; n < 2; ++n) _Pragma("unroll") for (int k = 0; k < 2; ++k) \
        acc[ai][bj][m][n] = __builtin_amdgcn_mfma_f32_16x16x32_bf16(Bt[n][k], At[m][k], acc[ai][bj][m][n], 0, 0, 0); __builtin_amdgcn_s_setprio(0); } while (0)
#define PG8_WAIT_V(n) asm volatile("s_waitcnt vmcnt(" #n ")" ::: "memory")
#define PG8_WAIT_L(n) asm volatile("s_waitcnt lgkmcnt(" #n ")" ::: "memory")
#define PG8_BAR __builtin_amdgcn_s_barrier()
#define PG8_SCHED __builtin_amdgcn_sched_barrier(0)
    Unit cur, nxt; int ui = 0;
    if (!S.next(0, cur)) return;
    f32x4 acc[2][2][4][2];
#pragma unroll
    for (int a = 0; a < 2; ++a)
#pragma unroll
        for (int b = 0; b < 2; ++b)
#pragma unroll
            for (int m = 0; m < 4; ++m)
#pragma unroll
                for (int n = 0; n < 2; ++n) acc[a][b][m][n] = (f32x4){0.f, 0.f, 0.f, 0.f};
    bf16x8 At[4][2], B0[2][2], B1[2][2];
    const char* cA = (const char*)g.A + (size_t)cur.pm * tstep; const char* cB = (const char*)g.Bt + (size_t)cur.pn * tstep;
    S.a_ready(cur);
    if constexpr (SP2) {
        PG8_STAGE(PG8_SB(0, 0), cB, voffB); PG8_STAGE(PG8_SB(0, 1), cB + hstep, voffB); PG8_STAGE(PG8_SA(0, 0), cA, voffA); PG8_STAGE(PG8_SA(0, 1), cA + hstep, voffA);
        if (wr == 1) PG8_BAR;
        PG8_WAIT_V(2); PG8_BAR;
        PG8_STAGE(PG8_SB(1, 0), cB + kstep, voffB); PG8_STAGE(PG8_SA(1, 0), cA + kstep, voffA); PG8_STAGE(PG8_SB(1, 1), cB + hstep + kstep, voffB);
        PG8_WAIT_V(6); PG8_BAR;
    } else {
        PG8_STAGE(PG8_SB(0, 0), cB, voffB); PG8_STAGE(PG8_SA(0, 0), cA, voffA); PG8_STAGE(PG8_SB(0, 1), cB + hstep, voffB); PG8_STAGE(PG8_SA(0, 1), cA + hstep, voffA);
        if (wr == 1) PG8_BAR;
        PG8_WAIT_V(4); PG8_BAR;
        PG8_STAGE(PG8_SB(1, 0), cB + kstep, voffB); PG8_STAGE(PG8_SA(1, 0), cA + kstep, voffA); PG8_STAGE(PG8_SB(1, 1), cB + hstep + kstep, voffB);
        PG8_WAIT_V(6); PG8_BAR;
    }
    for (;;) {
        const bool has_next = S.next(ui + 1, nxt);
        const char* nA = has_next ? (const char*)g.A + (size_t)nxt.pm * tstep : cA; const char* nB = has_next ? (const char*)g.Bt + (size_t)nxt.pn * tstep : cB;
        for (int t = 0; t < nt; t += 2) {
            const bool last = (t == nt - 2);
            const char* a1 = cA + (size_t)(t + 1) * kstep;
            const char* a2 = last ? nA : cA + (size_t)(t + 2) * kstep; const char* b2 = last ? nB : cB + (size_t)(t + 2) * kstep;
            const char* a3 = a2 + kstep; const char* b3 = b2 + kstep;
            if (last && has_next) S.a_ready(nxt);
            if constexpr (SP2) {
            PG8_LDB(B0, 0, 0); PG8_LDB(B1, 0, 1); PG8_SCHED; PG8_LDA(At, 0, 0); PG8_STAGE(PG8_SA(1, 1), a1 + hstep, voffA);
            PG8_WAIT_V(8); PG8_WAIT_L(0); PG8_BAR; PG8_MMA(0, 0, At, B0); PG8_MMA(0, 1, At, B1); PG8_BAR; PG8_SCHED;
            PG8_LDA(At, 0, 1); PG8_STAGE(PG8_SB(0, 0), b2, voffB); PG8_STAGE(PG8_SB(0, 1), b2 + hstep, voffB); PG8_STAGE(PG8_SA(0, 0), a2, voffA);
            PG8_WAIT_V(8); PG8_WAIT_L(0); PG8_BAR; PG8_MMA(1, 0, At, B0); PG8_MMA(1, 1, At, B1); PG8_BAR; PG8_SCHED;
            PG8_LDB(B0, 1, 0); PG8_LDB(B1, 1, 1); PG8_SCHED; PG8_LDA(At, 1, 0); PG8_STAGE(PG8_SA(0, 1), a2 + hstep, voffA);
            PG8_WAIT_V(8); PG8_WAIT_L(0); PG8_BAR; PG8_MMA(0, 0, At, B0); PG8_MMA(0, 1, At, B1); PG8_BAR; PG8_SCHED;
            PG8_LDA(At, 1, 1); PG8_STAGE(PG8_SB(1, 0), b3, voffB); PG8_STAGE(PG8_SB(1, 1), b3 + hstep, voffB); PG8_STAGE(PG8_SA(1, 0), a3, voffA);
            PG8_WAIT_V(8); PG8_WAIT_L(0); PG8_BAR; PG8_MMA(1, 0, At, B0); PG8_MMA(1, 1, At, B1); PG8_BAR; PG8_SCHED;
            } else {
            PG8_LDB(B0, 0, 0); PG8_SCHED; PG8_LDA(At, 0, 0); PG8_STAGE(PG8_SA(1, 1), a1 + hstep, voffA);
            PG8_WAIT_L(8); PG8_BAR; PG8_WAIT_L(0); PG8_MMA(0, 0, At, B0); PG8_BAR; PG8_SCHED;
            PG8_LDB(B1, 0, 1); PG8_STAGE(PG8_SB(0, 0), b2, voffB);
            PG8_BAR; PG8_WAIT_L(0); PG8_MMA(0, 1, At, B1); PG8_BAR;
            PG8_LDA(At, 0, 1); PG8_STAGE(PG8_SA(0, 0), a2, voffA);
            PG8_BAR; PG8_WAIT_L(0); PG8_MMA(1, 0, At, B0); PG8_BAR; PG8_SCHED;
            PG8_STAGE(PG8_SB(0, 1), b2 + hstep, voffB);
            PG8_WAIT_V(6); PG8_BAR; PG8_MMA(1, 1, At, B1); PG8_BAR;
            PG8_LDB(B0, 1, 0); PG8_SCHED; PG8_LDA(At, 1, 0); PG8_STAGE(PG8_SA(0, 1), a2 + hstep, voffA);
            PG8_WAIT_L(8); PG8_BAR; PG8_WAIT_L(0); PG8_MMA(0, 0, At, B0); PG8_BAR; PG8_SCHED;
            PG8_LDB(B1, 1, 1); PG8_STAGE(PG8_SB(1, 0), b3, voffB);
            PG8_BAR; PG8_WAIT_L(0); PG8_MMA(0, 1, At, B1); PG8_BAR;
            PG8_LDA(At, 1, 1); PG8_STAGE(PG8_SA(1, 0), a3, voffA);
            PG8_BAR; PG8_WAIT_L(0); PG8_MMA(1, 0, At, B0); PG8_BAR; PG8_SCHED;
            PG8_STAGE(PG8_SB(1, 1), b3 + hstep, voffB);
            PG8_WAIT_V(6); PG8_BAR; PG8_MMA(1, 1, At, B1); PG8_BAR;
            }
        }
        if constexpr (ALIGN_EPI) { if (wr == 0) PG8_BAR; }
        if constexpr (!Epi::AFTER_DRAIN) { E(acc, cur, wr, wc, fr, fq); S.done(cur); }
        if (!has_next) break;
#pragma unroll
        for (int a = 0; a < 2; ++a)
#pragma unroll
            for (int b = 0; b < 2; ++b)
#pragma unroll
                for (int m = 0; m < 4; ++m)
#pragma unroll
                    for (int n = 0; n < 2; ++n) acc[a][b][m][n] = (f32x4){0.f, 0.f, 0.f, 0.f};
        cur = nxt; cA = nA; cB = nB; ++ui;
        if constexpr (ALIGN_EPI) { if (wr == 1) PG8_BAR; }
    }
    PG8_WAIT_V(0);
    if constexpr (!ALIGN_EPI) { if (wr == 0) PG8_BAR; }
    PG8_BAR;
    if constexpr (Epi::AFTER_DRAIN) { E.fused(acc, cur, wr, wc, fr, fq, lds, wid, lane); S.done(cur); }
#undef PG8_SA
#undef PG8_SB
#undef PG8_STAGE
#undef PG8_LDA
#undef PG8_LDB
#undef PG8_MMA
#undef PG8_WAIT_V
#undef PG8_WAIT_L
#undef PG8_BAR
#undef PG8_SCHED
}
}

#define LAS __attribute__((address_space(3)))
typedef unsigned short bf16_t;
typedef short bf16x8 __attribute__((ext_vector_type(8)));
typedef short s16x4 __attribute__((ext_vector_type(4)));
typedef float f32x4 __attribute__((ext_vector_type(4)));
typedef float f32x2 __attribute__((ext_vector_type(2)));
typedef float f32x16 __attribute__((ext_vector_type(16)));
typedef unsigned u32x4 __attribute__((ext_vector_type(4)));
typedef unsigned u32x2 __attribute__((ext_vector_type(2)));
typedef __bf16 bf16x2_t __attribute__((ext_vector_type(2)));

__device__ __forceinline__ unsigned pk2(float lo, float hi) { f32x2 v = {lo, hi}; bf16x2_t b = __builtin_convertvector(v, bf16x2_t); return __builtin_bit_cast(unsigned, b); }
__device__ __forceinline__ float bflo(unsigned u) { return __uint_as_float(u << 16); }
__device__ __forceinline__ float bfhi(unsigned u) { return __uint_as_float(u & 0xffff0000u); }
__device__ __forceinline__ float fexp(float x) { return __builtin_amdgcn_exp2f(x * 1.4426950408889634f); }
__device__ __forceinline__ float frcp(float x) { return __builtin_amdgcn_rcpf(x); }
__device__ __forceinline__ float sigmoidf_(float x) { return frcp(1.f + fexp(-x)); }
template <int CTRL> __device__ __forceinline__ float dpp(float x) { return __builtin_bit_cast(float, __builtin_amdgcn_update_dpp(0, __builtin_bit_cast(int, x), CTRL, 0xf, 0xf, true)); }
__device__ __forceinline__ float swap32_sum(float x) { auto rr = __builtin_amdgcn_permlane32_swap(__float_as_uint(x), __float_as_uint(x), false, false); return __uint_as_float(rr[0]) + __uint_as_float(rr[1]); }
__device__ __forceinline__ float swap32_max(float x) { auto rr = __builtin_amdgcn_permlane32_swap(__float_as_uint(x), __float_as_uint(x), false, false); return fmaxf(__uint_as_float(rr[0]), __uint_as_float(rr[1])); }
__device__ __forceinline__ float swap16_sum(float x) { auto rr = __builtin_amdgcn_permlane16_swap(__float_as_uint(x), __float_as_uint(x), false, false); return __uint_as_float(rr[0]) + __uint_as_float(rr[1]); }
__device__ __forceinline__ float sum8(float x) { x += dpp<0xB1>(x); x += dpp<0x4E>(x); x += dpp<0x141>(x); return x; }
__device__ __forceinline__ float wave_sum(float x) { x += dpp<0xB1>(x); x += dpp<0x4E>(x); x += dpp<0x141>(x); x += dpp<0x140>(x); x = swap16_sum(x); x = swap32_sum(x); return x; }

constexpr size_t MiB = 1u << 20;
constexpr size_t WS_CTL = 0, CTL_ZERO_BYTES = 65536;
constexpr int CW_BAR = 4096, LDS_BARW = 147424;
constexpr size_t WS_ROPE = 1 * MiB;
constexpr size_t WS_LF = 1 * MiB + 640 * 1024;
constexpr size_t WS_W1T = 2 * MiB;
constexpr size_t WS_W2T = 35 * MiB;
constexpr size_t WS_XN = 43 * MiB;
constexpr size_t WS_RKV = 108 * MiB;
constexpr size_t WS_GR = 207 * MiB;
constexpr size_t WS_WA = 240 * MiB;
constexpr size_t WS_QD = 245 * MiB, WS_KD = 278 * MiB, WS_VD = 311 * MiB, WS_GD = 344 * MiB;
constexpr size_t WS_Y = 377 * MiB;
constexpr size_t WS_SSQ = 451 * MiB;
constexpr size_t WS_TAIL = 441 * MiB;
constexpr size_t WS_END = 512 * MiB;
constexpr int LDS_BYTES = 147456;
constexpr int LDS_QW = 147440;

struct Args {
    const float* in[21]; float* out; unsigned char* ws; float inv_freq[32]; int ph_lo, ph_hi, coop, pad;
};

constexpr float C2 = 0.125f * 1.4426950408889634f;
struct EpiProj {
    static constexpr bool PERM = true, AFTER_DRAIN = false;
    bf16_t *RKV, *GR, *WA, *QD, *KD, *VD, *GD; const float* rope;
    __device__ __forceinline__ void operator()(const f32x4 (&acc)[2][2][4][2], const pg8::Unit& u, int wr, int wc, int fr, int fq) const {
        const int pn = u.pn; bf16_t* base; int ld, colt, kind = 0;
        if (pn < 12) { base = RKV; ld = 3072; colt = pn * 256; }
        else if (pn < 16) { base = GR; ld = 1024; colt = (pn - 12) * 256; }
        else if (pn < 20) { base = QD; ld = 1024; colt = (pn - 16) * 256; kind = 1; }
        else if (pn < 24) { base = KD; ld = 1024; colt = (pn - 20) * 256; kind = 2; }
        else if (pn < 28) { base = VD; ld = 1024; colt = (pn - 24) * 256; }
        else if (pn < 32) { base = GD; ld = 1024; colt = (pn - 28) * 256; }
        else { base = WA; ld = 128; colt = 0; kind = 3; }
        const bool meta = (u.pm == 64);
        const int pos0 = meta ? 0 : (NMETA + (u.pm & 7) * 256);
        const int brow0 = meta ? 0 : (u.pm >> 3) * LP;
        const int cl = wc * 32 + 8 * fq;
        const int i0 = ((wc & 1) * 16 + 4 * fq);
        const float qs = (kind == 1) ? C2 : 1.f;
#pragma unroll
        for (int ai = 0; ai < 2; ++ai)
#pragma unroll
            for (int m = 0; m < 4; ++m) {
                const int rt = ai * 128 + wr * 64 + m * 16 + fr;
                if (meta && rt >= NMETA) continue;
                const int pos = pos0 + rt;
#pragma unroll
                for (int bj = 0; bj < 2; ++bj) {
                    if (kind == 3 && bj == 1) continue;
                    f32x4 v0 = acc[ai][bj][m][0], v1 = acc[ai][bj][m][1];
                    if (kind == 1 || kind == 2) {
                        const f32x4 cs0 = *(const f32x4*)(rope + ((size_t)pos * 32 + i0) * 2), cs1 = *(const f32x4*)(rope + ((size_t)pos * 32 + i0) * 2 + 4);
                        f32x4 o0, o1;
                        o0[0] = (v0[0] * cs0[0] - v0[1] * cs0[1]) * qs; o0[1] = (v0[1] * cs0[0] + v0[0] * cs0[1]) * qs;
                        o0[2] = (v0[2] * cs0[2] - v0[3] * cs0[3]) * qs; o0[3] = (v0[3] * cs0[2] + v0[2] * cs0[3]) * qs;
                        o1[0] = (v1[0] * cs1[0] - v1[1] * cs1[1]) * qs; o1[1] = (v1[1] * cs1[0] + v1[0] * cs1[1]) * qs;
                        o1[2] = (v1[2] * cs1[2] - v1[3] * cs1[3]) * qs; o1[3] = (v1[3] * cs1[2] + v1[2] * cs1[3]) * qs;
                        v0 = o0; v1 = o1;
                    }
                    u32x4 w; w.x = pk2(v0[0], v0[1]); w.y = pk2(v0[2], v0[3]); w.z = pk2(v1[0], v1[1]); w.w = pk2(v1[2], v1[3]);
                    const int col = colt + bj * 128 + cl;
                    if (!meta) { *(u32x4*)(base + (size_t)(brow0 + pos) * ld + col) = w; }
                    else {
#pragma unroll
                        for (int b = 0; b < NB; ++b) *(u32x4*)(base + (size_t)(b * LP + pos) * ld + col) = w;
                    }
                }
            }
    }
};

struct EpiY {
    static constexpr bool PERM = true, AFTER_DRAIN = false;
    bf16_t* YO; float* SSQ;
    __device__ __forceinline__ void operator()(const f32x4 (&acc)[2][2][4][2], const pg8::Unit& u, int wr, int wc, int fr, int fq) const {
        const int cl = u.pn * 256 + wc * 32 + 8 * fq;
#pragma unroll
        for (int ai = 0; ai < 2; ++ai)
#pragma unroll
            for (int m = 0; m < 4; ++m) {
                const int row = u.pm * 256 + ai * 128 + wr * 64 + m * 16 + fr;
#pragma unroll
                for (int bj = 0; bj < 2; ++bj) {
                    const f32x4 v0 = acc[ai][bj][m][0], v1 = acc[ai][bj][m][1];
                    u32x4 w; w.x = pk2(v0[0], v0[1]); w.y = pk2(v0[2], v0[3]); w.z = pk2(v1[0], v1[1]); w.w = pk2(v1[2], v1[3]);
                    *(u32x4*)(YO + (size_t)row * DM + cl + bj * 128) = w;
                }
            }
    }
};

__device__ __forceinline__ int w1_src_col(int n) {
    const int t = n >> 8, ct = n & 255;
    if (t < 12) return n;
    if (t < 16) return 3200 + (n - 3072);
    if (t < 24) { const int base = 4224 + (t - 16) * 256, hc = ct >> 6, p = ct & 63; return base + hc * 64 + (p >> 1) + 32 * (p & 1); }
    if (t < 32) return 6272 + (n - 6144);
    return ct < 128 ? 3072 + ct : -1;
}
template <bool MAP> __device__ __forceinline__ void p0_transpose_item(const float* W, int NS, bf16_t* WT, int nblk, LAS float* scr, int item, int lane) {
    const int kb = item / nblk, nb = item % nblk, k0 = 64 * kb, n0 = 32 * nb;
    const int sc = MAP ? w1_src_col(n0 + (lane & 31)) : (n0 + (lane & 31));
#pragma unroll 8
    for (int i = 0; i < 32; ++i) { const int kk = 2 * i + (lane >> 5); scr[kk * 33 + (lane & 31)] = (sc >= 0) ? W[(size_t)(k0 + kk) * NS + sc] : 0.f; }
    asm volatile("s_waitcnt lgkmcnt(0)" ::: "memory");
    const int c = lane & 7;
#pragma unroll
    for (int j = 0; j < 4; ++j) { const int n = (lane >> 3) + 8 * j; const LAS float* s = scr + (8 * c) * 33 + n;
        u32x4 o; o.x = pk2(s[0 * 33], s[1 * 33]); o.y = pk2(s[2 * 33], s[3 * 33]); o.z = pk2(s[4 * 33], s[5 * 33]); o.w = pk2(s[6 * 33], s[7 * 33]);
        *(u32x4*)(WT + (size_t)(n0 + n) * 2048 + k0 + 8 * c) = o; }
    asm volatile("s_waitcnt lgkmcnt(0)" ::: "memory");
}


__device__ __forceinline__ int w1_dst_row(int j) {
    if (j < 3072) return j;
    if (j < 3200) return 8192 + (j - 3072);
    if (j < 4224) return 3072 + (j - 3200);
    if (j < 6272) { const int rel = j - 4224, d = rel & 63, grp = rel >> 6; return 4096 + grp * 64 + ((d < 32) ? 2 * d : 2 * (d - 32) + 1); }
    return 6144 + (j - 6272);
}
template <bool MAP> __device__ __forceinline__ void p0_transpose128(const float* W, int NS, bf16_t* WT, int nblk, LAS float* scr, int item, int lane) {
    const int kb = item / nblk, nb = item % nblk, k0 = 32 * kb, n0 = 128 * nb;
#pragma unroll 4
    for (int i = 0; i < 16; ++i) { const int k = 2 * i + (lane >> 5); *(LAS f32x4*)(scr + k * 132 + 4 * (lane & 31)) = *(const f32x4*)(W + (size_t)(k0 + k) * NS + n0 + 4 * (lane & 31)); }
    asm volatile("s_waitcnt lgkmcnt(0)" ::: "memory");
    const int kq = lane >> 4, nl = lane & 15;
#pragma unroll
    for (int p = 0; p < 8; ++p) { const int n = 16 * p + nl; const LAS float* sp = scr + (8 * kq) * 132 + n;
        u32x4 o; o.x = pk2(sp[0 * 132], sp[1 * 132]); o.y = pk2(sp[2 * 132], sp[3 * 132]); o.z = pk2(sp[4 * 132], sp[5 * 132]); o.w = pk2(sp[6 * 132], sp[7 * 132]);
        const int dr = MAP ? w1_dst_row(n0 + n) : (n0 + n);
        *(u32x4*)(WT + (size_t)dr * 2048 + k0 + 8 * kq) = o; }
    asm volatile("s_waitcnt lgkmcnt(0)" ::: "memory");
}

constexpr int P0_NB1 = NIN / 64, P0_I1 = 32 * P0_NB1, P0_I2 = 32 * 32;
__device__ __forceinline__ void p0_ld(f32x4 (&r)[16], const Args& A, int it, int lane) {
    const bool w1 = it < P0_I1; const float* W = w1 ? A.in[3] : A.in[19]; const int NS = w1 ? NIN : 2048, nblk = w1 ? P0_NB1 : 32, item = w1 ? it : it - P0_I1;
    const int kb = item / nblk, nb = item % nblk;
    const float* p = W + (size_t)(64 * kb + (lane >> 4)) * NS + 64 * nb + 4 * (lane & 15);
#pragma unroll
    for (int i = 0; i < 16; ++i) r[i] = __builtin_nontemporal_load((const f32x4*)(p + (size_t)(4 * i) * NS));
}
__device__ __forceinline__ void p0_emit(const f32x4 (&r)[16], bf16_t* W1T, bf16_t* W2T, LAS float* scr, int it, int lane) {
    const bool w1 = it < P0_I1; const int nblk = w1 ? P0_NB1 : 32, item = w1 ? it : it - P0_I1;
    const int kb = item / nblk, nb = item % nblk, k0 = 64 * kb, n0 = 64 * nb;
#pragma unroll
    for (int i = 0; i < 16; ++i) *(LAS f32x4*)(scr + (4 * i + (lane >> 4)) * 68 + 4 * (lane & 15)) = r[i];
    asm volatile("s_waitcnt lgkmcnt(0)" ::: "memory");
    bf16_t* WT = w1 ? W1T : W2T;
    const int dr = w1 ? w1_dst_row(n0 + lane) : (n0 + lane);
    bf16_t* dst = WT + (size_t)dr * 2048 + k0;
#pragma unroll
    for (int p = 0; p < 8; ++p) { const LAS float* sp = scr + (8 * p) * 68 + lane;
        u32x4 o; o.x = pk2(sp[0 * 68], sp[1 * 68]); o.y = pk2(sp[2 * 68], sp[3 * 68]); o.z = pk2(sp[4 * 68], sp[5 * 68]); o.w = pk2(sp[6 * 68], sp[7 * 68]);
        *(u32x4*)(dst + 8 * p) = o; }
    asm volatile("s_waitcnt lgkmcnt(0)" ::: "memory");
}

constexpr int RW_NCH = 65, RW_TASKS = 128 * RW_NCH, RW_TB = 24832;
constexpr int RW_SEG0 = 5400;
__device__ __forceinline__ unsigned char* rw_block(const Args& A, int task) {
    if (task < RW_SEG0) return (unsigned char*)A.out + (size_t)task * RW_TB;
    return A.ws + WS_TAIL + (size_t)(task - RW_SEG0) * RW_TB;
}
__device__ __forceinline__ int Tk(int r, int hi) { return (r & 3) + 8 * (r >> 2) + 4 * hi; }
__device__ __forceinline__ bf16x8 pack8(const f32x16& x, int s) {
    return __builtin_bit_cast(bf16x8, (u32x4){pk2(x[8 * s], x[8 * s + 1]), pk2(x[8 * s + 2], x[8 * s + 3]), pk2(x[8 * s + 4], x[8 * s + 5]), pk2(x[8 * s + 6], x[8 * s + 7])});
}
__device__ __forceinline__ bf16x8 neg8(bf16x8 v) { u32x4 u = __builtin_bit_cast(u32x4, v); u ^= (u32x4){0x80008000u, 0x80008000u, 0x80008000u, 0x80008000u}; return __builtin_bit_cast(bf16x8, u); }
__device__ __forceinline__ float sum32h(float x) { x += dpp<0xB1>(x); x += dpp<0x4E>(x); x += dpp<0x141>(x); x += dpp<0x140>(x); return swap16_sum(x); }
#define MFMA32(a, b, c) __builtin_amdgcn_mfma_f32_32x32x16_bf16((a), (b), (c), 0, 0, 0)

#define BUFR(p, bytes) __builtin_amdgcn_make_buffer_rsrc((void*)(p), (short)0, (int)(bytes), 0x00020000)
#define SBAR0 do {} while (0)
namespace rwa {
__device__ __forceinline__ unsigned offm(unsigned t, unsigned p) { const unsigned f = (((t >> 1) & 1u) << 2) | ((t >> 2) & 3u); return 128u * t + 16u * ((p >> 3) ^ f) + 2u * (p & 7u); }
__device__ __forceinline__ void st16(LAS unsigned char* p, float x) { *(LAS bf16_t*)p = (bf16_t)(pk2(x, 0.f) & 0xffffu); }

__device__ __forceinline__ void task(const Args& A, int task, LAS unsigned char* wl, int lane_) {
    int lane = lane_; asm volatile("" : "+v"(lane));
    const int n = lane & 31, hi = lane >> 5;
    const int ch = task / RW_NCH, c = task - ch * RW_NCH, b = ch >> 4, h = ch & 15, t0 = 32 * c;
    const size_t rowb = (size_t)b * LP + t0;
    const __amdgpu_buffer_rsrc_t rR = BUFR((const bf16_t*)(A.ws + WS_RKV) + (rowb - 1) * 3072 + h * 64, 34 * 6144);
    const __amdgpu_buffer_rsrc_t rW = BUFR((const bf16_t*)(A.ws + WS_WA) + (rowb - 1) * 128, 34 * 256);
    const __amdgpu_buffer_rsrc_t rL = BUFR((const unsigned char*)(A.ws + WS_LF) + (size_t)h * 16384, 16384);
    unsigned char* ob = rw_block(A, task);
    const __amdgpu_buffer_rsrc_t rO = BUFR(ob, RW_TB);
    const __amdgpu_buffer_rsrc_t rPQ = BUFR(ob, (c == RW_NCH - 1) ? 0 : RW_TB);
    const float* mu = A.in[4];
    f32x16 accw[2], acca[2];
#pragma unroll
    for (int i = 0; i < 16; ++i) { accw[0][i] = 0.f; accw[1][i] = 0.f; acca[0][i] = 0.f; acca[1][i] = 0.f; }
    {
        const bool hasp = (t0 + n) > 0;
        const unsigned vo = (unsigned)(n * 256 + 16 * hi);
        u32x4 wcw[4], wca[4], wpw[4], wpa[4], lfw[4][2], lfa[4][2];
#pragma unroll
        for (int s = 0; s < 4; ++s) {
            wcw[s] = __builtin_amdgcn_raw_buffer_load_b128(rW, vo, 256 + 32 * s, 0); wca[s] = __builtin_amdgcn_raw_buffer_load_b128(rW, vo, 256 + 128 + 32 * s, 0);
            wpw[s] = __builtin_amdgcn_raw_buffer_load_b128(rW, vo, 32 * s, 0); wpa[s] = __builtin_amdgcn_raw_buffer_load_b128(rW, vo, 128 + 32 * s, 0); }
#pragma unroll
        for (int s = 0; s < 4; ++s)
#pragma unroll
            for (int nb = 0; nb < 2; ++nb) { lfw[s][nb] = __builtin_amdgcn_raw_buffer_load_b128(rL, (unsigned)lane * 16u, ((0 * 2 + nb) * 4 + s) * 1024, 0);
                                             lfa[s][nb] = __builtin_amdgcn_raw_buffer_load_b128(rL, (unsigned)lane * 16u, ((1 * 2 + nb) * 4 + s) * 1024, 0); }
        asm volatile("" ::: "memory");
#pragma unroll
        for (int s = 0; s < 4; ++s) {
            const u32x4 cw = wcw[s], ca = wca[s];
            u32x4 pw = wpw[s], pa = wpa[s];
            if (!hasp) { pw = (u32x4){0u, 0u, 0u, 0u}; pa = (u32x4){0u, 0u, 0u, 0u}; }
            const f32x4 mw0 = *(const f32x4*)(mu + 3072 + 16 * s + 8 * hi), mw1 = *(const f32x4*)(mu + 3072 + 16 * s + 8 * hi + 4);
            const f32x4 ma0 = *(const f32x4*)(mu + 3136 + 16 * s + 8 * hi), ma1 = *(const f32x4*)(mu + 3136 + 16 * s + 8 * hi + 4);
            const float mwv[8] = {mw0[0], mw0[1], mw0[2], mw0[3], mw1[0], mw1[1], mw1[2], mw1[3]}, mav[8] = {ma0[0], ma0[1], ma0[2], ma0[3], ma1[0], ma1[1], ma1[2], ma1[3]};
            float xw[8], xa[8];
#pragma unroll
            for (int j = 0; j < 4; ++j) {
                const float c0 = bflo(cw[j]), c1 = bfhi(cw[j]), p0 = bflo(pw[j]), p1 = bfhi(pw[j]);
                const float w0_ = c0 + (p0 - c0) * mwv[2 * j], w1_ = c1 + (p1 - c1) * mwv[2 * j + 1];
                xw[2 * j] = 1.f - 2.f * frcp(fexp(2.f * w0_) + 1.f); xw[2 * j + 1] = 1.f - 2.f * frcp(fexp(2.f * w1_) + 1.f);
                const float d0 = bflo(ca[j]), d1 = bfhi(ca[j]), q0 = bflo(pa[j]), q1 = bfhi(pa[j]);
                xa[2 * j] = d0 + (q0 - d0) * mav[2 * j]; xa[2 * j + 1] = d1 + (q1 - d1) * mav[2 * j + 1];
            }
            const bf16x8 Aw = __builtin_bit_cast(bf16x8, (u32x4){pk2(xw[0], xw[1]), pk2(xw[2], xw[3]), pk2(xw[4], xw[5]), pk2(xw[6], xw[7])});
            const bf16x8 Aa = __builtin_bit_cast(bf16x8, (u32x4){pk2(xa[0], xa[1]), pk2(xa[2], xa[3]), pk2(xa[4], xa[5]), pk2(xa[6], xa[7])});
#pragma unroll
            for (int nb = 0; nb < 2; ++nb) {
                accw[nb] = MFMA32(Aw, __builtin_bit_cast(bf16x8, lfw[s][nb]), accw[nb]); acca[nb] = MFMA32(Aa, __builtin_bit_cast(bf16x8, lfa[s][nb]), acca[nb]);
            }
            SBAR0;
        }
    }
    __builtin_amdgcn_s_barrier();
    const f32x2 w0v = *(const f32x2*)(A.in[5] + h * 64 + 2 * n), a0v = *(const f32x2*)(A.in[7] + h * 64 + 2 * n);
    float gC[2]; unsigned aap[2][8];
#pragma unroll
    for (int nb = 0; nb < 2; ++nb) {
        float prod = 1.f;
#pragma unroll
        for (int r = 0; r < 16; ++r) { const bool valid = (t0 + Tk(r, hi)) < LSEQ; const float sg = sigmoidf_(accw[nb][r] + w0v[nb]); const float d = valid ? fexp(-0.6065306597126334f * sg) : 1.f; accw[nb][r] = d; prod *= d; }
        const auto sw = __builtin_amdgcn_permlane32_swap(__float_as_uint(prod), __float_as_uint(prod), false, false);
        gC[nb] = __uint_as_float(sw[0]) * __uint_as_float(sw[1]);
#pragma unroll
        for (int i = 0; i < 8; ++i) aap[nb][i] = pk2(sigmoidf_(acca[nb][2 * i] + a0v[nb]), sigmoidf_(acca[nb][2 * i + 1] + a0v[nb]));
    }
    SBAR0;
    const f32x2 mur = *(const f32x2*)(mu + h * 64 + 2 * n), muk = *(const f32x2*)(mu + 1024 + h * 64 + 2 * n);
    const f32x2 kkw = *(const f32x2*)(A.in[9] + h * 64 + 2 * n), kaw = *(const f32x2*)(A.in[10] + h * 64 + 2 * n), rkw = *(const f32x2*)(A.in[11] + h * 64 + 2 * n);
    const unsigned voR = (unsigned)(hi * 4 * 6144 + 4 * n);
    u32x4 pKKg[2][2], pBc[2][2], pKc[2][2];
    const __amdgpu_buffer_rsrc_t rB = BUFR(ob + 24576, 128);
    float run0 = 1.f, run1 = 1.f;
    unsigned crn[5], ckn[5];
#pragma unroll
    for (int i = 0; i < 5; ++i) { crn[i] = __builtin_amdgcn_raw_buffer_load_b32(rR, voR, i * 6144, 0); ckn[i] = __builtin_amdgcn_raw_buffer_load_b32(rR, voR, i * 6144 + 2048, 0); }
#pragma unroll
    for (int g = 0; g < 4; ++g) {
        int ln = lane; asm volatile("" : "+v"(ln)); const int n2 = ln & 31, hi2 = ln >> 5;
        unsigned crg[5], ckg[5];
#pragma unroll
        for (int i = 0; i < 5; ++i) { crg[i] = crn[i]; ckg[i] = ckn[i]; }
        if (t0 + Tk(4 * g, hi2) == 0) { crg[0] = 0u; ckg[0] = 0u; }
        if (g < 3) {
#pragma unroll
            for (int i = 0; i < 5; ++i) { crn[i] = __builtin_amdgcn_raw_buffer_load_b32(rR, voR, (8 * (g + 1) + i) * 6144, 0); ckn[i] = __builtin_amdgcn_raw_buffer_load_b32(rR, voR, (8 * (g + 1) + i) * 6144 + 2048, 0); }
        }
        float Gi[2][4], Gx[2][4];
#pragma unroll
        for (int nb = 0; nb < 2; ++nb) {
            const float p0 = accw[nb][4 * g], p1 = p0 * accw[nb][4 * g + 1], p2 = p1 * accw[nb][4 * g + 2], p3 = p2 * accw[nb][4 * g + 3];
            const auto sw = __builtin_amdgcn_permlane32_swap(__float_as_uint(p3), __float_as_uint(p3), false, false);
            const float other = hi2 ? __uint_as_float(sw[0]) : __uint_as_float(sw[1]);
            const float run = nb ? run1 : run0;
            const float pre = hi2 ? run * other : run;
            Gi[nb][0] = pre * p0; Gi[nb][1] = pre * p1; Gi[nb][2] = pre * p2; Gi[nb][3] = pre * p3;
            Gx[nb][0] = pre; Gx[nb][1] = pre * p0; Gx[nb][2] = pre * p1; Gx[nb][3] = pre * p2;
            if (nb) run1 = run * p3 * other; else run0 = run * p3 * other;
        }
#pragma unroll
        for (int hp = 0; hp < 2; ++hp) {
            float oKKg[2][2], oBc[2][2], oKc[2][2];
#pragma unroll
            for (int e = 0; e < 2; ++e) {
                const int i4 = 2 * hp + e, r = 4 * g + i4, T = Tk(r, hi2);
                const bool valid = (t0 + T) < LSEQ;
                const unsigned cr_ = crg[i4 + 1], pr = crg[i4], ck_ = ckg[i4 + 1], pk = ckg[i4];
                float rr[2], kr[2];
                { const float c0 = bflo(cr_), c1 = bfhi(cr_), p0 = bflo(pr), p1 = bfhi(pr); rr[0] = valid ? c0 + (p0 - c0) * mur[0] : 0.f; rr[1] = valid ? c1 + (p1 - c1) * mur[1] : 0.f; }
                { const float c0 = bflo(ck_), c1 = bfhi(ck_), p0 = bflo(pk), p1 = bfhi(pk); kr[0] = c0 + (p0 - c0) * muk[0]; kr[1] = c1 + (p1 - c1) * muk[1]; }
                const float a0_ = (r & 1) ? bfhi(aap[0][r >> 1]) : bflo(aap[0][r >> 1]), a1_ = (r & 1) ? bfhi(aap[1][r >> 1]) : bflo(aap[1][r >> 1]);
                float k0 = kr[0] * kkw[0], k1 = kr[1] * kkw[1];
                const float ss = sum32h(k0 * k0 + k1 * k1); const float inv = valid ? __builtin_amdgcn_rsqf(fmaxf(ss, 1e-24f)) : 0.f;
                k0 *= inv; k1 *= inv;
                const float kp0 = valid ? kr[0] * (1.f + (a0_ - 1.f) * kaw[0]) : 0.f, kp1 = valid ? kr[1] * (1.f + (a1_ - 1.f) * kaw[1]) : 0.f;
                const float bs = sum32h(rr[0] * kp0 * rkw[0] + rr[1] * kp1 * rkw[1]);
                if (n2 == 0) __builtin_amdgcn_raw_buffer_store_b32(__float_as_uint(bs), rB, (unsigned)(hi2 * 16), 4 * (i4 + 8 * g), 0);
                const float ig0 = frcp(Gi[0][i4]), ig1 = frcp(Gi[1][i4]);
                const float kkg0 = k0 * Gx[0][i4], kkg1 = k1 * Gx[1][i4], rg0 = rr[0] * Gi[0][i4], rg1 = rr[1] * Gi[1][i4];
                const float bi0 = k0 * a0_ * ig0, bi1 = k1 * a1_ * ig1, ki0 = kp0 * ig0, ki1 = kp1 * ig1;
                LAS unsigned char* q0 = wl + offm(T, n2); LAS unsigned char* q1 = wl + offm(T, 32 + n2);
                st16(q0, kkg0); st16(q1, kkg1); st16(q0 + 4096, rg0); st16(q1 + 4096, rg1); st16(q0 + 8192, bi0); st16(q1 + 8192, bi1); st16(q0 + 12288, ki0); st16(q1 + 12288, ki1);
                oKKg[0][e] = kkg0; oKKg[1][e] = kkg1; oBc[0][e] = bi0 * gC[0]; oBc[1][e] = bi1 * gC[1]; oKc[0][e] = ki0 * gC[0]; oKc[1][e] = ki1 * gC[1];
            }
#pragma unroll
            for (int nb = 0; nb < 2; ++nb) { pKKg[nb][g >> 1][2 * (g & 1) + hp] = pk2(oKKg[nb][0], oKKg[nb][1]); pBc[nb][g >> 1][2 * (g & 1) + hp] = pk2(oBc[nb][0], oBc[nb][1]); pKc[nb][g >> 1][2 * (g & 1) + hp] = pk2(oKc[nb][0], oKc[nb][1]); }
            SBAR0;
        }
    }
    bf16x8 fKKg[2][2], fBc[2][2], fKc[2][2], fV[2][2];
#pragma unroll
    for (int nb = 0; nb < 2; ++nb)
#pragma unroll
        for (int s_ = 0; s_ < 2; ++s_) { fKKg[nb][s_] = __builtin_bit_cast(bf16x8, pKKg[nb][s_]); fBc[nb][s_] = __builtin_bit_cast(bf16x8, pBc[nb][s_]); fKc[nb][s_] = __builtin_bit_cast(bf16x8, pKc[nb][s_]); }
    {
        const unsigned voV = (unsigned)(hi * 4 * 6144 + 4 * n);
        const f32x2 muv = *(const f32x2*)(mu + 2048 + h * 64 + 2 * n);
        unsigned cv[16], pv4[4]; f32x16 x0, x1;
#pragma unroll
        for (int r = 0; r < 16; ++r) { const int T0 = (r & 3) + 8 * (r >> 2); cv[r] = __builtin_amdgcn_raw_buffer_load_b32(rR, voV, (T0 + 1) * 6144 + 4096, 0); }
#pragma unroll
        for (int g = 0; g < 4; ++g) pv4[g] = __builtin_amdgcn_raw_buffer_load_b32(rR, voV, (8 * g) * 6144 + 4096, 0);
        asm volatile("" : "+v"(pv4[0]), "+v"(pv4[1]), "+v"(pv4[2]), "+v"(pv4[3]));
#pragma unroll
        for (int g = 0; g < 4; ++g) if (t0 + Tk(4 * g, hi) == 0) pv4[g] = 0u;
#pragma unroll
        for (int r = 0; r < 16; ++r) { const unsigned pv = (r & 3) ? cv[r - 1] : pv4[r >> 2]; const bool valid = (t0 + Tk(r, hi)) < LSEQ;
            const float c0 = bflo(cv[r]), c1 = bfhi(cv[r]), p0 = bflo(pv), p1 = bfhi(pv);
            x0[r] = valid ? c0 + (p0 - c0) * muv[0] : 0.f; x1[r] = valid ? c1 + (p1 - c1) * muv[1] : 0.f; }
        fV[0][0] = pack8(x0, 0); fV[0][1] = pack8(x0, 1); fV[1][0] = pack8(x1, 0); fV[1][1] = pack8(x1, 1);
    }
    asm volatile("s_waitcnt lgkmcnt(0)" ::: "memory");
    SBAR0;
    __builtin_amdgcn_s_barrier();
    f32x16 Sbb, Sbk, Arb, Ark;
#pragma unroll
    for (int i = 0; i < 16; ++i) { Sbb[i] = 0.f; Sbk[i] = 0.f; Arb[i] = 0.f; Ark[i] = 0.f; }
#pragma unroll
    for (int s = 0; s < 4; ++s) {
        const unsigned o = offm(n, 16 * s + 8 * hi);
        const bf16x8 kg = *(const LAS bf16x8*)(wl + 0 * 4096 + o), rg = *(const LAS bf16x8*)(wl + 1 * 4096 + o), bi = *(const LAS bf16x8*)(wl + 2 * 4096 + o), ki = *(const LAS bf16x8*)(wl + 3 * 4096 + o);
        Sbb = MFMA32(bi, kg, Sbb); Sbk = MFMA32(ki, kg, Sbk); Arb = MFMA32(bi, rg, Arb); Ark = MFMA32(ki, rg, Ark);
        SBAR0;
    }
#pragma unroll
    for (int r = 0; r < 16; ++r) { const int j = Tk(r, hi); if (!(j < n)) { Sbb[r] = 0.f; Sbk[r] = 0.f; } if (!(j <= n)) { Arb[r] = 0.f; Ark[r] = 0.f; } }
    SBAR0;
    f32x16 Yl[2]; bf16x8 fZ[2][2];
    {
        const bf16x8 sk0 = pack8(Sbk, 0), sk1 = pack8(Sbk, 1), ak0 = pack8(Ark, 0), ak1 = pack8(Ark, 1);
#pragma unroll
        for (int vt = 0; vt < 2; ++vt) {
            f32x16 z;
#pragma unroll
            for (int i = 0; i < 16; ++i) z[i] = 0.f;
            const f32x16 zz = MFMA32(sk1, fV[vt][1], MFMA32(sk0, fV[vt][0], z));
            fZ[vt][0] = pack8(zz, 0); fZ[vt][1] = pack8(zz, 1);
            Yl[vt] = MFMA32(ak1, fV[vt][1], MFMA32(ak0, fV[vt][0], z));
        }
    }
#pragma unroll
    for (int i = 0; i < 2; ++i)
#pragma unroll
        for (int s_ = 0; s_ < 2; ++s_) { *(LAS bf16x8*)(wl + 8192 + ((i * 2 + s_) * 64 + lane) * 16) = fKc[i][s_]; *(LAS bf16x8*)(wl + 12288 + ((i * 2 + s_) * 64 + lane) * 16) = fV[i][s_]; }
    const bf16x8 fArb0 = pack8(Arb, 0), fArb1 = pack8(Arb, 1);
    SBAR0;
    __builtin_amdgcn_s_barrier();
    float TH[16];
    {
        LAS float* Mc = (LAS float*)wl;
#pragma unroll
        for (int r = 0; r < 16; ++r) Mc[Tk(r, hi) * 32 + n] = Sbb[r];
        asm volatile("s_waitcnt lgkmcnt(0)" ::: "memory");
#pragma unroll
        for (int i = 0; i < 16; ++i) TH[i] = ((4 * (2 * (i >> 2) + hi) + (i & 3)) == n) ? 1.f : 0.f;
        unsigned mh = (unsigned)(size_t)(Mc + 4 * hi);
        f32x4 mcur[4], mnxt[4];
        mcur[3] = *(const LAS f32x4*)(size_t)(mh + (30 * 32 + 8 * 3) * 4);
        mnxt[0] = mnxt[1] = mnxt[2] = mnxt[3] = mcur[3];
#pragma unroll
        for (int c = 30; c >= 0; --c) {
            if (c > 0) {
#pragma unroll
                for (int qq = (c >> 3); qq < 4; ++qq) mnxt[qq] = *(const LAS f32x4*)(size_t)(mh + ((c - 1) * 32 + 8 * qq) * 4);
            }
            float part = 0.f;
#pragma unroll
            for (int qq = ((c + 1) >> 3); qq < 4; ++qq) part += (TH[4 * qq] * mcur[qq][0] + TH[4 * qq + 1] * mcur[qq][1]) + (TH[4 * qq + 2] * mcur[qq][2] + TH[4 * qq + 3] * mcur[qq][3]);
            float tot = swap32_sum(part);
            asm volatile("" : "+v"(mh), "+v"(tot));
            const int idx = 4 * (c >> 3) + (c & 3), owner = (c >> 2) & 1;
            TH[idx] = (hi == owner) ? ((c == n) ? 1.f : -tot) : TH[idx];
#pragma unroll
            for (int qq = 0; qq < 4; ++qq) mcur[qq] = mnxt[qq];
        }
    }
    bf16x8 fT[2];
#pragma unroll
    for (int s_ = 0; s_ < 2; ++s_) fT[s_] = __builtin_bit_cast(bf16x8, (u32x4){pk2(TH[8 * s_], TH[8 * s_ + 1]), pk2(TH[8 * s_ + 2], TH[8 * s_ + 3]), pk2(TH[8 * s_ + 4], TH[8 * s_ + 5]), pk2(TH[8 * s_ + 6], TH[8 * s_ + 7])});
    SBAR0;
    __builtin_amdgcn_s_barrier();
    bf16x8 fKKt[2][2], fW[2][2];
#pragma unroll
    for (int i = 0; i < 2; ++i) {
        f32x16 z;
#pragma unroll
        for (int q = 0; q < 16; ++q) z[q] = 0.f;
        const f32x16 kkt = MFMA32(fT[1], fKKg[i][1], MFMA32(fT[0], fKKg[i][0], z));
        const f32x16 w = MFMA32(fT[1], fZ[i][1], MFMA32(fT[0], fZ[i][0], z));
        fKKt[i][0] = pack8(kkt, 0); fKKt[i][1] = pack8(kkt, 1); fW[i][0] = neg8(pack8(w, 0)); fW[i][1] = neg8(pack8(w, 1));
    }
    SBAR0;
    const unsigned vo16 = (unsigned)lane * 16u;
#pragma unroll
    for (int i = 0; i < 2; ++i)
#pragma unroll
        for (int s_ = 0; s_ < 2; ++s_) { fKc[i][s_] = *(const LAS bf16x8*)(wl + 8192 + ((i * 2 + s_) * 64 + lane) * 16); fV[i][s_] = *(const LAS bf16x8*)(wl + 12288 + ((i * 2 + s_) * 64 + lane) * 16); }
#pragma unroll
    for (int kt = 0; kt < 2; ++kt)
#pragma unroll
        for (int kp = 0; kp < 2; ++kp) {
            f32x16 z;
#pragma unroll
            for (int q = 0; q < 16; ++q) z[q] = 0.f;
            f32x16 a = MFMA32(fKKt[kp][1], fBc[kt][1], MFMA32(fKKt[kp][0], fBc[kt][0], z));
#pragma unroll
            for (int r = 0; r < 16; ++r) a[r] = ((kt == kp && Tk(r, hi) == n) ? gC[kt] : 0.f) - a[r];
            __builtin_amdgcn_raw_buffer_store_b128(__builtin_bit_cast(u32x4, pack8(a, 0)), rPQ, vo16, ((kt * 2 + kp) * 2 + 0) * 1024, 0);
            __builtin_amdgcn_raw_buffer_store_b128(__builtin_bit_cast(u32x4, pack8(a, 1)), rPQ, vo16, ((kt * 2 + kp) * 2 + 1) * 1024, 0);
        }
    SBAR0;
#pragma unroll
    for (int kt = 0; kt < 2; ++kt)
#pragma unroll
        for (int vt = 0; vt < 2; ++vt) {
            f32x16 z;
#pragma unroll
            for (int q = 0; q < 16; ++q) z[q] = 0.f;
            f32x16 a = MFMA32(fKc[kt][1], fV[vt][1], MFMA32(fKc[kt][0], fV[vt][0], z));
            a = MFMA32(fBc[kt][1], fW[vt][1], MFMA32(fBc[kt][0], fW[vt][0], a));
            __builtin_amdgcn_raw_buffer_store_b128(__builtin_bit_cast(u32x4, pack8(a, 0)), rPQ, vo16, 8192 + ((kt * 2 + vt) * 2 + 0) * 1024, 0);
            __builtin_amdgcn_raw_buffer_store_b128(__builtin_bit_cast(u32x4, pack8(a, 1)), rPQ, vo16, 8192 + ((kt * 2 + vt) * 2 + 1) * 1024, 0);
        }
    SBAR0;
#pragma unroll
    for (int kp = 0; kp < 2; ++kp) {
        f32x16 z;
#pragma unroll
        for (int q = 0; q < 16; ++q) z[q] = 0.f;
        f32x16 a = MFMA32(fKKt[kp][1], fArb1, MFMA32(fKKt[kp][0], fArb0, z));
#pragma unroll
        for (int g = 0; g < 4; ++g) { const u32x2 rg = *(const LAS u32x2*)(wl + 1 * 4096 + offm(n, kp * 32 + 8 * g + 4 * hi));
            a[4 * g] = bflo(rg.x) - a[4 * g]; a[4 * g + 1] = bfhi(rg.x) - a[4 * g + 1]; a[4 * g + 2] = bflo(rg.y) - a[4 * g + 2]; a[4 * g + 3] = bfhi(rg.y) - a[4 * g + 3]; }
        __builtin_amdgcn_raw_buffer_store_b128(__builtin_bit_cast(u32x4, pack8(a, 0)), rO, vo16, 16384 + (kp * 2 + 0) * 1024, 0);
        __builtin_amdgcn_raw_buffer_store_b128(__builtin_bit_cast(u32x4, pack8(a, 1)), rO, vo16, 16384 + (kp * 2 + 1) * 1024, 0);
    }
    SBAR0;
#pragma unroll
    for (int vt = 0; vt < 2; ++vt) {
        const f32x16 a = MFMA32(fArb1, fW[vt][1], MFMA32(fArb0, fW[vt][0], Yl[vt]));
        __builtin_amdgcn_raw_buffer_store_b128(__builtin_bit_cast(u32x4, pack8(a, 0)), rO, vo16, 20480 + (vt * 2 + 0) * 1024, 0);
        __builtin_amdgcn_raw_buffer_store_b128(__builtin_bit_cast(u32x4, pack8(a, 1)), rO, vo16, 20480 + (vt * 2 + 1) * 1024, 0);
    }
    asm volatile("s_waitcnt lgkmcnt(0)" ::: "memory");
}
}

namespace rwb {
__device__ __forceinline__ f32x16 unpack16(u32x4 a, u32x4 b) {
    f32x16 x; x[0] = bflo(a.x); x[1] = bfhi(a.x); x[2] = bflo(a.y); x[3] = bfhi(a.y); x[4] = bflo(a.z); x[5] = bfhi(a.z); x[6] = bflo(a.w); x[7] = bfhi(a.w);
    x[8] = bflo(b.x); x[9] = bfhi(b.x); x[10] = bflo(b.y); x[11] = bfhi(b.y); x[12] = bflo(b.z); x[13] = bfhi(b.z); x[14] = bflo(b.w); x[15] = bfhi(b.w); return x;
}
struct Frags { u32x4 P[2][2][2]; u32x4 Q[2][2]; u32x4 R[2][2]; u32x4 Y[2]; };
__device__ __forceinline__ void load_frags_pr(Frags& F, __amdgpu_buffer_rsrc_t rb, unsigned vo16) {
#pragma unroll
    for (int kt = 0; kt < 2; ++kt)
#pragma unroll
        for (int kp = 0; kp < 2; ++kp) { F.P[kt][kp][0] = __builtin_amdgcn_raw_buffer_load_b128(rb, vo16, ((kt * 2 + kp) * 2 + 0) * 1024, 0); F.P[kt][kp][1] = __builtin_amdgcn_raw_buffer_load_b128(rb, vo16, ((kt * 2 + kp) * 2 + 1) * 1024, 0); }
#pragma unroll
    for (int kp = 0; kp < 2; ++kp) { F.R[kp][0] = __builtin_amdgcn_raw_buffer_load_b128(rb, vo16, 16384 + (kp * 2 + 0) * 1024, 0); F.R[kp][1] = __builtin_amdgcn_raw_buffer_load_b128(rb, vo16, 16384 + (kp * 2 + 1) * 1024, 0); }
}
template <int VT> __device__ __forceinline__ void load_frags_qy(Frags& F, __amdgpu_buffer_rsrc_t rb, unsigned vo16) {
#pragma unroll
    for (int kt = 0; kt < 2; ++kt) { F.Q[kt][0] = __builtin_amdgcn_raw_buffer_load_b128(rb, vo16, 8192 + ((kt * 2 + VT) * 2 + 0) * 1024, 0); F.Q[kt][1] = __builtin_amdgcn_raw_buffer_load_b128(rb, vo16, 8192 + ((kt * 2 + VT) * 2 + 1) * 1024, 0); }
    F.Y[0] = __builtin_amdgcn_raw_buffer_load_b128(rb, vo16, 20480 + (VT * 2 + 0) * 1024, 0); F.Y[1] = __builtin_amdgcn_raw_buffer_load_b128(rb, vo16, 20480 + (VT * 2 + 1) * 1024, 0);
}
__device__ __forceinline__ void group(const Args& A, int grp, unsigned char* ldsb) {
    const int tid = threadIdx.x, lane = tid & 63, wid = __builtin_amdgcn_readfirstlane(tid >> 6), n = lane & 31, hi = lane >> 5, ci = wid >> 1, vt = wid & 1;
    const int ch = grp * 4 + ci, b = ch >> 4, h = ch & 15, v = 32 * vt + n;
    bf16_t* Yo = (bf16_t*)(A.ws + WS_Y);
    LAS float* ex = (LAS float*)(LAS unsigned char*)ldsb;
    const float gnw = A.in[12][h * 64 + v], gnb = A.in[13][h * 64 + v], muv = A.in[4][2048 + h * 64 + v];
    const unsigned vo16 = (unsigned)lane * 16u;
    f32x16 H[2];
#pragma unroll
    for (int i = 0; i < 16; ++i) { H[0][i] = 0.f; H[1][i] = 0.f; }
    Frags cur, nxt;
    { const __amdgpu_buffer_rsrc_t rb0 = BUFR(rw_block(A, ch * RW_NCH), RW_TB); load_frags_pr(cur, rb0, vo16); if (vt) load_frags_qy<1>(cur, rb0, vo16); else load_frags_qy<0>(cur, rb0, vo16); }
    for (int c = 0; c < RW_NCH; ++c) {
        const int t0 = 32 * c;
        const __amdgpu_buffer_rsrc_t rbc = BUFR(rw_block(A, ch * RW_NCH + c) + 24576, 128);
        const __amdgpu_buffer_rsrc_t rbn = BUFR(rw_block(A, ch * RW_NCH + ((c + 1 < RW_NCH) ? c + 1 : c)), RW_TB);
        load_frags_pr(nxt, rbn, vo16);
        SBAR0;
        bf16x8 Hp[2][2];
        Hp[0][0] = pack8(H[0], 0); Hp[0][1] = pack8(H[0], 1); Hp[1][0] = pack8(H[1], 0); Hp[1][1] = pack8(H[1], 1);
        f32x16 Y = unpack16(cur.Y[0], cur.Y[1]);
#pragma unroll
        for (int kp = 0; kp < 2; ++kp)
#pragma unroll
            for (int s = 0; s < 2; ++s) Y = MFMA32(__builtin_bit_cast(bf16x8, cur.R[kp][s]), Hp[kp][s], Y);
#pragma unroll
        for (int kt = 0; kt < 2; ++kt) {
            f32x16 hn = unpack16(cur.Q[kt][0], cur.Q[kt][1]);
#pragma unroll
            for (int kp = 0; kp < 2; ++kp)
#pragma unroll
                for (int s = 0; s < 2; ++s) hn = MFMA32(__builtin_bit_cast(bf16x8, cur.P[kt][kp][s]), Hp[kp][s], hn);
            H[kt] = hn;
        }
        SBAR0;
        if (vt) load_frags_qy<1>(nxt, rbn, vo16); else load_frags_qy<0>(nxt, rbn, vo16);
        float vs[16], gt[16], bo[16];
        { const __amdgpu_buffer_rsrc_t rV = BUFR((const bf16_t*)(A.ws + WS_RKV) + ((size_t)b * LP + t0 - 1) * 3072 + 2048 + h * 64, 34 * 6144);
          const __amdgpu_buffer_rsrc_t rG = BUFR((const bf16_t*)(A.ws + WS_GR) + ((size_t)b * LP + t0) * 1024 + h * 64, 33 * 2048);
          const unsigned voV = (unsigned)(hi * 4 * 6144 + 2 * v), voG = (unsigned)(hi * 4 * 2048 + 2 * v), voB = (unsigned)(hi * 16);
          float cv[16], pv4[4];
#pragma unroll
          for (int r = 0; r < 16; ++r) { const int T0 = (r & 3) + 8 * (r >> 2); cv[r] = __uint_as_float((unsigned)__builtin_amdgcn_raw_buffer_load_b16(rV, voV, (T0 + 1) * 6144, 0) << 16);
              gt[r] = __uint_as_float((unsigned)__builtin_amdgcn_raw_buffer_load_b16(rG, voG, T0 * 2048, 0) << 16); bo[r] = __uint_as_float(__builtin_amdgcn_raw_buffer_load_b32(rbc, voB, 4 * T0, 0)); }
#pragma unroll
          for (int g = 0; g < 4; ++g) { pv4[g] = __uint_as_float((unsigned)__builtin_amdgcn_raw_buffer_load_b16(rV, voV, (8 * g) * 6144, 0) << 16); if (t0 + Tk(4 * g, hi) == 0) pv4[g] = 0.f; }
#pragma unroll
          for (int r = 0; r < 16; ++r) { const float pv = (r & 3) ? cv[r - 1] : pv4[r >> 2]; vs[r] = cv[r] + (pv - cv[r]) * muv; } }
        SBAR0;
        float s1[16], s2[16];
#pragma unroll
        for (int r = 0; r < 16; ++r) { s1[r] = sum32h(Y[r]); s2[r] = sum32h(Y[r] * Y[r]); }
        LAS float* exw = ex + ((c & 1) * 8 + wid) * 64; LAS float* exp_ = ex + ((c & 1) * 8 + (wid ^ 1)) * 64;
        if (n == 0) {
#pragma unroll
            for (int r = 0; r < 16; ++r) { exw[2 * Tk(r, hi)] = s1[r]; exw[2 * Tk(r, hi) + 1] = s2[r]; } }
        __syncthreads();
#pragma unroll
        for (int r = 0; r < 16; ++r) {
            const int T = Tk(r, hi), t = t0 + T;
            const f32x2 o2 = *(const LAS f32x2*)(exp_ + 2 * T);
            const float mean = (s1[r] + o2[0]) * (1.f / 64.f), var = fmaxf((s2[r] + o2[1]) * (1.f / 64.f) - mean * mean, 0.f);
            float o = (Y[r] - mean) * __builtin_amdgcn_rsqf(var + 64e-5f) * gnw + gnb + bo[r] * vs[r];
            const float g = gt[r]; o *= g * sigmoidf_(g);
            if (t >= NMETA && t < LSEQ) Yo[(size_t)(b * TS + t - NMETA) * DM + h * 64 + v] = (bf16_t)(pk2(o, 0.f) & 0xffffu);
        }
        cur = nxt;
    }
    __syncthreads();
}
}

namespace rwc {
using rwb::unpack16;
__device__ __forceinline__ void hrec(const Args& A, int grp) {
    const int tid = threadIdx.x, lane = tid & 63, wid = __builtin_amdgcn_readfirstlane(tid >> 6), ci = wid >> 1, vt = wid & 1;
    const int ch = grp * 4 + ci;
    const unsigned vo16 = (unsigned)lane * 16u;
    f32x16 H[2];
#pragma unroll
    for (int i = 0; i < 16; ++i) { H[0][i] = 0.f; H[1][i] = 0.f; }
    u32x4 cP[2][2][2], cQ[2][2], nP[2][2][2], nQ[2][2];
#define HREC_LOAD(P_, Q_, rb) do { \
        _Pragma("unroll") for (int kt = 0; kt < 2; ++kt) _Pragma("unroll") for (int kp = 0; kp < 2; ++kp) { P_[kt][kp][0] = __builtin_amdgcn_raw_buffer_load_b128(rb, vo16, ((kt * 2 + kp) * 2 + 0) * 1024, 0); P_[kt][kp][1] = __builtin_amdgcn_raw_buffer_load_b128(rb, vo16, ((kt * 2 + kp) * 2 + 1) * 1024, 0); } \
        _Pragma("unroll") for (int kt = 0; kt < 2; ++kt) { Q_[kt][0] = __builtin_amdgcn_raw_buffer_load_b128(rb, vo16, 8192 + ((kt * 2 + vt) * 2 + 0) * 1024, 0); Q_[kt][1] = __builtin_amdgcn_raw_buffer_load_b128(rb, vo16, 8192 + ((kt * 2 + vt) * 2 + 1) * 1024, 0); } } while (0)
    { const __amdgpu_buffer_rsrc_t rb0 = BUFR(rw_block(A, ch * RW_NCH), RW_TB); HREC_LOAD(cP, cQ, rb0); }
    for (int c = 0; c < RW_NCH; ++c) {
        const __amdgpu_buffer_rsrc_t rbc = BUFR(rw_block(A, ch * RW_NCH + c), RW_TB);
        const __amdgpu_buffer_rsrc_t rbn = BUFR(rw_block(A, ch * RW_NCH + ((c + 1 < RW_NCH) ? c + 1 : c)), RW_TB);
        HREC_LOAD(nP, nQ, rbn);
        bf16x8 Hp[2][2];
        Hp[0][0] = pack8(H[0], 0); Hp[0][1] = pack8(H[0], 1); Hp[1][0] = pack8(H[1], 0); Hp[1][1] = pack8(H[1], 1);
#pragma unroll
        for (int kt = 0; kt < 2; ++kt) {
            f32x16 hn = unpack16(cQ[kt][0], cQ[kt][1]);
#pragma unroll
            for (int kp = 0; kp < 2; ++kp)
#pragma unroll
                for (int s = 0; s < 2; ++s) hn = MFMA32(__builtin_bit_cast(bf16x8, cP[kt][kp][s]), Hp[kp][s], hn);
            H[kt] = hn;
        }
#pragma unroll
        for (int kp = 0; kp < 2; ++kp)
#pragma unroll
            for (int s = 0; s < 2; ++s) __builtin_amdgcn_raw_buffer_store_b128(__builtin_bit_cast(u32x4, Hp[kp][s]), rbc, vo16, 8192 + ((kp * 2 + vt) * 2 + s) * 1024, 0);
#pragma unroll
        for (int kt = 0; kt < 2; ++kt) { cQ[kt][0] = nQ[kt][0]; cQ[kt][1] = nQ[kt][1];
#pragma unroll
            for (int kp = 0; kp < 2; ++kp) { cP[kt][kp][0] = nP[kt][kp][0]; cP[kt][kp][1] = nP[kt][kp][1]; } }
    }
#undef HREC_LOAD
}

__device__ __forceinline__ void ytask(const Args& A, int task, int lane_) {
    int lane = lane_; asm volatile("" : "+v"(lane));
    const int n = lane & 31, hi = lane >> 5;
    const int ch = task / RW_NCH, c = task - ch * RW_NCH, b = ch >> 4, h = ch & 15, t0 = 32 * c;
    const __amdgpu_buffer_rsrc_t rb = BUFR(rw_block(A, task), RW_TB);
    const unsigned vo16 = (unsigned)lane * 16u;
    bf16_t* Yo = (bf16_t*)(A.ws + WS_Y);
    f32x16 Y[2];
    {
        u32x4 R[2][2], Hq[2][2][2], Yl[2][2];
#pragma unroll
        for (int kp = 0; kp < 2; ++kp)
#pragma unroll
            for (int s = 0; s < 2; ++s) { R[kp][s] = __builtin_amdgcn_raw_buffer_load_b128(rb, vo16, 16384 + (kp * 2 + s) * 1024, 0);
#pragma unroll
                for (int vt = 0; vt < 2; ++vt) Hq[kp][vt][s] = __builtin_amdgcn_raw_buffer_load_b128(rb, vo16, 8192 + ((kp * 2 + vt) * 2 + s) * 1024, 0); }
#pragma unroll
        for (int vt = 0; vt < 2; ++vt) { Yl[vt][0] = __builtin_amdgcn_raw_buffer_load_b128(rb, vo16, 20480 + (vt * 2 + 0) * 1024, 0); Yl[vt][1] = __builtin_amdgcn_raw_buffer_load_b128(rb, vo16, 20480 + (vt * 2 + 1) * 1024, 0); }
#pragma unroll
        for (int vt = 0; vt < 2; ++vt) {
            f32x16 y = unpack16(Yl[vt][0], Yl[vt][1]);
#pragma unroll
            for (int kp = 0; kp < 2; ++kp)
#pragma unroll
                for (int s = 0; s < 2; ++s) y = MFMA32(__builtin_bit_cast(bf16x8, R[kp][s]), __builtin_bit_cast(bf16x8, Hq[kp][vt][s]), y);
            Y[vt] = y;
        }
    }
    float vs[2][16], gt[2][16], bo[16];
    {
        const __amdgpu_buffer_rsrc_t rV = BUFR((const bf16_t*)(A.ws + WS_RKV) + ((size_t)b * LP + t0 - 1) * 3072 + 2048 + h * 64, 34 * 6144);
        const __amdgpu_buffer_rsrc_t rG = BUFR((const bf16_t*)(A.ws + WS_GR) + ((size_t)b * LP + t0) * 1024 + h * 64, 33 * 2048);
        const __amdgpu_buffer_rsrc_t rBn = BUFR(rw_block(A, task) + 24576, 128);
#pragma unroll
        for (int r = 0; r < 16; ++r) bo[r] = __uint_as_float(__builtin_amdgcn_raw_buffer_load_b32(rBn, (unsigned)(hi * 16), 4 * ((r & 3) + 8 * (r >> 2)), 0));
        const f32x2 muv = *(const f32x2*)(A.in[4] + 2048 + h * 64 + 2 * n);
        const unsigned voV = (unsigned)(hi * 4 * 6144 + 4 * n), voG = (unsigned)(hi * 4 * 2048 + 4 * n);
        unsigned cv[16], pv4[4];
#pragma unroll
        for (int r = 0; r < 16; ++r) { const int T0 = (r & 3) + 8 * (r >> 2); cv[r] = __builtin_amdgcn_raw_buffer_load_b32(rV, voV, (T0 + 1) * 6144, 0);
            const unsigned g2 = __builtin_amdgcn_raw_buffer_load_b32(rG, voG, T0 * 2048, 0); gt[0][r] = bflo(g2); gt[1][r] = bfhi(g2); }
#pragma unroll
        for (int g = 0; g < 4; ++g) pv4[g] = __builtin_amdgcn_raw_buffer_load_b32(rV, voV, (8 * g) * 6144, 0);
        asm volatile("" : "+v"(pv4[0]), "+v"(pv4[1]), "+v"(pv4[2]), "+v"(pv4[3]));
#pragma unroll
        for (int g = 0; g < 4; ++g) if (t0 + Tk(4 * g, hi) == 0) pv4[g] = 0u;
#pragma unroll
        for (int r = 0; r < 16; ++r) { const unsigned pv = (r & 3) ? cv[r - 1] : pv4[r >> 2]; const float c0 = bflo(cv[r]), c1 = bfhi(cv[r]), p0 = bflo(pv), p1 = bfhi(pv);
            vs[0][r] = c0 + (p0 - c0) * muv[0]; vs[1][r] = c1 + (p1 - c1) * muv[1]; }
    }
    __builtin_amdgcn_s_barrier();
    const f32x2 gnw = *(const f32x2*)(A.in[12] + h * 64 + 2 * n), gnb = *(const f32x2*)(A.in[13] + h * 64 + 2 * n);
#pragma unroll
    for (int r = 0; r < 16; ++r) {
        const int t = t0 + Tk(r, hi);
        const float y0 = Y[0][r], y1 = Y[1][r];
        const float mean = sum32h(y0 + y1) * (1.f / 64.f);
        const float d0 = y0 - mean, d1 = y1 - mean;
        const float var = sum32h(d0 * d0 + d1 * d1) * (1.f / 64.f);
        const float rs = __builtin_amdgcn_rsqf(var + 64e-5f);
        float o0 = d0 * rs * gnw[0] + gnb[0] + bo[r] * vs[0][r], o1 = d1 * rs * gnw[1] + gnb[1] + bo[r] * vs[1][r];
        o0 *= gt[0][r] * sigmoidf_(gt[0][r]); o1 *= gt[1][r] * sigmoidf_(gt[1][r]);
        if (t >= NMETA && t < LSEQ) *(unsigned*)(Yo + (size_t)(b * TS + t - NMETA) * DM + h * 64 + 2 * n) = pk2(o0, o1);
    }
    __builtin_amdgcn_s_barrier();
}
}

namespace att {
constexpr float THR = 8.f;
constexpr int O_K = 0, O_V = 32768, O_WSF = 69632, XP = 132;
__device__ __forceinline__ unsigned off_b(unsigned row, unsigned ch) { return 256u * row + 16u * (ch ^ (((row & 3u) << 2) | ((row >> 2) & 3u))); }

__device__ __forceinline__ void unit(const Args& A, int b, int h, int qb, float lam, unsigned char* ldsb) {
    const int tid = threadIdx.x, lane = tid & 63, wid = __builtin_amdgcn_readfirstlane(tid >> 6), r32 = lane & 31, hh = lane >> 5, qblk = wid >> 1, comp = wid & 1;
    const bf16_t* QD = (const bf16_t*)(A.ws + WS_QD); const bf16_t* KD = (const bf16_t*)(A.ws + WS_KD); const bf16_t* VD = (const bf16_t*)(A.ws + WS_VD); const bf16_t* GD = (const bf16_t*)(A.ws + WS_GD);
    bf16_t* Y = (bf16_t*)(A.ws + WS_Y);
    LAS unsigned char* lds3 = (LAS unsigned char*)ldsb;
    const int qpos0 = NMETA + 128 * qb + 32 * qblk, qpos = qpos0 + r32;
    const int NT = 2 * qb + 3, wlast = (qpos0 + 31) >> 6;
    bf16x8 qf[4];
    { const bf16_t* qp = QD + (size_t)(b * LP + qpos) * 1024 + h * 128 + comp * 64 + 8 * hh;
#pragma unroll
      for (int d0 = 0; d0 < 4; ++d0) qf[d0] = *(const bf16x8*)(qp + 16 * d0); }
    const int srow = tid >> 4, sch = tid & 15;
    const unsigned sdst0 = off_b(srow, sch), sdst1 = off_b(srow + 32, sch);
    const bf16_t* kg = KD + (size_t)(b * LP + srow) * 1024 + h * 128 + sch * 8; const bf16_t* vg = VD + (size_t)(b * LP + srow) * 1024 + h * 128 + sch * 8;
    u32x4 kA0, kA1, vA0, vA1, kB0, kB1, vB0, vB1;
#define ATT_LOAD(X, tl_) do { const size_t o_ = (size_t)(tl_) * 64 * 1024; k##X##0 = *(const u32x4*)(kg + o_); k##X##1 = *(const u32x4*)(kg + o_ + 32 * 1024); v##X##0 = *(const u32x4*)(vg + o_); v##X##1 = *(const u32x4*)(vg + o_ + 32 * 1024); } while (0)
#define ATT_STORE(X, buf) do { *(LAS u32x4*)(lds3 + O_K + (buf) * 16384 + sdst0) = k##X##0; *(LAS u32x4*)(lds3 + O_K + (buf) * 16384 + sdst1) = k##X##1; \
                               *(LAS u32x4*)(lds3 + O_V + (buf) * 16384 + sdst0) = v##X##0; *(LAS u32x4*)(lds3 + O_V + (buf) * 16384 + sdst1) = v##X##1; } while (0)
    const unsigned sw = ((r32 & 3) << 2) | ((r32 >> 2) & 3);
    const unsigned kx = (unsigned)(comp * 8 + hh) ^ sw;
    const unsigned kbase = 256u * r32;
    const unsigned q4 = (lane & 15) >> 2, p4 = lane & 3, blk = (lane >> 4) & 1, cb = 2 * blk + (p4 >> 1);
    float m = 0.f, lsum = 0.f;
    f32x16 NEGM;
#pragma unroll
    for (int i = 0; i < 16; ++i) NEGM[i] = 0.f;
    f32x16 O[4];
#pragma unroll
    for (int d = 0; d < 4; ++d)
#pragma unroll
        for (int i = 0; i < 16; ++i) O[d][i] = 0.f;
    LAS float* wsf = (LAS float*)(lds3 + O_WSF) + wid * 64;
    unsigned valo[4], vahi[4];
#pragma unroll
    for (int d = 0; d < 4; ++d) { valo[d] = 256u * (4 * hh + q4) + 16u * ((((unsigned)d ^ q4) << 2) | (cb ^ (unsigned)hh)) + 8u * (p4 & 1);
                                  vahi[d] = 256u * (8 + 4 * hh + q4) + 16u * ((((unsigned)d ^ q4) << 2) | (cb ^ (2u + (unsigned)hh))) + 8u * (p4 & 1); }
#define MAX3G(r_, a_, b_, c_) asm volatile("s_nop 15\n\tv_max3_f32 %0, %1, %2, %3" : "=v"(r_) : "v"(a_), "v"(b_), "v"(c_))
#define MAX3(r_, a_, b_, c_) asm("v_max3_f32 %0, %1, %2, %3" : "=v"(r_) : "v"(a_), "v"(b_), "v"(c_))
#define ATT_COMPUTE(tl_, cur_) do { const int tl = (tl_); \
            LAS unsigned char* Kb = lds3 + O_K + (cur_) * 16384; LAS unsigned char* Vb = lds3 + O_V + (cur_) * 16384; \
            f32x16 p0 = NEGM, p1 = NEGM; \
            _Pragma("unroll") for (int d0 = 0; d0 < 4; ++d0) { \
                const bf16x8 a0 = *(const LAS bf16x8*)(Kb + kbase + 16u * (kx ^ (2u * d0))); \
                const bf16x8 a1 = *(const LAS bf16x8*)(Kb + 8192 + kbase + 16u * (kx ^ (2u * d0))); \
                p0 = __builtin_amdgcn_mfma_f32_32x32x16_bf16(a0, qf[d0], p0, 0, 0, 0); \
                p1 = __builtin_amdgcn_mfma_f32_32x32x16_bf16(a1, qf[d0], p1, 0, 0, 0); } \
            if (64 * tl + 63 > qpos0) { \
                _Pragma("unroll") for (int r = 0; r < 16; ++r) { const int kp = 64 * tl + (r & 3) + 8 * (r >> 2) + 4 * hh; if (kp > qpos) p0[r] = -INFINITY; if (kp + 32 > qpos) p1[r] = -INFINITY; } } \
            float rm, rm2; MAX3G(rm, p0[0], p1[0], p0[1]); MAX3(rm2, rm, p1[1], p0[2]); MAX3(rm, rm, p1[2], p0[3]); \
            MAX3(rm2, rm2, p1[3], p0[4]); MAX3(rm, rm, p1[4], p0[5]); MAX3(rm2, rm2, p1[5], p0[6]); MAX3(rm, rm, p1[6], p0[7]); \
            MAX3(rm2, rm2, p1[7], p0[8]); MAX3(rm, rm, p1[8], p0[9]); MAX3(rm2, rm2, p1[9], p0[10]); MAX3(rm, rm, p1[10], p0[11]); \
            MAX3(rm2, rm2, p1[11], p0[12]); MAX3(rm, rm, p1[12], p0[13]); MAX3(rm2, rm2, p1[13], p0[14]); MAX3(rm, rm, p1[14], p0[15]); \
            MAX3(rm, rm, rm2, p1[15]); \
            rm = swap32_max(rm); \
            if (tl == 0 || __any(rm > THR)) {            \
                const float dm = (tl == 0) ? rm : fmaxf(rm, 0.f), alpha = (tl == 0) ? 1.f : __builtin_amdgcn_exp2f(-dm);        \
                lsum *= alpha; m += dm; \
                if (hh == 0) wsf[r32] = alpha; \
                asm volatile("s_waitcnt lgkmcnt(0)" ::: "memory"); \
                _Pragma("unroll") for (int g = 0; g < 4; ++g) { const f32x4 a4 = *(const LAS f32x4*)(wsf + 8 * g + 4 * hh); \
                    _Pragma("unroll") for (int d = 0; d < 4; ++d) { O[d][4 * g] *= a4[0]; O[d][4 * g + 1] *= a4[1]; O[d][4 * g + 2] *= a4[2]; O[d][4 * g + 3] *= a4[3]; } } \
                _Pragma("unroll") for (int r = 0; r < 16; ++r) { p0[r] -= dm; p1[r] -= dm; NEGM[r] = -m; } \
            } \
            float ps0 = 0.f, ps1 = 0.f; \
            _Pragma("unroll") for (int r = 0; r < 16; ++r) { p0[r] = __builtin_amdgcn_exp2f(p0[r]); p1[r] = __builtin_amdgcn_exp2f(p1[r]); ps0 += p0[r]; ps1 += p1[r]; } \
            lsum += ps0 + ps1; \
            bf16x8 pw[4]; \
            pw[0] = __builtin_bit_cast(bf16x8, (u32x4){pk2(p0[0], p0[1]), pk2(p0[2], p0[3]), pk2(p0[4], p0[5]), pk2(p0[6], p0[7])}); \
            pw[1] = __builtin_bit_cast(bf16x8, (u32x4){pk2(p0[8], p0[9]), pk2(p0[10], p0[11]), pk2(p0[12], p0[13]), pk2(p0[14], p0[15])}); \
            pw[2] = __builtin_bit_cast(bf16x8, (u32x4){pk2(p1[0], p1[1]), pk2(p1[2], p1[3]), pk2(p1[4], p1[5]), pk2(p1[6], p1[7])}); \
            pw[3] = __builtin_bit_cast(bf16x8, (u32x4){pk2(p1[8], p1[9]), pk2(p1[10], p1[11]), pk2(p1[12], p1[13]), pk2(p1[14], p1[15])}); \
            _Pragma("unroll") for (int s = 0; s < 4; ++s) \
                _Pragma("unroll") for (int d = 0; d < 4; ++d) { \
                    const s16x4 lo = __builtin_amdgcn_ds_read_tr16_b64_v4i16((LAS s16x4*)(Vb + 4096 * s + valo[d])); \
                    const s16x4 hi = __builtin_amdgcn_ds_read_tr16_b64_v4i16((LAS s16x4*)(Vb + 4096 * s + vahi[d])); \
                    const bf16x8 vf = {lo[0], lo[1], lo[2], lo[3], hi[0], hi[1], hi[2], hi[3]}; \
                    O[d] = __builtin_amdgcn_mfma_f32_32x32x16_bf16(pw[s], vf, O[d], 0, 0, 0); } \
        } while (0)

    ATT_LOAD(A, 0); ATT_STORE(A, 0);
    __syncthreads();
    if (NT > 1) ATT_LOAD(A, 1);
    for (int t2 = 0; t2 < NT; t2 += 2) {
        if (t2 + 2 < NT) ATT_LOAD(B, t2 + 2);
        if (t2 <= wlast) ATT_COMPUTE(t2, 0);
        if (t2 + 1 < NT) ATT_STORE(A, 1);
        __syncthreads();
        if (t2 + 1 >= NT) break;
        if (t2 + 3 < NT) ATT_LOAD(A, t2 + 3);
        if (t2 + 1 <= wlast) ATT_COMPUTE(t2 + 1, 1);
        if (t2 + 2 < NT) ATT_STORE(B, 0);
        __syncthreads();
    }
#undef ATT_COMPUTE
#undef MAX3
#undef MAX3G
#undef ATT_LOAD
#undef ATT_STORE
    const float lt = swap32_sum(lsum);
    const float sc = (comp ? lam : 1.f) / lt;
    if (hh == 0) wsf[r32] = sc;
    asm volatile("s_waitcnt lgkmcnt(0)" ::: "memory");
    LAS float* X = (LAS float*)lds3 + qblk * (32 * XP);
    if (comp == 1) {
#pragma unroll
        for (int g = 0; g < 4; ++g) { const f32x4 s4 = *(const LAS f32x4*)(wsf + 8 * g + 4 * hh);
#pragma unroll
            for (int i = 0; i < 4; ++i)
#pragma unroll
                for (int d = 0; d < 4; ++d) X[(8 * g + 4 * hh + i) * XP + 32 * d + r32] = O[d][4 * g + i] * s4[i]; }
    }
    __syncthreads();
    if (comp == 0) {
#pragma unroll
        for (int g = 0; g < 4; ++g) { const f32x4 s4 = *(const LAS f32x4*)(wsf + 8 * g + 4 * hh);
#pragma unroll
            for (int i = 0; i < 4; ++i)
#pragma unroll
                for (int d = 0; d < 4; ++d) { LAS float* xp = X + (8 * g + 4 * hh + i) * XP + 32 * d + r32; *xp = O[d][4 * g + i] * s4[i] - *xp; } }
        asm volatile("s_waitcnt lgkmcnt(0)" ::: "memory");
        const LAS float* xr = X + r32 * XP + 64 * hh;
        f32x4 dv[16]; float ss = 0.f;
#pragma unroll
        for (int i = 0; i < 16; ++i) { dv[i] = *(const LAS f32x4*)(xr + 4 * i); ss += (dv[i][0] * dv[i][0] + dv[i][1] * dv[i][1]) + (dv[i][2] * dv[i][2] + dv[i][3] * dv[i][3]); }
        ss = swap32_sum(ss);
        const float rms = __builtin_amdgcn_rsqf(ss * (1.f / 128.f) + 1e-5f) * 0.8f;
        const bf16_t* gp = GD + (size_t)(b * LP + qpos) * 1024 + h * 128 + 64 * hh; const float* sw_ = A.in[18] + 64 * hh;
        bf16_t* yp = Y + (size_t)(b * TS + qpos - NMETA) * DM + 1024 + h * 128 + 64 * hh;
#pragma unroll
        for (int c8 = 0; c8 < 8; ++c8) {
            const u32x4 gv = *(const u32x4*)(gp + 8 * c8); const f32x4 w0 = *(const f32x4*)(sw_ + 8 * c8), w1 = *(const f32x4*)(sw_ + 8 * c8 + 4);
            const float g0 = bflo(gv.x), g1 = bfhi(gv.x), g2 = bflo(gv.y), g3 = bfhi(gv.y), g4 = bflo(gv.z), g5 = bfhi(gv.z), g6 = bflo(gv.w), g7 = bfhi(gv.w);
            const f32x4 d0 = dv[2 * c8], d1 = dv[2 * c8 + 1];
            u32x4 o;
            o.x = pk2(d0[0] * rms * w0[0] * g0 * sigmoidf_(g0), d0[1] * rms * w0[1] * g1 * sigmoidf_(g1));
            o.y = pk2(d0[2] * rms * w0[2] * g2 * sigmoidf_(g2), d0[3] * rms * w0[3] * g3 * sigmoidf_(g3));
            o.z = pk2(d1[0] * rms * w1[0] * g4 * sigmoidf_(g4), d1[1] * rms * w1[1] * g5 * sigmoidf_(g5));
            o.w = pk2(d1[2] * rms * w1[2] * g6 * sigmoidf_(g6), d1[3] * rms * w1[3] * g7 * sigmoidf_(g7));
            *(u32x4*)(yp + 8 * c8) = o;
        }
    }
    __syncthreads();
}
}

#define XB_TMO      128
#define XB_XCNT(j)  (256  + 64 * (j))
#define XB_XSUB(j)  (1280 + 64 * (j))
#define XB_XGEN(j)  (2304 + 64 * (j))
#define XB_TOP      3328
#define XB_TOPGEN   3392
#define XCD_BAR_WORDS 3456
#define XB_SPIN_CAP (1u << 18)

__device__ __forceinline__ unsigned xb_ld(unsigned* p)              { return __hip_atomic_load(p, __ATOMIC_RELAXED, __HIP_MEMORY_SCOPE_AGENT); }
__device__ __forceinline__ unsigned xb_add(unsigned* p, unsigned v) { return __hip_atomic_fetch_add(p, v, __ATOMIC_RELAXED, __HIP_MEMORY_SCOPE_AGENT); }
__device__ __forceinline__ unsigned xb_xcc_id() { return (unsigned)__builtin_amdgcn_s_getreg((3 << 11) | 20) & 0xFu; }
#define XB_SPIN(cond, bar) do { unsigned _sp = 0; while (cond) { __builtin_amdgcn_s_sleep(1); \
    if ((++_sp & 255u) == 0u) { if (xb_ld(&(bar)[XB_TMO])) break; if (_sp > XB_SPIN_CAP) { atomicAdd(&(bar)[XB_TMO], 1u); break; } } } } while (0)

struct XcdBarrier {
    unsigned* bar; unsigned x;
    volatile LAS unsigned* st;
};

__device__ __forceinline__ XcdBarrier xcd_barrier_post(unsigned* bar, volatile LAS unsigned* st) {
    XcdBarrier b; b.bar = bar; b.x = xb_xcc_id(); b.st = st;
    if (threadIdx.x == 0) (void)xb_add(&bar[XB_XCNT(b.x)], 1u);
    return b;
}
__device__ __forceinline__ void xcd_barrier_complete(unsigned* bar, unsigned x, unsigned& nloc, unsigned& nx) {
    const unsigned G = gridDim.x * gridDim.y * gridDim.z;
    unsigned sum, cnt, mine, sp = 0u;
    for (;;) {
        sum = 0u; cnt = 0u; mine = 0u;
#pragma unroll
        for (unsigned j = 0; j < 16; ++j) { const unsigned c = xb_ld(&bar[XB_XCNT(j)]); sum += c; cnt += (c > 0u) ? 1u : 0u; mine = (j == x) ? c : mine; }
        if (sum == G) break;
        __builtin_amdgcn_s_sleep(1);
        if ((++sp & 255u) == 0u) { if (xb_ld(&bar[XB_TMO])) break; if (sp > XB_SPIN_CAP) { atomicAdd(&bar[XB_TMO], 1u); break; } }
    }
    nloc = mine > 0u ? mine : 1u; nx = cnt > 0u ? cnt : 1u;
}

__device__ __forceinline__ void xcd_barrier(const XcdBarrier& b) {
    asm volatile("s_waitcnt vmcnt(0)" ::: "memory");
    __syncthreads();
    if (threadIdx.x == 0) {
        unsigned* bar = b.bar;
        __builtin_amdgcn_s_waitcnt(0);
        unsigned nloc = b.st[0], nx = b.st[1];
        if (nloc == 0u) { xcd_barrier_complete(bar, b.x, nloc, nx); b.st[0] = nloc; b.st[1] = nx; }
        const unsigned old = xb_add(&bar[XB_XSUB(b.x)], 1u);
        const unsigned gen = old / nloc;
        if (old + 1u == (gen + 1u) * nloc) {
            __builtin_amdgcn_fence(__ATOMIC_RELEASE, "agent");
            asm volatile("s_waitcnt vmcnt(0)" ::: "memory");
            const unsigned og = xb_add(&bar[XB_TOP], 1u);
            const unsigned tg = og / nx;
            if (og + 1u == (tg + 1u) * nx) xb_add(&bar[XB_TOPGEN], 1u);
            else XB_SPIN(xb_ld(&bar[XB_TOPGEN]) == tg, bar);
            __builtin_amdgcn_fence(__ATOMIC_ACQUIRE, "agent");
            xb_add(&bar[XB_XGEN(b.x)], 1u);
            asm volatile("s_waitcnt vmcnt(0)" ::: "memory");
        } else {
            XB_SPIN(xb_ld(&bar[XB_XGEN(b.x)]) == gen, bar);
            __builtin_amdgcn_fence(__ATOMIC_ACQUIRE, "agent");
            asm volatile("s_waitcnt vmcnt(0)" ::: "memory");
        }
    }
    __syncthreads();
}


__global__ void __launch_bounds__(512, 2) hymba_fwd(Args A) {
    extern __shared__ __attribute__((aligned(16))) unsigned char lds[];
    const int tid = threadIdx.x, lane = tid & 63, wave = __builtin_amdgcn_readfirstlane(tid >> 6);
    const int G = gridDim.x, bx = blockIdx.x;
    const int lo = A.ph_lo, hi = A.ph_hi;
    unsigned char* ws = A.ws;
    bf16_t* W1T = (bf16_t*)(ws + WS_W1T); bf16_t* W2T = (bf16_t*)(ws + WS_W2T); bf16_t* XN = (bf16_t*)(ws + WS_XN);
    float* ROPE = (float*)(ws + WS_ROPE); float* SSQ = (float*)(ws + WS_SSQ);
#define IN_PH(k) (lo <= (k) && (k) < hi)
    volatile LAS unsigned* bst = (volatile LAS unsigned*)((LAS unsigned char*)lds + LDS_BARW);
    if (tid < 2) bst[tid] = 0u;
    __syncthreads();
    XcdBarrier gbar; gbar.bar = (unsigned*)(ws + WS_CTL) + CW_BAR; gbar.x = 0; gbar.st = nullptr;
    if (A.coop) gbar = xcd_barrier_post((unsigned*)(ws + WS_CTL) + CW_BAR, bst);
#define GRID_SYNC(k) do { if (A.coop && IN_PH(k) && IN_PH((k) + 1)) { xcd_barrier(gbar); } } while (0)

    if (IN_PH(0)) {
        const int gw = bx * 8 + wave, NGW = G * 8;
        LAS float* scr = (LAS float*)((LAS unsigned char*)lds + wave * 17408);
        constexpr int I_1 = P0_I1, I_2 = 0;
        if (gw < I_1 + I_2) {
            f32x4 cur[16]; p0_ld(cur, A, gw, lane);
            for (int it = gw; it < I_1 + I_2; it += NGW) {
                f32x4 nxt[16]; { const int nx = it + NGW; p0_ld(nxt, A, nx < I_1 + I_2 ? nx : it, lane); }
                p0_emit(cur, W1T, W2T, scr, it, lane);
#pragma unroll
                for (int i = 0; i < 16; ++i) cur[i] = nxt[i];
            }
        }
        for (int e = bx * 512 + tid; e < 128 * 2048 / 8; e += G * 512) *(u32x4*)(W1T + (size_t)8320 * 2048 + (size_t)e * 8) = (u32x4){0u, 0u, 0u, 0u};
        { const f32x4* wv = (const f32x4*)A.in[2] + lane; f32x4 pw[8];
#pragma unroll
          for (int j = 0; j < 8; ++j) pw[j] = wv[64 * j];
          constexpr int NREAL = MR + NMETA;
#define XN_SRC(row) ((const f32x4*)(((row) < MR) ? A.in[0] + (size_t)(row) * DM : A.in[1] + (size_t)((row) - MR) * DM) + lane)
          f32x4 v[8];
          { const f32x4* xr = XN_SRC(gw);
#pragma unroll
            for (int j = 0; j < 8; ++j) v[j] = __builtin_nontemporal_load(xr + 64 * j); }
          for (int mrow = gw; mrow < NREAL; mrow += NGW) {
              f32x4 nv[8]; { const int nx = mrow + NGW; const int nr = nx < NREAL ? nx : mrow; const f32x4* xr = XN_SRC(nr);
#pragma unroll
                for (int j = 0; j < 8; ++j) nv[j] = __builtin_nontemporal_load(xr + 64 * j); }
              unsigned long long* o8 = (unsigned long long*)(XN + (size_t)mrow * DM) + lane;
              float s = 0.f;
#pragma unroll
              for (int j = 0; j < 8; ++j) s += (v[j][0] * v[j][0] + v[j][1] * v[j][1]) + (v[j][2] * v[j][2] + v[j][3] * v[j][3]);
              const float rstd = __builtin_amdgcn_rsqf(wave_sum(s) * (1.f / DM) + 1e-6f);
#pragma unroll
              for (int j = 0; j < 8; ++j) { const f32x4 y = v[j] * rstd * pw[j]; o8[64 * j] = (unsigned long long)pk2(y[0], y[1]) | ((unsigned long long)pk2(y[2], y[3]) << 32); }
#pragma unroll
              for (int j = 0; j < 8; ++j) v[j] = nv[j];
          }
#undef XN_SRC
          for (int mrow = NREAL + gw; mrow < MP; mrow += NGW) {
              unsigned long long* o8 = (unsigned long long*)(XN + (size_t)mrow * DM) + lane;
#pragma unroll
              for (int j = 0; j < 8; ++j) o8[64 * j] = 0ull;
          } }
        for (int e = bx * 512 + tid; e < LSEQ * 32; e += G * 512) {
            const int pos = e >> 5, i = e & 31; const double rev = (double)pos * (double)A.inv_freq[i] * 0.15915494309189535; const float f = (float)(rev - floor(rev));
            ROPE[2 * e] = __builtin_amdgcn_cosf(f); ROPE[2 * e + 1] = __builtin_amdgcn_sinf(f); }
        { u32x4* LF = (u32x4*)(ws + WS_LF);
          for (int e = bx * 512 + tid; e < 16 * 2 * 2 * 4 * 64; e += G * 512) {
              const int l = e & 63, s_ = (e >> 6) & 3, nb = (e >> 8) & 1, mat = (e >> 9) & 1, hd = e >> 10; const float* up = mat ? A.in[8] : A.in[6];
              const float* p = up + (size_t)(16 * s_ + 8 * (l >> 5)) * 1024 + hd * 64 + 2 * (l & 31) + nb;
              LF[e] = (u32x4){pk2(p[0], p[1024]), pk2(p[2048], p[3072]), pk2(p[4096], p[5120]), pk2(p[6144], p[7168])}; } }
        { bf16_t* KD = (bf16_t*)(ws + WS_KD); bf16_t* VD = (bf16_t*)(ws + WS_VD); constexpr int PADC = (LP - LSEQ) * 1024 / 8;
          for (int e = bx * 512 + tid; e < NB * PADC * 2; e += G * 512) { const int which = e / (NB * PADC), r = e % (NB * PADC), b = r / PADC, c = r % PADC;
              *(u32x4*)((which ? VD : KD) + (size_t)(b * LP + LSEQ) * 1024 + (size_t)c * 8) = (u32x4){0u, 0u, 0u, 0u}; } }
    }
    GRID_SYNC(0);

    if (IN_PH(1)) {
        pg8::Gemm g{XN, W1T, MP, N1, DM}; pg8::StaticOrder S; S.init(MP, N1, G, bx);
        EpiProj E{(bf16_t*)(ws + WS_RKV), (bf16_t*)(ws + WS_GR), (bf16_t*)(ws + WS_WA), (bf16_t*)(ws + WS_QD), (bf16_t*)(ws + WS_KD), (bf16_t*)(ws + WS_VD), (bf16_t*)(ws + WS_GD), ROPE};
        pg8::gemm_phase<EpiProj, pg8::StaticOrder, true, true>((PG8_LAS unsigned char*)lds, g, S, E);
    }
    GRID_SYNC(1);

    if (IN_PH(2)) {
        const int gw = bx * 8 + wave, NGW = G * 8;
        LAS unsigned char* wl = (LAS unsigned char*)lds + wave * 18432;
        for (int sl = gw; sl < 128 * (RW_NCH - 1); sl += NGW) { rwa::task(A, (sl >> 6) * RW_NCH + (sl & 63), wl, lane); __builtin_amdgcn_s_barrier(); }
    }
    GRID_SYNC(2);

    if (IN_PH(3)) {
        float lam;
        { const float a = A.in[14][lane] * A.in[15][lane], c = A.in[16][lane] * A.in[17][lane];
          lam = fexp(wave_sum(a)) - fexp(wave_sum(c)) + 0.2f; }
        unsigned* qctr = (unsigned*)(ws + WS_CTL);
        volatile LAS int* qw = (volatile LAS int*)((LAS unsigned char*)lds + LDS_QW);
        constexpr int NRG = 32, NTL = 16, NW2 = 16, NITEMS = NRG + NTL + NW2 + 1024;
#define Q_FETCH(dst) do { __syncthreads(); if (tid == 0) *qw = (int)atomicAdd(qctr, 1u); __syncthreads(); dst = *qw; } while (0)
        int item; Q_FETCH(item);
        while (item < NRG) { rwc::hrec(A, item); Q_FETCH(item); }
        while (item < NRG + NTL) { rwa::task(A, ((item - NRG) * 8 + wave) * RW_NCH + (RW_NCH - 1), (LAS unsigned char*)lds + wave * 18432, lane); __builtin_amdgcn_s_barrier(); Q_FETCH(item); }
        while (item < NRG + NTL + NW2) {
            LAS float* scr = (LAS float*)((LAS unsigned char*)lds + wave * 17408);
            const int base = P0_I1 + (item - NRG - NTL) * 64 + wave * 8;
            f32x4 cur[16]; p0_ld(cur, A, base, lane);
            for (int j = 0; j < 8; ++j) { f32x4 nxt[16]; p0_ld(nxt, A, base + (j < 7 ? j + 1 : j), lane); p0_emit(cur, W1T, W2T, scr, base + j, lane);
#pragma unroll
                for (int i = 0; i < 16; ++i) cur[i] = nxt[i]; }
            Q_FETCH(item);
        }
        while (item < NITEMS) { const int a = item - NRG - NTL - NW2, qb = 15 - (a >> 6), bh = a & 63; att::unit(A, bh >> 3, bh & 7, qb, lam, lds); Q_FETCH(item); }
#undef Q_FETCH
    }
    GRID_SYNC(3);

    if (IN_PH(4)) {
        const int gw = bx * 8 + wave, NGW = G * 8;
        const int full_ = RW_TASKS / NGW;
        for (int it_ = 0; it_ < full_; ++it_) rwc::ytask(A, gw + it_ * NGW, lane);
        { const int left_ = RW_TASKS - full_ * NGW;
          for (int base_ = 0; base_ < left_; base_ += G) {
              if (wave == 0 && base_ + bx < left_) rwc::ytask(A, full_ * NGW + base_ + bx, lane);
              else { __builtin_amdgcn_s_barrier(); __builtin_amdgcn_s_barrier(); }
          } }
    }
    GRID_SYNC(4);

    if (IN_PH(5)) {
        pg8::Gemm g{(const bf16_t*)(ws + WS_Y), W2T, MR, DM, DM}; pg8::StaticOrder S; S.init(MR, DM, G, bx);
        EpiY E{XN  , SSQ};
        pg8::gemm_phase<EpiY, pg8::StaticOrder, true, true>((PG8_LAS unsigned char*)lds, g, S, E);
    }
    GRID_SYNC(5);

    if (IN_PH(6)) {
        const int gw = bx * 8 + wave, NGW = G * 8;
        const f32x4* wv = (const f32x4*)A.in[20] + lane; f32x4 pw[8];
#pragma unroll
        for (int j = 0; j < 8; ++j) pw[j] = wv[64 * j];
        const bf16_t* YO = XN;
        u32x2 yv[8];
        { const u32x2* yr = (const u32x2*)(YO + (size_t)gw * DM) + lane;
#pragma unroll
          for (int j = 0; j < 8; ++j) yv[j] = yr[64 * j]; }
        for (int row = gw; row < MR; row += NGW) {
            const f32x4* xr = (const f32x4*)(A.in[0] + (size_t)row * DM) + lane;
            f32x4 xv[8];
#pragma unroll
            for (int j = 0; j < 8; ++j) xv[j] = __builtin_nontemporal_load(xr + 64 * j);
            u32x2 nyv[8];
            { const int nx = row + NGW; const u32x2* yr = (const u32x2*)(YO + (size_t)(nx < MR ? nx : row) * DM) + lane;
#pragma unroll
              for (int j = 0; j < 8; ++j) nyv[j] = yr[64 * j]; }
            float ssq = 0.f;
#pragma unroll
            for (int j = 0; j < 8; ++j) { const float e0 = bflo(yv[j].x), e1 = bfhi(yv[j].x), e2 = bflo(yv[j].y), e3 = bfhi(yv[j].y); ssq += (e0 * e0 + e1 * e1) + (e2 * e2 + e3 * e3); }
            const float rstd = __builtin_amdgcn_rsqf(wave_sum(ssq) * (1.f / DM) + 1e-6f);
            f32x4* orow = (f32x4*)(A.out + (size_t)row * DM) + lane;
#pragma unroll
            for (int j = 0; j < 8; ++j) { const f32x4 y = {bflo(yv[j].x), bfhi(yv[j].x), bflo(yv[j].y), bfhi(yv[j].y)};
                orow[64 * j] = xv[j] + y * rstd * pw[j]; }
#pragma unroll
            for (int j = 0; j < 8; ++j) yv[j] = nyv[j];
        }
    }
#undef IN_PH
#undef GRID_SYNC
}

extern "C" void kernel_launch(void* const* d_in, const int* in_sizes, int n_in, void* d_out, int out_size, void* d_ws, size_t ws_size, hipStream_t stream) {
    static int grid = 0;
    if (grid == 0) {
        if (n_in != 21 || in_sizes[0] != MR * DM || out_size != MR * DM || ws_size < WS_END) { fprintf(stderr, "kernel_launch: unexpected shapes (n_in %d, in0 %d, out %d, ws %zu); nothing launched\n", n_in, n_in > 0 ? in_sizes[0] : -1, out_size, ws_size); grid = -1; return; }
        int dev = 0, cus = 0, per_cu = 0;
        if (hipGetDevice(&dev) != hipSuccess || hipDeviceGetAttribute(&cus, hipDeviceAttributeMultiprocessorCount, dev) != hipSuccess) { grid = -1; return; }
        if (hipFuncSetAttribute((const void*)hymba_fwd, hipFuncAttributeMaxDynamicSharedMemorySize, LDS_BYTES) != hipSuccess) { fprintf(stderr, "kernel_launch: hipFuncSetAttribute failed\n"); grid = -1; return; }
        if (hipOccupancyMaxActiveBlocksPerMultiprocessor(&per_cu, (const void*)hymba_fwd, 512, LDS_BYTES) != hipSuccess || per_cu < 1) { fprintf(stderr, "kernel_launch: occupancy query reports %d\n", per_cu); per_cu = 1; }
        (void)hipGetLastError();
        grid = cus;
    }
    if (grid < 0) return;
    (void)hipMemsetAsync((char*)d_ws + WS_CTL, 0, CTL_ZERO_BYTES, stream);
    Args a{};
    for (int i = 0; i < 21; ++i) a.in[i] = (const float*)d_in[i];
    a.out = (float*)d_out; a.ws = (unsigned char*)d_ws;
    for (int i = 0; i < 32; ++i) a.inv_freq[i] = (float)pow(10000.0, -(double)(2 * i) / 64.0);
#if MK_N_LAUNCHES == 1
    a.ph_lo = 0; a.ph_hi = NPH; a.coop = 1;
    void* kargs[] = {&a};
    (void)kargs;
    hipLaunchKernelGGL(hymba_fwd, dim3(grid), dim3(512), LDS_BYTES, stream, a);
#else
    for (int p = 0; p < NPH; ++p) { a.ph_lo = p; a.ph_hi = p + 1; a.coop = 0; hipLaunchKernelGGL(hymba_fwd, dim3(grid), dim3(512), LDS_BYTES, stream, a); }
#endif
}
```

```cpp
#include <hip/hip_runtime.h>
#include <hip/hip_cooperative_groups.h>
#include <cstdio>
#include <cstdint>
#include <cmath>
namespace cg = cooperative_groups;

#ifndef REP_PH
#define REP_PH -1
#endif
#ifndef MK_N_LAUNCHES
#define MK_N_LAUNCHES 1
#endif

constexpr int NB = 8, TS = 2048, NMETA = 16, LSEQ = TS + NMETA, LP = 2112, DM = 2048;
constexpr int MR = NB * TS;
constexpr int MP = 16640;
constexpr int N1 = 8448;
constexpr int NIN = 8320;
constexpr int NPH = 7;

namespace pg8 {
#define PG8_LAS __attribute__((address_space(3)))
typedef unsigned short bf16_t;
typedef short bf16x8 __attribute__((ext_vector_type(8)));
typedef float f32x4 __attribute__((ext_vector_type(4)));
typedef unsigned u32x4 __attribute__((ext_vector_type(4)));
constexpr int BM = 256, BK = 64, HALF = 128, HTB = HALF * BK * 2, STAGE_BYTES = 8 * HTB, NXCD = 8, WGM = 8;

__host__ __device__ __forceinline__ int lds_byte(int r, int c) { const int st = (r >> 4) * 2 + (c >> 5), rr = r & 15, cc = c & 31, ob = rr * 64 + cc * 2; return st * 1024 + (ob ^ (((ob >> 9) & 1) << 5)); }
__host__ __device__ __forceinline__ void stage_rc(int b, int& R, int& C) { const int st = b / 1024, sb = b % 1024, swz = sb ^ (((sb >> 9) & 1) << 5); R = (st >> 1) * 16 + swz / 64; C = (st & 1) * 32 + (swz % 64) / 2; }
__host__ __device__ __forceinline__ int perm32(int rho) { const int n = rho >> 4, i = rho & 15; return 8 * (i >> 2) + 4 * n + (i & 3); }

struct Unit { int pm, pn; };
struct Gemm { const bf16_t* A; const bf16_t* Bt; int M, N, K; };

struct StaticOrder {
    int nM, nN, nwg, G, c;
    __host__ __device__ void init(int M, int N, int G_, int c_) { nM = M / BM; nN = N / BM; nwg = nM * nN; G = G_; c = c_; }
    __host__ __device__ bool next(int i, Unit& u) const {
        const long L = (long)i * G + c; if (L >= nwg) return false;
        int wgid = (int)L; { const int q = nwg / NXCD, r = nwg % NXCD, xcd = wgid % NXCD, off = wgid / NXCD; wgid = (xcd < r ? xcd * (q + 1) : r * (q + 1) + (xcd - r) * q) + off; }
        const int nig = WGM * nN, gid = wgid / nig, fm = gid * WGM, gsz = (nM - fm) < WGM ? (nM - fm) : WGM;
        u.pm = fm + ((wgid % nig) % gsz); u.pn = (wgid % nig) / gsz; return true;
    }
    __device__ __forceinline__ void a_ready(const Unit&) const {}
    __device__ __forceinline__ void done(const Unit&) const {}
};

__device__ __forceinline__ unsigned cvt_pk_bf16(float lo, float hi) { unsigned r; asm volatile("v_cvt_pk_bf16_f32 %0, %1, %2" : "=v"(r) : "v"(lo), "v"(hi)); return r; }

template <class Epi, class Sched, bool ALIGN_EPI = false, bool SP2 = false>
__device__ __forceinline__ void gemm_phase(PG8_LAS unsigned char* lds, const Gemm g, const Sched& S, const Epi& E) {
    const int tid = threadIdx.x, wid = __builtin_amdgcn_readfirstlane(tid >> 6), lane = tid & 63, wr = wid >> 2, wc = wid & 3, fr = lane & 15, fq = lane >> 4;
    const int K = g.K, nt = K / BK;
    unsigned voffA[2], voffB[2];
#pragma unroll
    for (int i = 0; i < 2; ++i) { int R, C; stage_rc(tid * 16 + i * 8192, R, C); const int Rb = Epi::PERM ? ((R & ~31) + perm32(R & 31)) : R;
        voffA[i] = (unsigned)(R * K + C) * 2u; voffB[i] = (unsigned)(Rb * K + C) * 2u; }
    const size_t kstep = (size_t)(BK * 2);
    const size_t hstep = (size_t)HALF * K * 2;
    const size_t tstep = 2 * hstep;
    const unsigned ldsw = (unsigned)wid * 1024u;
    const int aoff = lds_byte(wr * 64 + fr, fq * 8), boff = lds_byte(wc * 32 + fr, fq * 8);
#define PG8_SA(b, h) (((b) * 2 + (h)) * HTB)
#define PG8_SB(b, h) ((4 + (b) * 2 + (h)) * HTB)
#define PG8_STAGE(bufoff, gbase, voff) do { _Pragma("unroll") for (int _i = 0; _i < 2; ++_i) \
        __builtin_amdgcn_global_load_lds((const unsigned*)((const char*)(gbase) + (voff)[_i]), (PG8_LAS unsigned*)(lds + (bufoff) + ldsw + _i * 8192), 16, 0, 0); } while (0)
#define PG8_LDA(dst, b, h) do { _Pragma("unroll") for (int m = 0; m < 4; ++m) _Pragma("unroll") for (int k = 0; k < 2; ++k) dst[m][k] = *(const PG8_LAS bf16x8*)(lds + PG8_SA(b, h) + aoff + m * 2048 + k * 1024); } while (0)
#define PG8_LDB(dst, b, h) do { _Pragma("unroll") for (int n = 0; n < 2; ++n) _Pragma("unroll") for (int k = 0; k < 2; ++k) dst[n][k] = *(const PG8_LAS bf16x8*)(lds + PG8_SB(b, h) + boff + n * 2048 + k * 1024); } while (0)
#define PG8_MMA(ai, bj, At, Bt) do { __builtin_amdgcn_s_setprio(1); _Pragma("unroll") for (int m = 0; m < 4; ++m) _Pragma("unroll") for (int n = 0; n < 2; ++n) _Pragma("unroll") for (int k = 0; k < 2; ++k) \
        acc[ai][bj][m][n] = __builtin_amdgcn_mfma_f32_16x16x32_bf16(Bt[n][k], At[m][k], acc[ai][bj][m][n], 0, 0, 0); __builtin_amdgcn_s_setprio(0); } while (0)
#define PG8_WAIT_V(n) asm volatile("s_waitcnt vmcnt(" #n ")" ::: "memory")
#define PG8_WAIT_L(n) asm volatile("s_waitcnt lgkmcnt(" #n ")" ::: "memory")
#define PG8_BAR __builtin_amdgcn_s_barrier()
#define PG8_SCHED __builtin_amdgcn_sched_barrier(0)
    Unit cur, nxt; int ui = 0;
    if (!S.next(0, cur)) return;
    f32x4 acc[2][2][4][2];
#pragma unroll
    for (int a = 0; a < 2; ++a)
#pragma unroll
        for (int b = 0; b < 2; ++b)
#pragma unroll
            for (int m = 0; m < 4; ++m)
#pragma unroll
                for (int n = 0; n < 2; ++n) acc[a][b][m][n] = (f32x4){0.f, 0.f, 0.f, 0.f};
    bf16x8 At[4][2], B0[2][2], B1[2][2];
    const char* cA = (const char*)g.A + (size_t)cur.pm * tstep; const char* cB = (const char*)g.Bt + (size_t)cur.pn * tstep;
    S.a_ready(cur);
    if constexpr (SP2) {
        PG8_STAGE(PG8_SB(0, 0), cB, voffB); PG8_STAGE(PG8_SB(0, 1), cB + hstep, voffB); PG8_STAGE(PG8_SA(0, 0), cA, voffA); PG8_STAGE(PG8_SA(0, 1), cA + hstep, voffA);
        if (wr == 1) PG8_BAR;
        PG8_WAIT_V(2); PG8_BAR;
        PG8_STAGE(PG8_SB(1, 0), cB + kstep, voffB); PG8_STAGE(PG8_SA(1, 0), cA + kstep, voffA); PG8_STAGE(PG8_SB(1, 1), cB + hstep + kstep, voffB);
        PG8_WAIT_V(6); PG8_BAR;
    } else {
        PG8_STAGE(PG8_SB(0, 0), cB, voffB); PG8_STAGE(PG8_SA(0, 0), cA, voffA); PG8_STAGE(PG8_SB(0, 1), cB + hstep, voffB); PG8_STAGE(PG8_SA(0, 1), cA + hstep, voffA);
        if (wr == 1) PG8_BAR;
        PG8_WAIT_V(4); PG8_BAR;
        PG8_STAGE(PG8_SB(1, 0), cB + kstep, voffB); PG8_STAGE(PG8_SA(1, 0), cA + kstep, voffA); PG8_STAGE(PG8_SB(1, 1), cB + hstep + kstep, voffB);
        PG8_WAIT_V(6); PG8_BAR;
    }
    for (;;) {
        const bool has_next = S.next(ui + 1, nxt);
        const char* nA = has_next ? (const char*)g.A + (size_t)nxt.pm * tstep : cA; const char* nB = has_next ? (const char*)g.Bt + (size_t)nxt.pn * tstep : cB;
        for (int t = 0; t < nt; t += 2) {
            const bool last = (t == nt - 2);
            const char* a1 = cA + (size_t)(t + 1) * kstep;
            const char* a2 = last ? nA : cA + (size_t)(t + 2) * kstep; const char* b2 = last ? nB : cB + (size_t)(t + 2) * kstep;
            const char* a3 = a2 + kstep; const char* b3 = b2 + kstep;
            if (last && has_next) S.a_ready(nxt);
            if constexpr (SP2) {
            PG8_LDB(B0, 0, 0); PG8_LDB(B1, 0, 1); PG8_SCHED; PG8_LDA(At, 0, 0); PG8_STAGE(PG8_SA(1, 1), a1 + hstep, voffA);
            PG8_WAIT_V(8); PG8_WAIT_L(0); PG8_BAR; PG8_MMA(0, 0, At, B0); PG8_MMA(0, 1, At, B1); PG8_BAR; PG8_SCHED;
            PG8_LDA(At, 0, 1); PG8_STAGE(PG8_SB(0, 0), b2, voffB); PG8_STAGE(PG8_SB(0, 1), b2 + hstep, voffB); PG8_STAGE(PG8_SA(0, 0), a2, voffA);
            PG8_WAIT_V(8); PG8_WAIT_L(0); PG8_BAR; PG8_MMA(1, 0, At, B0); PG8_MMA(1, 1, At, B1); PG8_BAR; PG8_SCHED;
            PG8_LDB(B0, 1, 0); PG8_LDB(B1, 1, 1); PG8_SCHED; PG8_LDA(At, 1, 0); PG8_STAGE(PG8_SA(0, 1), a2 + hstep, voffA);
            PG8_WAIT_V(8); PG8_WAIT_L(0); PG8_BAR; PG8_MMA(0, 0, At, B0); PG8_MMA(0, 1, At, B1); PG8_BAR; PG8_SCHED;
            PG8_LDA(At, 1, 1); PG8_STAGE(PG8_SB(1, 0), b3, voffB); PG8_STAGE(PG8_SB(1, 1), b3 + hstep, voffB); PG8_STAGE(PG8_SA(1, 0), a3, voffA);
            PG8_WAIT_V(8); PG8_WAIT_L(0); PG8_BAR; PG8_MMA(1, 0, At, B0); PG8_MMA(1, 1, At, B1); PG8_BAR; PG8_SCHED;
            } else {
            PG8_LDB(B0, 0, 0); PG8_SCHED; PG8_LDA(At, 0, 0); PG8_STAGE(PG8_SA(1, 1), a1 + hstep, voffA);
            PG8_WAIT_L(8); PG8_BAR; PG8_WAIT_L(0); PG8_MMA(0, 0, At, B0); PG8_BAR; PG8_SCHED;
            PG8_LDB(B1, 0, 1); PG8_STAGE(PG8_SB(0, 0), b2, voffB);
            PG8_BAR; PG8_WAIT_L(0); PG8_MMA(0, 1, At, B1); PG8_BAR;
            PG8_LDA(At, 0, 1); PG8_STAGE(PG8_SA(0, 0), a2, voffA);
            PG8_BAR; PG8_WAIT_L(0); PG8_MMA(1, 0, At, B0); PG8_BAR; PG8_SCHED;
            PG8_STAGE(PG8_SB(0, 1), b2 + hstep, voffB);
            PG8_WAIT_V(6); PG8_BAR; PG8_MMA(1, 1, At, B1); PG8_BAR;
            PG8_LDB(B0, 1, 0); PG8_SCHED; PG8_LDA(At, 1, 0); PG8_STAGE(PG8_SA(0, 1), a2 + hstep, voffA);
            PG8_WAIT_L(8); PG8_BAR; PG8_WAIT_L(0); PG8_MMA(0, 0, At, B0); PG8_BAR; PG8_SCHED;
            PG8_LDB(B1, 1, 1); PG8_STAGE(PG8_SB(1, 0), b3, voffB);
            PG8_BAR; PG8_WAIT_L(0); PG8_MMA(0, 1, At, B1); PG8_BAR;
            PG8_LDA(At, 1, 1); PG8_STAGE(PG8_SA(1, 0), a3, voffA);
            PG8_BAR; PG8_WAIT_L(0); PG8_MMA(1, 0, At, B0); PG8_BAR; PG8_SCHED;
            PG8_STAGE(PG8_SB(1, 1), b3 + hstep, voffB);
            PG8_WAIT_V(6); PG8_BAR; PG8_MMA(1, 1, At, B1); PG8_BAR;
            }
        }
        if constexpr (ALIGN_EPI) { if (wr == 0) PG8_BAR; }
        if constexpr (!Epi::AFTER_DRAIN) { E(acc, cur, wr, wc, fr, fq); S.done(cur); }
        if (!has_next) break;
#pragma unroll
        for (int a = 0; a < 2; ++a)
#pragma unroll
            for (int b = 0; b < 2; ++b)
#pragma unroll
                for (int m = 0; m < 4; ++m)
#pragma unroll
                    for (int n = 0; n < 2; ++n) acc[a][b][m][n] = (f32x4){0.f, 0.f, 0.f, 0.f};
        cur = nxt; cA = nA; cB = nB; ++ui;
        if constexpr (ALIGN_EPI) { if (wr == 1) PG8_BAR; }
    }
    PG8_WAIT_V(0);
    if constexpr (!ALIGN_EPI) { if (wr == 0) PG8_BAR; }
    PG8_BAR;
    if constexpr (Epi::AFTER_DRAIN) { E.fused(acc, cur, wr, wc, fr, fq, lds, wid, lane); S.done(cur); }
#undef PG8_SA
#undef PG8_SB
#undef PG8_STAGE
#undef PG8_LDA
#undef PG8_LDB
#undef PG8_MMA
#undef PG8_WAIT_V
#undef PG8_WAIT_L
#undef PG8_BAR
#undef PG8_SCHED
}
}

#define LAS __attribute__((address_space(3)))
typedef unsigned short bf16_t;
typedef short bf16x8 __attribute__((ext_vector_type(8)));
typedef short s16x4 __attribute__((ext_vector_type(4)));
typedef float f32x4 __attribute__((ext_vector_type(4)));
typedef float f32x2 __attribute__((ext_vector_type(2)));
typedef float f32x16 __attribute__((ext_vector_type(16)));
typedef unsigned u32x4 __attribute__((ext_vector_type(4)));
typedef unsigned u32x2 __attribute__((ext_vector_type(2)));
typedef __bf16 bf16x2_t __attribute__((ext_vector_type(2)));

__device__ __forceinline__ unsigned pk2(float lo, float hi) { f32x2 v = {lo, hi}; bf16x2_t b = __builtin_convertvector(v, bf16x2_t); return __builtin_bit_cast(unsigned, b); }
__device__ __forceinline__ float bflo(unsigned u) { return __uint_as_float(u << 16); }
__device__ __forceinline__ float bfhi(unsigned u) { return __uint_as_float(u & 0xffff0000u); }
__device__ __forceinline__ float fexp(float x) { return __builtin_amdgcn_exp2f(x * 1.4426950408889634f); }
__device__ __forceinline__ float frcp(float x) { return __builtin_amdgcn_rcpf(x); }
__device__ __forceinline__ float sigmoidf_(float x) { return frcp(1.f + fexp(-x)); }
template <int CTRL> __device__ __forceinline__ float dpp(float x) { return __builtin_bit_cast(float, __builtin_amdgcn_update_dpp(0, __builtin_bit_cast(int, x), CTRL, 0xf, 0xf, true)); }
__device__ __forceinline__ float swap32_sum(float x) { auto rr = __builtin_amdgcn_permlane32_swap(__float_as_uint(x), __float_as_uint(x), false, false); return __uint_as_float(rr[0]) + __uint_as_float(rr[1]); }
__device__ __forceinline__ float swap32_max(float x) { auto rr = __builtin_amdgcn_permlane32_swap(__float_as_uint(x), __float_as_uint(x), false, false); return fmaxf(__uint_as_float(rr[0]), __uint_as_float(rr[1])); }
__device__ __forceinline__ float swap16_sum(float x) { auto rr = __builtin_amdgcn_permlane16_swap(__float_as_uint(x), __float_as_uint(x), false, false); return __uint_as_float(rr[0]) + __uint_as_float(rr[1]); }
__device__ __forceinline__ float sum8(float x) { x += dpp<0xB1>(x); x += dpp<0x4E>(x); x += dpp<0x141>(x); return x; }
__device__ __forceinline__ float wave_sum(float x) { x += dpp<0xB1>(x); x += dpp<0x4E>(x); x += dpp<0x141>(x); x += dpp<0x140>(x); x = swap16_sum(x); x = swap32_sum(x); return x; }

constexpr size_t MiB = 1u << 20;
constexpr size_t WS_CTL = 0, CTL_ZERO_BYTES = 65536;
constexpr int CW_BAR = 4096, LDS_BARW = 147424;
constexpr size_t WS_ROPE = 1 * MiB;
constexpr size_t WS_LF = 1 * MiB + 640 * 1024;
constexpr size_t WS_W1T = 2 * MiB;
constexpr size_t K64 = 65536;
constexpr size_t WS_W2T = 561 * K64;
constexpr size_t WS_XN = 690 * K64;
constexpr size_t WS_RKV = 1731 * K64;
constexpr size_t WS_GR = 3316 * K64;
constexpr size_t WS_WA = 3845 * K64;
constexpr size_t WS_QD = 3912 * K64, WS_KD = 4441 * K64, WS_VD = 4970 * K64, WS_GD = 5499 * K64;
constexpr size_t WS_Y = 6028 * K64;
constexpr size_t WS_SSQ = 451 * MiB;
constexpr size_t WS_TAIL = 7053 * K64;
constexpr size_t WS_END = 512 * MiB;
constexpr int LDS_BYTES = 147456;
constexpr int LDS_QW = 147440;

struct Args {
    const float* in[21]; float* out; unsigned char* ws; float inv_freq[32]; int ph_lo, ph_hi, coop, pad;
};

constexpr float C2 = 0.125f * 1.4426950408889634f;
struct EpiProj {
    static constexpr bool PERM = true, AFTER_DRAIN = false;
    bf16_t *RKV, *GR, *WA, *QD, *KD, *VD, *GD; const float* rope;
    __device__ __forceinline__ void operator()(const f32x4 (&acc)[2][2][4][2], const pg8::Unit& u, int wr, int wc, int fr, int fq) const {
        const int pn = u.pn; bf16_t* base; int ld, colt, kind = 0;
        if (pn < 12) { base = RKV; ld = 3072; colt = pn * 256; }
        else if (pn < 16) { base = GR; ld = 1024; colt = (pn - 12) * 256; }
        else if (pn < 20) { base = QD; ld = 1024; colt = (pn - 16) * 256; kind = 1; }
        else if (pn < 24) { base = KD; ld = 1024; colt = (pn - 20) * 256; kind = 2; }
        else if (pn < 28) { base = VD; ld = 1024; colt = (pn - 24) * 256; }
        else if (pn < 32) { base = GD; ld = 1024; colt = (pn - 28) * 256; }
        else { base = WA; ld = 128; colt = 0; kind = 3; }
        const bool meta = (u.pm == 64);
        const int pos0 = meta ? 0 : (NMETA + (u.pm & 7) * 256);
        const int brow0 = meta ? 0 : (u.pm >> 3) * LP;
        const int cl = wc * 32 + 8 * fq;
        const int i0 = ((wc & 1) * 16 + 4 * fq);
        const float qs = (kind == 1) ? C2 : 1.f;
#pragma unroll
        for (int ai = 0; ai < 2; ++ai)
#pragma unroll
            for (int m = 0; m < 4; ++m) {
                const int rt = ai * 128 + wr * 64 + m * 16 + fr;
                if (meta && rt >= NMETA) continue;
                const int pos = pos0 + rt;
#pragma unroll
                for (int bj = 0; bj < 2; ++bj) {
                    if (kind == 3 && bj == 1) continue;
                    f32x4 v0 = acc[ai][bj][m][0], v1 = acc[ai][bj][m][1];
                    if (kind == 1 || kind == 2) {
                        const f32x4 cs0 = *(const f32x4*)(rope + ((size_t)pos * 32 + i0) * 2), cs1 = *(const f32x4*)(rope + ((size_t)pos * 32 + i0) * 2 + 4);
                        f32x4 o0, o1;
                        o0[0] = (v0[0] * cs0[0] - v0[1] * cs0[1]) * qs; o0[1] = (v0[1] * cs0[0] + v0[0] * cs0[1]) * qs;
                        o0[2] = (v0[2] * cs0[2] - v0[3] * cs0[3]) * qs; o0[3] = (v0[3] * cs0[2] + v0[2] * cs0[3]) * qs;
                        o1[0] = (v1[0] * cs1[0] - v1[1] * cs1[1]) * qs; o1[1] = (v1[1] * cs1[0] + v1[0] * cs1[1]) * qs;
                        o1[2] = (v1[2] * cs1[2] - v1[3] * cs1[3]) * qs; o1[3] = (v1[3] * cs1[2] + v1[2] * cs1[3]) * qs;
                        v0 = o0; v1 = o1;
                    }
                    u32x4 w; w.x = pk2(v0[0], v0[1]); w.y = pk2(v0[2], v0[3]); w.z = pk2(v1[0], v1[1]); w.w = pk2(v1[2], v1[3]);
                    const int col = colt + bj * 128 + cl;
                    if (!meta) { *(u32x4*)(base + (size_t)(brow0 + pos) * ld + col) = w; }
                    else {
#pragma unroll
                        for (int b = 0; b < NB; ++b) *(u32x4*)(base + (size_t)(b * LP + pos) * ld + col) = w;
                    }
                }
            }
    }
};

struct EpiY {
    static constexpr bool PERM = true, AFTER_DRAIN = false;
    bf16_t* YO; float* SSQ;
    __device__ __forceinline__ void operator()(const f32x4 (&acc)[2][2][4][2], const pg8::Unit& u, int wr, int wc, int fr, int fq) const {
        const int cl = u.pn * 256 + wc * 32 + 8 * fq;
#pragma unroll
        for (int ai = 0; ai < 2; ++ai)
#pragma unroll
            for (int m = 0; m < 4; ++m) {
                const int row = u.pm * 256 + ai * 128 + wr * 64 + m * 16 + fr;
#pragma unroll
                for (int bj = 0; bj < 2; ++bj) {
                    const f32x4 v0 = acc[ai][bj][m][0], v1 = acc[ai][bj][m][1];
                    u32x4 w; w.x = pk2(v0[0], v0[1]); w.y = pk2(v0[2], v0[3]); w.z = pk2(v1[0], v1[1]); w.w = pk2(v1[2], v1[3]);
                    *(u32x4*)(YO + (size_t)row * DM + cl + bj * 128) = w;
                }
            }
    }
};

__device__ __forceinline__ int w1_src_col(int n) {
    const int t = n >> 8, ct = n & 255;
    if (t < 12) return n;
    if (t < 16) return 3200 + (n - 3072);
    if (t < 24) { const int base = 4224 + (t - 16) * 256, hc = ct >> 6, p = ct & 63; return base + hc * 64 + (p >> 1) + 32 * (p & 1); }
    if (t < 32) return 6272 + (n - 6144);
    return ct < 128 ? 3072 + ct : -1;
}
template <bool MAP> __device__ __forceinline__ void p0_transpose_item(const float* W, int NS, bf16_t* WT, int nblk, LAS float* scr, int item, int lane) {
    const int kb = item / nblk, nb = item % nblk, k0 = 64 * kb, n0 = 32 * nb;
    const int sc = MAP ? w1_src_col(n0 + (lane & 31)) : (n0 + (lane & 31));
#pragma unroll 8
    for (int i = 0; i < 32; ++i) { const int kk = 2 * i + (lane >> 5); scr[kk * 33 + (lane & 31)] = (sc >= 0) ? W[(size_t)(k0 + kk) * NS + sc] : 0.f; }
    asm volatile("s_waitcnt lgkmcnt(0)" ::: "memory");
    const int c = lane & 7;
#pragma unroll
    for (int j = 0; j < 4; ++j) { const int n = (lane >> 3) + 8 * j; const LAS float* s = scr + (8 * c) * 33 + n;
        u32x4 o; o.x = pk2(s[0 * 33], s[1 * 33]); o.y = pk2(s[2 * 33], s[3 * 33]); o.z = pk2(s[4 * 33], s[5 * 33]); o.w = pk2(s[6 * 33], s[7 * 33]);
        *(u32x4*)(WT + (size_t)(n0 + n) * 2048 + k0 + 8 * c) = o; }
    asm volatile("s_waitcnt lgkmcnt(0)" ::: "memory");
}


__device__ __forceinline__ int w1_dst_row(int j) {
    if (j < 3072) return j;
    if (j < 3200) return 8192 + (j - 3072);
    if (j < 4224) return 3072 + (j - 3200);
    if (j < 6272) { const int rel = j - 4224, d = rel & 63, grp = rel >> 6; return 4096 + grp * 64 + ((d < 32) ? 2 * d : 2 * (d - 32) + 1); }
    return 6144 + (j - 6272);
}
template <bool MAP> __device__ __forceinline__ void p0_transpose128(const float* W, int NS, bf16_t* WT, int nblk, LAS float* scr, int item, int lane) {
    const int kb = item / nblk, nb = item % nblk, k0 = 32 * kb, n0 = 128 * nb;
#pragma unroll 4
    for (int i = 0; i < 16; ++i) { const int k = 2 * i + (lane >> 5); *(LAS f32x4*)(scr + k * 132 + 4 * (lane & 31)) = *(const f32x4*)(W + (size_t)(k0 + k) * NS + n0 + 4 * (lane & 31)); }
    asm volatile("s_waitcnt lgkmcnt(0)" ::: "memory");
    const int kq = lane >> 4, nl = lane & 15;
#pragma unroll
    for (int p = 0; p < 8; ++p) { const int n = 16 * p + nl; const LAS float* sp = scr + (8 * kq) * 132 + n;
        u32x4 o; o.x = pk2(sp[0 * 132], sp[1 * 132]); o.y = pk2(sp[2 * 132], sp[3 * 132]); o.z = pk2(sp[4 * 132], sp[5 * 132]); o.w = pk2(sp[6 * 132], sp[7 * 132]);
        const int dr = MAP ? w1_dst_row(n0 + n) : (n0 + n);
        *(u32x4*)(WT + (size_t)dr * 2048 + k0 + 8 * kq) = o; }
    asm volatile("s_waitcnt lgkmcnt(0)" ::: "memory");
}

constexpr int P0_NB1 = NIN / 64, P0_I1 = 32 * P0_NB1, P0_I2 = 32 * 32;
__device__ __forceinline__ void p0_ld(f32x4 (&r)[16], const Args& A, int it, int lane) {
    const bool w1 = it < P0_I1; const float* W = w1 ? A.in[3] : A.in[19]; const int NS = w1 ? NIN : 2048, nblk = w1 ? P0_NB1 : 32, item = w1 ? it : it - P0_I1;
    const int kb = item / nblk, nb = item % nblk;
    const float* p = W + (size_t)(64 * kb + (lane >> 4)) * NS + 64 * nb + 4 * (lane & 15);
#pragma unroll
    for (int i = 0; i < 16; ++i) r[i] = __builtin_nontemporal_load((const f32x4*)(p + (size_t)(4 * i) * NS));
}
__device__ __forceinline__ void p0_emit(const f32x4 (&r)[16], bf16_t* W1T, bf16_t* W2T, LAS float* scr, int it, int lane) {
    const bool w1 = it < P0_I1; const int nblk = w1 ? P0_NB1 : 32, item = w1 ? it : it - P0_I1;
    const int kb = item / nblk, nb = item % nblk, k0 = 64 * kb, n0 = 64 * nb;
#pragma unroll
    for (int i = 0; i < 16; ++i) *(LAS f32x4*)(scr + (4 * i + (lane >> 4)) * 68 + 4 * (lane & 15)) = r[i];
    asm volatile("s_waitcnt lgkmcnt(0)" ::: "memory");
    bf16_t* WT = w1 ? W1T : W2T;
    const int dr = w1 ? w1_dst_row(n0 + lane) : (n0 + lane);
    bf16_t* dst = WT + (size_t)dr * 2048 + k0;
#pragma unroll
    for (int p = 0; p < 8; ++p) { const LAS float* sp = scr + (8 * p) * 68 + lane;
        u32x4 o; o.x = pk2(sp[0 * 68], sp[1 * 68]); o.y = pk2(sp[2 * 68], sp[3 * 68]); o.z = pk2(sp[4 * 68], sp[5 * 68]); o.w = pk2(sp[6 * 68], sp[7 * 68]);
        *(u32x4*)(dst + 8 * p) = o; }
    asm volatile("s_waitcnt lgkmcnt(0)" ::: "memory");
}

constexpr int RW_NCH = 65, RW_TASKS = 128 * RW_NCH, RW_TB = 24832;
constexpr int RW_SEG0 = 5400;
__device__ __forceinline__ unsigned char* rw_block(const Args& A, int task) {
    if (task < RW_SEG0) return (unsigned char*)A.out + (size_t)task * RW_TB;
    return A.ws + WS_TAIL + (size_t)(task - RW_SEG0) * RW_TB;
}
__device__ __forceinline__ int Tk(int r, int hi) { return (r & 3) + 8 * (r >> 2) + 4 * hi; }
__device__ __forceinline__ bf16x8 pack8(const f32x16& x, int s) {
    return __builtin_bit_cast(bf16x8, (u32x4){pk2(x[8 * s], x[8 * s + 1]), pk2(x[8 * s + 2], x[8 * s + 3]), pk2(x[8 * s + 4], x[8 * s + 5]), pk2(x[8 * s + 6], x[8 * s + 7])});
}
__device__ __forceinline__ bf16x8 neg8(bf16x8 v) { u32x4 u = __builtin_bit_cast(u32x4, v); u ^= (u32x4){0x80008000u, 0x80008000u, 0x80008000u, 0x80008000u}; return __builtin_bit_cast(bf16x8, u); }
__device__ __forceinline__ float sum32h(float x) { x += dpp<0xB1>(x); x += dpp<0x4E>(x); x += dpp<0x141>(x); x += dpp<0x140>(x); return swap16_sum(x); }
#define MFMA32(a, b, c) __builtin_amdgcn_mfma_f32_32x32x16_bf16((a), (b), (c), 0, 0, 0)

#define BUFR(p, bytes) __builtin_amdgcn_make_buffer_rsrc((void*)(p), (short)0, (int)(bytes), 0x00020000)
#define SBAR0 do {} while (0)
namespace rwa {
__device__ __forceinline__ unsigned offm(unsigned t, unsigned p) { const unsigned f = (((t >> 1) & 1u) << 2) | ((t >> 2) & 3u); return 128u * t + 16u * ((p >> 3) ^ f) + 2u * (p & 7u); }
__device__ __forceinline__ void st16(LAS unsigned char* p, float x) { *(LAS bf16_t*)p = (bf16_t)(pk2(x, 0.f) & 0xffffu); }

__device__ __forceinline__ void task(const Args& A, int task, LAS unsigned char* wl, int lane_) {
    int lane = lane_; asm volatile("" : "+v"(lane));
    const int n = lane & 31, hi = lane >> 5;
    const int ch = task / RW_NCH, c = task - ch * RW_NCH, b = ch >> 4, h = ch & 15, t0 = 32 * c;
    const size_t rowb = (size_t)b * LP + t0;
    const __amdgpu_buffer_rsrc_t rR = BUFR((const bf16_t*)(A.ws + WS_RKV) + (rowb - 1) * 3072 + h * 64, 34 * 6144);
    const __amdgpu_buffer_rsrc_t rW = BUFR((const bf16_t*)(A.ws + WS_WA) + (rowb - 1) * 128, 34 * 256);
    const __amdgpu_buffer_rsrc_t rL = BUFR((const unsigned char*)(A.ws + WS_LF) + (size_t)h * 16384, 16384);
    unsigned char* ob = rw_block(A, task);
    const __amdgpu_buffer_rsrc_t rO = BUFR(ob, RW_TB);
    const __amdgpu_buffer_rsrc_t rPQ = BUFR(ob, (c == RW_NCH - 1) ? 0 : RW_TB);
    const float* mu = A.in[4];
    f32x16 accw[2], acca[2];
#pragma unroll
    for (int i = 0; i < 16; ++i) { accw[0][i] = 0.f; accw[1][i] = 0.f; acca[0][i] = 0.f; acca[1][i] = 0.f; }
    {
        const bool hasp = (t0 + n) > 0;
        const unsigned vo = (unsigned)(n * 256 + 16 * hi);
        u32x4 wcw[4], wca[4], wpw[4], wpa[4], lfw[4][2], lfa[4][2];
#pragma unroll
        for (int s = 0; s < 4; ++s) {
            wcw[s] = __builtin_amdgcn_raw_buffer_load_b128(rW, vo, 256 + 32 * s, 0); wca[s] = __builtin_amdgcn_raw_buffer_load_b128(rW, vo, 256 + 128 + 32 * s, 0);
            wpw[s] = __builtin_amdgcn_raw_buffer_load_b128(rW, vo, 32 * s, 0); wpa[s] = __builtin_amdgcn_raw_buffer_load_b128(rW, vo, 128 + 32 * s, 0); }
#pragma unroll
        for (int s = 0; s < 4; ++s)
#pragma unroll
            for (int nb = 0; nb < 2; ++nb) { lfw[s][nb] = __builtin_amdgcn_raw_buffer_load_b128(rL, (unsigned)lane * 16u, ((0 * 2 + nb) * 4 + s) * 1024, 0);
                                             lfa[s][nb] = __builtin_amdgcn_raw_buffer_load_b128(rL, (unsigned)lane * 16u, ((1 * 2 + nb) * 4 + s) * 1024, 0); }
        asm volatile("" ::: "memory");
#pragma unroll
        for (int s = 0; s < 4; ++s) {
            const u32x4 cw = wcw[s], ca = wca[s];
            u32x4 pw = wpw[s], pa = wpa[s];
            if (!hasp) { pw = (u32x4){0u, 0u, 0u, 0u}; pa = (u32x4){0u, 0u, 0u, 0u}; }
            const f32x4 mw0 = *(const f32x4*)(mu + 3072 + 16 * s + 8 * hi), mw1 = *(const f32x4*)(mu + 3072 + 16 * s + 8 * hi + 4);
            const f32x4 ma0 = *(const f32x4*)(mu + 3136 + 16 * s + 8 * hi), ma1 = *(const f32x4*)(mu + 3136 + 16 * s + 8 * hi + 4);
            const float mwv[8] = {mw0[0], mw0[1], mw0[2], mw0[3], mw1[0], mw1[1], mw1[2], mw1[3]}, mav[8] = {ma0[0], ma0[1], ma0[2], ma0[3], ma1[0], ma1[1], ma1[2], ma1[3]};
            float xw[8], xa[8];
#pragma unroll
            for (int j = 0; j < 4; ++j) {
                const float c0 = bflo(cw[j]), c1 = bfhi(cw[j]), p0 = bflo(pw[j]), p1 = bfhi(pw[j]);
                const float w0_ = c0 + (p0 - c0) * mwv[2 * j], w1_ = c1 + (p1 - c1) * mwv[2 * j + 1];
                xw[2 * j] = 1.f - 2.f * frcp(fexp(2.f * w0_) + 1.f); xw[2 * j + 1] = 1.f - 2.f * frcp(fexp(2.f * w1_) + 1.f);
                const float d0 = bflo(ca[j]), d1 = bfhi(ca[j]), q0 = bflo(pa[j]), q1 = bfhi(pa[j]);
                xa[2 * j] = d0 + (q0 - d0) * mav[2 * j]; xa[2 * j + 1] = d1 + (q1 - d1) * mav[2 * j + 1];
            }
            const bf16x8 Aw = __builtin_bit_cast(bf16x8, (u32x4){pk2(xw[0], xw[1]), pk2(xw[2], xw[3]), pk2(xw[4], xw[5]), pk2(xw[6], xw[7])});
            const bf16x8 Aa = __builtin_bit_cast(bf16x8, (u32x4){pk2(xa[0], xa[1]), pk2(xa[2], xa[3]), pk2(xa[4], xa[5]), pk2(xa[6], xa[7])});
#pragma unroll
            for (int nb = 0; nb < 2; ++nb) {
                accw[nb] = MFMA32(Aw, __builtin_bit_cast(bf16x8, lfw[s][nb]), accw[nb]); acca[nb] = MFMA32(Aa, __builtin_bit_cast(bf16x8, lfa[s][nb]), acca[nb]);
            }
            SBAR0;
        }
    }
    __builtin_amdgcn_s_barrier();
    const f32x2 w0v = *(const f32x2*)(A.in[5] + h * 64 + 2 * n), a0v = *(const f32x2*)(A.in[7] + h * 64 + 2 * n);
    float gC[2]; unsigned aap[2][8];
#pragma unroll
    for (int nb = 0; nb < 2; ++nb) {
        float prod = 1.f;
#pragma unroll
        for (int r = 0; r < 16; ++r) { const bool valid = (t0 + Tk(r, hi)) < LSEQ; const float sg = sigmoidf_(accw[nb][r] + w0v[nb]); const float d = valid ? fexp(-0.6065306597126334f * sg) : 1.f; accw[nb][r] = d; prod *= d; }
        const auto sw = __builtin_amdgcn_permlane32_swap(__float_as_uint(prod), __float_as_uint(prod), false, false);
        gC[nb] = __uint_as_float(sw[0]) * __uint_as_float(sw[1]);
#pragma unroll
        for (int i = 0; i < 8; ++i) aap[nb][i] = pk2(sigmoidf_(acca[nb][2 * i] + a0v[nb]), sigmoidf_(acca[nb][2 * i + 1] + a0v[nb]));
    }
    SBAR0;
    const f32x2 mur = *(const f32x2*)(mu + h * 64 + 2 * n), muk = *(const f32x2*)(mu + 1024 + h * 64 + 2 * n);
    const f32x2 kkw = *(const f32x2*)(A.in[9] + h * 64 + 2 * n), kaw = *(const f32x2*)(A.in[10] + h * 64 + 2 * n), rkw = *(const f32x2*)(A.in[11] + h * 64 + 2 * n);
    const unsigned voR = (unsigned)(hi * 4 * 6144 + 4 * n);
    u32x4 pKKg[2][2], pBc[2][2], pKc[2][2];
    const __amdgpu_buffer_rsrc_t rB = BUFR(ob + 24576, 128);
    float run0 = 1.f, run1 = 1.f;
    unsigned crn[5], ckn[5];
#pragma unroll
    for (int i = 0; i < 5; ++i) { crn[i] = __builtin_amdgcn_raw_buffer_load_b32(rR, voR, i * 6144, 0); ckn[i] = __builtin_amdgcn_raw_buffer_load_b32(rR, voR, i * 6144 + 2048, 0); }
#pragma unroll
    for (int g = 0; g < 4; ++g) {
        int ln = lane; asm volatile("" : "+v"(ln)); const int n2 = ln & 31, hi2 = ln >> 5;
        unsigned crg[5], ckg[5];
#pragma unroll
        for (int i = 0; i < 5; ++i) { crg[i] = crn[i]; ckg[i] = ckn[i]; }
        if (t0 + Tk(4 * g, hi2) == 0) { crg[0] = 0u; ckg[0] = 0u; }
        if (g < 3) {
#pragma unroll
            for (int i = 0; i < 5; ++i) { crn[i] = __builtin_amdgcn_raw_buffer_load_b32(rR, voR, (8 * (g + 1) + i) * 6144, 0); ckn[i] = __builtin_amdgcn_raw_buffer_load_b32(rR, voR, (8 * (g + 1) + i) * 6144 + 2048, 0); }
        }
        float Gi[2][4], Gx[2][4];
#pragma unroll
        for (int nb = 0; nb < 2; ++nb) {
            const float p0 = accw[nb][4 * g], p1 = p0 * accw[nb][4 * g + 1], p2 = p1 * accw[nb][4 * g + 2], p3 = p2 * accw[nb][4 * g + 3];
            const auto sw = __builtin_amdgcn_permlane32_swap(__float_as_uint(p3), __float_as_uint(p3), false, false);
            const float other = hi2 ? __uint_as_float(sw[0]) : __uint_as_float(sw[1]);
            const float run = nb ? run1 : run0;
            const float pre = hi2 ? run * other : run;
            Gi[nb][0] = pre * p0; Gi[nb][1] = pre * p1; Gi[nb][2] = pre * p2; Gi[nb][3] = pre * p3;
            Gx[nb][0] = pre; Gx[nb][1] = pre * p0; Gx[nb][2] = pre * p1; Gx[nb][3] = pre * p2;
            if (nb) run1 = run * p3 * other; else run0 = run * p3 * other;
        }
#pragma unroll
        for (int hp = 0; hp < 2; ++hp) {
            float oKKg[2][2], oBc[2][2], oKc[2][2];
#pragma unroll
            for (int e = 0; e < 2; ++e) {
                const int i4 = 2 * hp + e, r = 4 * g + i4, T = Tk(r, hi2);
                const bool valid = (t0 + T) < LSEQ;
                const unsigned cr_ = crg[i4 + 1], pr = crg[i4], ck_ = ckg[i4 + 1], pk = ckg[i4];
                float rr[2], kr[2];
                { const float c0 = bflo(cr_), c1 = bfhi(cr_), p0 = bflo(pr), p1 = bfhi(pr); rr[0] = valid ? c0 + (p0 - c0) * mur[0] : 0.f; rr[1] = valid ? c1 + (p1 - c1) * mur[1] : 0.f; }
                { const float c0 = bflo(ck_), c1 = bfhi(ck_), p0 = bflo(pk), p1 = bfhi(pk); kr[0] = c0 + (p0 - c0) * muk[0]; kr[1] = c1 + (p1 - c1) * muk[1]; }
                const float a0_ = (r & 1) ? bfhi(aap[0][r >> 1]) : bflo(aap[0][r >> 1]), a1_ = (r & 1) ? bfhi(aap[1][r >> 1]) : bflo(aap[1][r >> 1]);
                float k0 = kr[0] * kkw[0], k1 = kr[1] * kkw[1];
                const float ss = sum32h(k0 * k0 + k1 * k1); const float inv = valid ? __builtin_amdgcn_rsqf(fmaxf(ss, 1e-24f)) : 0.f;
                k0 *= inv; k1 *= inv;
                const float kp0 = valid ? kr[0] * (1.f + (a0_ - 1.f) * kaw[0]) : 0.f, kp1 = valid ? kr[1] * (1.f + (a1_ - 1.f) * kaw[1]) : 0.f;
                const float bs = sum32h(rr[0] * kp0 * rkw[0] + rr[1] * kp1 * rkw[1]);
                if (n2 == 0) __builtin_amdgcn_raw_buffer_store_b32(__float_as_uint(bs), rB, (unsigned)(hi2 * 16), 4 * (i4 + 8 * g), 0);
                const float ig0 = frcp(Gi[0][i4]), ig1 = frcp(Gi[1][i4]);
                const float kkg0 = k0 * Gx[0][i4], kkg1 = k1 * Gx[1][i4], rg0 = rr[0] * Gi[0][i4], rg1 = rr[1] * Gi[1][i4];
                const float bi0 = k0 * a0_ * ig0, bi1 = k1 * a1_ * ig1, ki0 = kp0 * ig0, ki1 = kp1 * ig1;
                LAS unsigned char* q0 = wl + offm(T, n2); LAS unsigned char* q1 = wl + offm(T, 32 + n2);
                st16(q0, kkg0); st16(q1, kkg1); st16(q0 + 4096, rg0); st16(q1 + 4096, rg1); st16(q0 + 8192, bi0); st16(q1 + 8192, bi1); st16(q0 + 12288, ki0); st16(q1 + 12288, ki1);
                oKKg[0][e] = kkg0; oKKg[1][e] = kkg1; oBc[0][e] = bi0 * gC[0]; oBc[1][e] = bi1 * gC[1]; oKc[0][e] = ki0 * gC[0]; oKc[1][e] = ki1 * gC[1];
            }
#pragma unroll
            for (int nb = 0; nb < 2; ++nb) { pKKg[nb][g >> 1][2 * (g & 1) + hp] = pk2(oKKg[nb][0], oKKg[nb][1]); pBc[nb][g >> 1][2 * (g & 1) + hp] = pk2(oBc[nb][0], oBc[nb][1]); pKc[nb][g >> 1][2 * (g & 1) + hp] = pk2(oKc[nb][0], oKc[nb][1]); }
            SBAR0;
        }
    }
    bf16x8 fKKg[2][2], fBc[2][2], fKc[2][2], fV[2][2];
#pragma unroll
    for (int nb = 0; nb < 2; ++nb)
#pragma unroll
        for (int s_ = 0; s_ < 2; ++s_) { fKKg[nb][s_] = __builtin_bit_cast(bf16x8, pKKg[nb][s_]); fBc[nb][s_] = __builtin_bit_cast(bf16x8, pBc[nb][s_]); fKc[nb][s_] = __builtin_bit_cast(bf16x8, pKc[nb][s_]); }
    {
        const unsigned voV = (unsigned)(hi * 4 * 6144 + 4 * n);
        const f32x2 muv = *(const f32x2*)(mu + 2048 + h * 64 + 2 * n);
        unsigned cv[16], pv4[4]; f32x16 x0, x1;
#pragma unroll
        for (int r = 0; r < 16; ++r) { const int T0 = (r & 3) + 8 * (r >> 2); cv[r] = __builtin_amdgcn_raw_buffer_load_b32(rR, voV, (T0 + 1) * 6144 + 4096, 0); }
#pragma unroll
        for (int g = 0; g < 4; ++g) pv4[g] = __builtin_amdgcn_raw_buffer_load_b32(rR, voV, (8 * g) * 6144 + 4096, 0);
        asm volatile("" : "+v"(pv4[0]), "+v"(pv4[1]), "+v"(pv4[2]), "+v"(pv4[3]));
#pragma unroll
        for (int g = 0; g < 4; ++g) if (t0 + Tk(4 * g, hi) == 0) pv4[g] = 0u;
#pragma unroll
        for (int r = 0; r < 16; ++r) { const unsigned pv = (r & 3) ? cv[r - 1] : pv4[r >> 2]; const bool valid = (t0 + Tk(r, hi)) < LSEQ;
            const float c0 = bflo(cv[r]), c1 = bfhi(cv[r]), p0 = bflo(pv), p1 = bfhi(pv);
            x0[r] = valid ? c0 + (p0 - c0) * muv[0] : 0.f; x1[r] = valid ? c1 + (p1 - c1) * muv[1] : 0.f; }
        fV[0][0] = pack8(x0, 0); fV[0][1] = pack8(x0, 1); fV[1][0] = pack8(x1, 0); fV[1][1] = pack8(x1, 1);
    }
    asm volatile("s_waitcnt lgkmcnt(0)" ::: "memory");
    SBAR0;
    __builtin_amdgcn_s_barrier();
    f32x16 Sbb, Sbk, Arb, Ark;
#pragma unroll
    for (int i = 0; i < 16; ++i) { Sbb[i] = 0.f; Sbk[i] = 0.f; Arb[i] = 0.f; Ark[i] = 0.f; }
#pragma unroll
    for (int s = 0; s < 4; ++s) {
        const unsigned o = offm(n, 16 * s + 8 * hi);
        const bf16x8 kg = *(const LAS bf16x8*)(wl + 0 * 4096 + o), rg = *(const LAS bf16x8*)(wl + 1 * 4096 + o), bi = *(const LAS bf16x8*)(wl + 2 * 4096 + o), ki = *(const LAS bf16x8*)(wl + 3 * 4096 + o);
        Sbb = MFMA32(bi, kg, Sbb); Sbk = MFMA32(ki, kg, Sbk); Arb = MFMA32(bi, rg, Arb); Ark = MFMA32(ki, rg, Ark);
        SBAR0;
    }
#pragma unroll
    for (int r = 0; r < 16; ++r) { const int j = Tk(r, hi); if (!(j < n)) { Sbb[r] = 0.f; Sbk[r] = 0.f; } if (!(j <= n)) { Arb[r] = 0.f; Ark[r] = 0.f; } }
    SBAR0;
    f32x16 Yl[2]; bf16x8 fZ[2][2];
    {
        const bf16x8 sk0 = pack8(Sbk, 0), sk1 = pack8(Sbk, 1), ak0 = pack8(Ark, 0), ak1 = pack8(Ark, 1);
#pragma unroll
        for (int vt = 0; vt < 2; ++vt) {
            f32x16 z;
#pragma unroll
            for (int i = 0; i < 16; ++i) z[i] = 0.f;
            const f32x16 zz = MFMA32(sk1, fV[vt][1], MFMA32(sk0, fV[vt][0], z));
            fZ[vt][0] = pack8(zz, 0); fZ[vt][1] = pack8(zz, 1);
            Yl[vt] = MFMA32(ak1, fV[vt][1], MFMA32(ak0, fV[vt][0], z));
        }
    }
#pragma unroll
    for (int i = 0; i < 2; ++i)
#pragma unroll
        for (int s_ = 0; s_ < 2; ++s_) { *(LAS bf16x8*)(wl + 8192 + ((i * 2 + s_) * 64 + lane) * 16) = fKc[i][s_]; *(LAS bf16x8*)(wl + 12288 + ((i * 2 + s_) * 64 + lane) * 16) = fV[i][s_]; }
    const bf16x8 fArb0 = pack8(Arb, 0), fArb1 = pack8(Arb, 1);
    SBAR0;
    __builtin_amdgcn_s_barrier();
    float TH[16];
    {
        LAS float* Mc = (LAS float*)wl;
#pragma unroll
        for (int r = 0; r < 16; ++r) Mc[Tk(r, hi) * 32 + n] = Sbb[r];
        asm volatile("s_waitcnt lgkmcnt(0)" ::: "memory");
#pragma unroll
        for (int i = 0; i < 16; ++i) TH[i] = ((4 * (2 * (i >> 2) + hi) + (i & 3)) == n) ? 1.f : 0.f;
        unsigned mh = (unsigned)(size_t)(Mc + 4 * hi);
        f32x4 mcur[4], mnxt[4];
        mcur[3] = *(const LAS f32x4*)(size_t)(mh + (30 * 32 + 8 * 3) * 4);
        mnxt[0] = mnxt[1] = mnxt[2] = mnxt[3] = mcur[3];
#pragma unroll
        for (int c = 30; c >= 0; --c) {
            if (c > 0) {
#pragma unroll
                for (int qq = (c >> 3); qq < 4; ++qq) mnxt[qq] = *(const LAS f32x4*)(size_t)(mh + ((c - 1) * 32 + 8 * qq) * 4);
            }
            float part = 0.f;
#pragma unroll
            for (int qq = ((c + 1) >> 3); qq < 4; ++qq) part += (TH[4 * qq] * mcur[qq][0] + TH[4 * qq + 1] * mcur[qq][1]) + (TH[4 * qq + 2] * mcur[qq][2] + TH[4 * qq + 3] * mcur[qq][3]);
            float tot = swap32_sum(part);
            asm volatile("" : "+v"(mh), "+v"(tot));
            const int idx = 4 * (c >> 3) + (c & 3), owner = (c >> 2) & 1;
            TH[idx] = (hi == owner) ? ((c == n) ? 1.f : -tot) : TH[idx];
#pragma unroll
            for (int qq = 0; qq < 4; ++qq) mcur[qq] = mnxt[qq];
        }
    }
    bf16x8 fT[2];
#pragma unroll
    for (int s_ = 0; s_ < 2; ++s_) fT[s_] = __builtin_bit_cast(bf16x8, (u32x4){pk2(TH[8 * s_], TH[8 * s_ + 1]), pk2(TH[8 * s_ + 2], TH[8 * s_ + 3]), pk2(TH[8 * s_ + 4], TH[8 * s_ + 5]), pk2(TH[8 * s_ + 6], TH[8 * s_ + 7])});
    SBAR0;
    __builtin_amdgcn_s_barrier();
    bf16x8 fKKt[2][2], fW[2][2];
#pragma unroll
    for (int i = 0; i < 2; ++i) {
        f32x16 z;
#pragma unroll
        for (int q = 0; q < 16; ++q) z[q] = 0.f;
        const f32x16 kkt = MFMA32(fT[1], fKKg[i][1], MFMA32(fT[0], fKKg[i][0], z));
        const f32x16 w = MFMA32(fT[1], fZ[i][1], MFMA32(fT[0], fZ[i][0], z));
        fKKt[i][0] = pack8(kkt, 0); fKKt[i][1] = pack8(kkt, 1); fW[i][0] = neg8(pack8(w, 0)); fW[i][1] = neg8(pack8(w, 1));
    }
    SBAR0;
    const unsigned vo16 = (unsigned)lane * 16u;
#pragma unroll
    for (int i = 0; i < 2; ++i)
#pragma unroll
        for (int s_ = 0; s_ < 2; ++s_) { fKc[i][s_] = *(const LAS bf16x8*)(wl + 8192 + ((i * 2 + s_) * 64 + lane) * 16); fV[i][s_] = *(const LAS bf16x8*)(wl + 12288 + ((i * 2 + s_) * 64 + lane) * 16); }
#pragma unroll
    for (int kt = 0; kt < 2; ++kt)
#pragma unroll
        for (int kp = 0; kp < 2; ++kp) {
            f32x16 z;
#pragma unroll
            for (int q = 0; q < 16; ++q) z[q] = 0.f;
            f32x16 a = MFMA32(fKKt[kp][1], fBc[kt][1], MFMA32(fKKt[kp][0], fBc[kt][0], z));
#pragma unroll
            for (int r = 0; r < 16; ++r) a[r] = ((kt == kp && Tk(r, hi) == n) ? gC[kt] : 0.f) - a[r];
            __builtin_amdgcn_raw_buffer_store_b128(__builtin_bit_cast(u32x4, pack8(a, 0)), rPQ, vo16, ((kt * 2 + kp) * 2 + 0) * 1024, 0);
            __builtin_amdgcn_raw_buffer_store_b128(__builtin_bit_cast(u32x4, pack8(a, 1)), rPQ, vo16, ((kt * 2 + kp) * 2 + 1) * 1024, 0);
        }
    SBAR0;
#pragma unroll
    for (int kt = 0; kt < 2; ++kt)
#pragma unroll
        for (int vt = 0; vt < 2; ++vt) {
            f32x16 z;
#pragma unroll
            for (int q = 0; q < 16; ++q) z[q] = 0.f;
            f32x16 a = MFMA32(fKc[kt][1], fV[vt][1], MFMA32(fKc[kt][0], fV[vt][0], z));
            a = MFMA32(fBc[kt][1], fW[vt][1], MFMA32(fBc[kt][0], fW[vt][0], a));
            __builtin_amdgcn_raw_buffer_store_b128(__builtin_bit_cast(u32x4, pack8(a, 0)), rPQ, vo16, 8192 + ((kt * 2 + vt) * 2 + 0) * 1024, 0);
            __builtin_amdgcn_raw_buffer_store_b128(__builtin_bit_cast(u32x4, pack8(a, 1)), rPQ, vo16, 8192 + ((kt * 2 + vt) * 2 + 1) * 1024, 0);
        }
    SBAR0;
#pragma unroll
    for (int kp = 0; kp < 2; ++kp) {
        f32x16 z;
#pragma unroll
        for (int q = 0; q < 16; ++q) z[q] = 0.f;
        f32x16 a = MFMA32(fKKt[kp][1], fArb1, MFMA32(fKKt[kp][0], fArb0, z));
#pragma unroll
        for (int g = 0; g < 4; ++g) { const u32x2 rg = *(const LAS u32x2*)(wl + 1 * 4096 + offm(n, kp * 32 + 8 * g + 4 * hi));
            a[4 * g] = bflo(rg.x) - a[4 * g]; a[4 * g + 1] = bfhi(rg.x) - a[4 * g + 1]; a[4 * g + 2] = bflo(rg.y) - a[4 * g + 2]; a[4 * g + 3] = bfhi(rg.y) - a[4 * g + 3]; }
        __builtin_amdgcn_raw_buffer_store_b128(__builtin_bit_cast(u32x4, pack8(a, 0)), rO, vo16, 16384 + (kp * 2 + 0) * 1024, 0);
        __builtin_amdgcn_raw_buffer_store_b128(__builtin_bit_cast(u32x4, pack8(a, 1)), rO, vo16, 16384 + (kp * 2 + 1) * 1024, 0);
    }
    SBAR0;
#pragma unroll
    for (int vt = 0; vt < 2; ++vt) {
        const f32x16 a = MFMA32(fArb1, fW[vt][1], MFMA32(fArb0, fW[vt][0], Yl[vt]));
        __builtin_amdgcn_raw_buffer_store_b128(__builtin_bit_cast(u32x4, pack8(a, 0)), rO, vo16, 20480 + (vt * 2 + 0) * 1024, 0);
        __builtin_amdgcn_raw_buffer_store_b128(__builtin_bit_cast(u32x4, pack8(a, 1)), rO, vo16, 20480 + (vt * 2 + 1) * 1024, 0);
    }
    asm volatile("s_waitcnt lgkmcnt(0)" ::: "memory");
}
}

namespace rwb {
__device__ __forceinline__ f32x16 unpack16(u32x4 a, u32x4 b) {
    f32x16 x; x[0] = bflo(a.x); x[1] = bfhi(a.x); x[2] = bflo(a.y); x[3] = bfhi(a.y); x[4] = bflo(a.z); x[5] = bfhi(a.z); x[6] = bflo(a.w); x[7] = bfhi(a.w);
    x[8] = bflo(b.x); x[9] = bfhi(b.x); x[10] = bflo(b.y); x[11] = bfhi(b.y); x[12] = bflo(b.z); x[13] = bfhi(b.z); x[14] = bflo(b.w); x[15] = bfhi(b.w); return x;
}
struct Frags { u32x4 P[2][2][2]; u32x4 Q[2][2]; u32x4 R[2][2]; u32x4 Y[2]; };
__device__ __forceinline__ void load_frags_pr(Frags& F, __amdgpu_buffer_rsrc_t rb, unsigned vo16) {
#pragma unroll
    for (int kt = 0; kt < 2; ++kt)
#pragma unroll
        for (int kp = 0; kp < 2; ++kp) { F.P[kt][kp][0] = __builtin_amdgcn_raw_buffer_load_b128(rb, vo16, ((kt * 2 + kp) * 2 + 0) * 1024, 0); F.P[kt][kp][1] = __builtin_amdgcn_raw_buffer_load_b128(rb, vo16, ((kt * 2 + kp) * 2 + 1) * 1024, 0); }
#pragma unroll
    for (int kp = 0; kp < 2; ++kp) { F.R[kp][0] = __builtin_amdgcn_raw_buffer_load_b128(rb, vo16, 16384 + (kp * 2 + 0) * 1024, 0); F.R[kp][1] = __builtin_amdgcn_raw_buffer_load_b128(rb, vo16, 16384 + (kp * 2 + 1) * 1024, 0); }
}
template <int VT> __device__ __forceinline__ void load_frags_qy(Frags& F, __amdgpu_buffer_rsrc_t rb, unsigned vo16) {
#pragma unroll
    for (int kt = 0; kt < 2; ++kt) { F.Q[kt][0] = __builtin_amdgcn_raw_buffer_load_b128(rb, vo16, 8192 + ((kt * 2 + VT) * 2 + 0) * 1024, 0); F.Q[kt][1] = __builtin_amdgcn_raw_buffer_load_b128(rb, vo16, 8192 + ((kt * 2 + VT) * 2 + 1) * 1024, 0); }
    F.Y[0] = __builtin_amdgcn_raw_buffer_load_b128(rb, vo16, 20480 + (VT * 2 + 0) * 1024, 0); F.Y[1] = __builtin_amdgcn_raw_buffer_load_b128(rb, vo16, 20480 + (VT * 2 + 1) * 1024, 0);
}
__device__ __forceinline__ void group(const Args& A, int grp, unsigned char* ldsb) {
    const int tid = threadIdx.x, lane = tid & 63, wid = __builtin_amdgcn_readfirstlane(tid >> 6), n = lane & 31, hi = lane >> 5, ci = wid >> 1, vt = wid & 1;
    const int ch = grp * 4 + ci, b = ch >> 4, h = ch & 15, v = 32 * vt + n;
    bf16_t* Yo = (bf16_t*)(A.ws + WS_Y);
    LAS float* ex = (LAS float*)(LAS unsigned char*)ldsb;
    const float gnw = A.in[12][h * 64 + v], gnb = A.in[13][h * 64 + v], muv = A.in[4][2048 + h * 64 + v];
    const unsigned vo16 = (unsigned)lane * 16u;
    f32x16 H[2];
#pragma unroll
    for (int i = 0; i < 16; ++i) { H[0][i] = 0.f; H[1][i] = 0.f; }
    Frags cur, nxt;
    { const __amdgpu_buffer_rsrc_t rb0 = BUFR(rw_block(A, ch * RW_NCH), RW_TB); load_frags_pr(cur, rb0, vo16); if (vt) load_frags_qy<1>(cur, rb0, vo16); else load_frags_qy<0>(cur, rb0, vo16); }
    for (int c = 0; c < RW_NCH; ++c) {
        const int t0 = 32 * c;
        const __amdgpu_buffer_rsrc_t rbc = BUFR(rw_block(A, ch * RW_NCH + c) + 24576, 128);
        const __amdgpu_buffer_rsrc_t rbn = BUFR(rw_block(A, ch * RW_NCH + ((c + 1 < RW_NCH) ? c + 1 : c)), RW_TB);
        load_frags_pr(nxt, rbn, vo16);
        SBAR0;
        bf16x8 Hp[2][2];
        Hp[0][0] = pack8(H[0], 0); Hp[0][1] = pack8(H[0], 1); Hp[1][0] = pack8(H[1], 0); Hp[1][1] = pack8(H[1], 1);
        f32x16 Y = unpack16(cur.Y[0], cur.Y[1]);
#pragma unroll
        for (int kp = 0; kp < 2; ++kp)
#pragma unroll
            for (int s = 0; s < 2; ++s) Y = MFMA32(__builtin_bit_cast(bf16x8, cur.R[kp][s]), Hp[kp][s], Y);
#pragma unroll
        for (int kt = 0; kt < 2; ++kt) {
            f32x16 hn = unpack16(cur.Q[kt][0], cur.Q[kt][1]);
#pragma unroll
            for (int kp = 0; kp < 2; ++kp)
#pragma unroll
                for (int s = 0; s < 2; ++s) hn = MFMA32(__builtin_bit_cast(bf16x8, cur.P[kt][kp][s]), Hp[kp][s], hn);
            H[kt] = hn;
        }
        SBAR0;
        if (vt) load_frags_qy<1>(nxt, rbn, vo16); else load_frags_qy<0>(nxt, rbn, vo16);
        float vs[16], gt[16], bo[16];
        { const __amdgpu_buffer_rsrc_t rV = BUFR((const bf16_t*)(A.ws + WS_RKV) + ((size_t)b * LP + t0 - 1) * 3072 + 2048 + h * 64, 34 * 6144);
          const __amdgpu_buffer_rsrc_t rG = BUFR((const bf16_t*)(A.ws + WS_GR) + ((size_t)b * LP + t0) * 1024 + h * 64, 33 * 2048);
          const unsigned voV = (unsigned)(hi * 4 * 6144 + 2 * v), voG = (unsigned)(hi * 4 * 2048 + 2 * v), voB = (unsigned)(hi * 16);
          float cv[16], pv4[4];
#pragma unroll
          for (int r = 0; r < 16; ++r) { const int T0 = (r & 3) + 8 * (r >> 2); cv[r] = __uint_as_float((unsigned)__builtin_amdgcn_raw_buffer_load_b16(rV, voV, (T0 + 1) * 6144, 0) << 16);
              gt[r] = __uint_as_float((unsigned)__builtin_amdgcn_raw_buffer_load_b16(rG, voG, T0 * 2048, 0) << 16); bo[r] = __uint_as_float(__builtin_amdgcn_raw_buffer_load_b32(rbc, voB, 4 * T0, 0)); }
#pragma unroll
          for (int g = 0; g < 4; ++g) { pv4[g] = __uint_as_float((unsigned)__builtin_amdgcn_raw_buffer_load_b16(rV, voV, (8 * g) * 6144, 0) << 16); if (t0 + Tk(4 * g, hi) == 0) pv4[g] = 0.f; }
#pragma unroll
          for (int r = 0; r < 16; ++r) { const float pv = (r & 3) ? cv[r - 1] : pv4[r >> 2]; vs[r] = cv[r] + (pv - cv[r]) * muv; } }
        SBAR0;
        float s1[16], s2[16];
#pragma unroll
        for (int r = 0; r < 16; ++r) { s1[r] = sum32h(Y[r]); s2[r] = sum32h(Y[r] * Y[r]); }
        LAS float* exw = ex + ((c & 1) * 8 + wid) * 64; LAS float* exp_ = ex + ((c & 1) * 8 + (wid ^ 1)) * 64;
        if (n == 0) {
#pragma unroll
            for (int r = 0; r < 16; ++r) { exw[2 * Tk(r, hi)] = s1[r]; exw[2 * Tk(r, hi) + 1] = s2[r]; } }
        __syncthreads();
#pragma unroll
        for (int r = 0; r < 16; ++r) {
            const int T = Tk(r, hi), t = t0 + T;
            const f32x2 o2 = *(const LAS f32x2*)(exp_ + 2 * T);
            const float mean = (s1[r] + o2[0]) * (1.f / 64.f), var = fmaxf((s2[r] + o2[1]) * (1.f / 64.f) - mean * mean, 0.f);
            float o = (Y[r] - mean) * __builtin_amdgcn_rsqf(var + 64e-5f) * gnw + gnb + bo[r] * vs[r];
            const float g = gt[r]; o *= g * sigmoidf_(g);
            if (t >= NMETA && t < LSEQ) Yo[(size_t)(b * TS + t - NMETA) * DM + h * 64 + v] = (bf16_t)(pk2(o, 0.f) & 0xffffu);
        }
        cur = nxt;
    }
    __syncthreads();
}
}

namespace rwc {
using rwb::unpack16;
__device__ __forceinline__ void hrec(const Args& A, int grp) {
    const int tid = threadIdx.x, lane = tid & 63, wid = __builtin_amdgcn_readfirstlane(tid >> 6), ci = wid >> 1, vt = wid & 1;
    const int ch = grp * 4 + ci;
    const unsigned vo16 = (unsigned)lane * 16u;
    f32x16 H[2];
#pragma unroll
    for (int i = 0; i < 16; ++i) { H[0][i] = 0.f; H[1][i] = 0.f; }
    u32x4 cP[2][2][2], cQ[2][2], nP[2][2][2], nQ[2][2];
#define HREC_LOAD(P_, Q_, rb) do { \
        _Pragma("unroll") for (int kt = 0; kt < 2; ++kt) _Pragma("unroll") for (int kp = 0; kp < 2; ++kp) { P_[kt][kp][0] = __builtin_amdgcn_raw_buffer_load_b128(rb, vo16, ((kt * 2 + kp) * 2 + 0) * 1024, 0); P_[kt][kp][1] = __builtin_amdgcn_raw_buffer_load_b128(rb, vo16, ((kt * 2 + kp) * 2 + 1) * 1024, 0); } \
        _Pragma("unroll") for (int kt = 0; kt < 2; ++kt) { Q_[kt][0] = __builtin_amdgcn_raw_buffer_load_b128(rb, vo16, 8192 + ((kt * 2 + vt) * 2 + 0) * 1024, 0); Q_[kt][1] = __builtin_amdgcn_raw_buffer_load_b128(rb, vo16, 8192 + ((kt * 2 + vt) * 2 + 1) * 1024, 0); } } while (0)
    { const __amdgpu_buffer_rsrc_t rb0 = BUFR(rw_block(A, ch * RW_NCH), RW_TB); HREC_LOAD(cP, cQ, rb0); }
    for (int c = 0; c < RW_NCH; ++c) {
        const __amdgpu_buffer_rsrc_t rbc = BUFR(rw_block(A, ch * RW_NCH + c), RW_TB);
        const __amdgpu_buffer_rsrc_t rbn = BUFR(rw_block(A, ch * RW_NCH + ((c + 1 < RW_NCH) ? c + 1 : c)), RW_TB);
        HREC_LOAD(nP, nQ, rbn);
        bf16x8 Hp[2][2];
        Hp[0][0] = pack8(H[0], 0); Hp[0][1] = pack8(H[0], 1); Hp[1][0] = pack8(H[1], 0); Hp[1][1] = pack8(H[1], 1);
#pragma unroll
        for (int kt = 0; kt < 2; ++kt) {
            f32x16 hn = unpack16(cQ[kt][0], cQ[kt][1]);
#pragma unroll
            for (int kp = 0; kp < 2; ++kp)
#pragma unroll
                for (int s = 0; s < 2; ++s) hn = MFMA32(__builtin_bit_cast(bf16x8, cP[kt][kp][s]), Hp[kp][s], hn);
            H[kt] = hn;
        }
#pragma unroll
        for (int kp = 0; kp < 2; ++kp)
#pragma unroll
            for (int s = 0; s < 2; ++s) __builtin_amdgcn_raw_buffer_store_b128(__builtin_bit_cast(u32x4, Hp[kp][s]), rbc, vo16, 8192 + ((kp * 2 + vt) * 2 + s) * 1024, 0);
#pragma unroll
        for (int kt = 0; kt < 2; ++kt) { cQ[kt][0] = nQ[kt][0]; cQ[kt][1] = nQ[kt][1];
#pragma unroll
            for (int kp = 0; kp < 2; ++kp) { cP[kt][kp][0] = nP[kt][kp][0]; cP[kt][kp][1] = nP[kt][kp][1]; } }
    }
#undef HREC_LOAD
}

__device__ __forceinline__ void ytask(const Args& A, int task, int lane_) {
    int lane = lane_; asm volatile("" : "+v"(lane));
    const int n = lane & 31, hi = lane >> 5;
    const int ch = task / RW_NCH, c = task - ch * RW_NCH, b = ch >> 4, h = ch & 15, t0 = 32 * c;
    const __amdgpu_buffer_rsrc_t rb = BUFR(rw_block(A, task), RW_TB);
    const unsigned vo16 = (unsigned)lane * 16u;
    bf16_t* Yo = (bf16_t*)(A.ws + WS_Y);
    f32x16 Y[2];
    {
        u32x4 R[2][2], Hq[2][2][2], Yl[2][2];
#pragma unroll
        for (int kp = 0; kp < 2; ++kp)
#pragma unroll
            for (int s = 0; s < 2; ++s) { R[kp][s] = __builtin_amdgcn_raw_buffer_load_b128(rb, vo16, 16384 + (kp * 2 + s) * 1024, 0);
#pragma unroll
                for (int vt = 0; vt < 2; ++vt) Hq[kp][vt][s] = __builtin_amdgcn_raw_buffer_load_b128(rb, vo16, 8192 + ((kp * 2 + vt) * 2 + s) * 1024, 0); }
#pragma unroll
        for (int vt = 0; vt < 2; ++vt) { Yl[vt][0] = __builtin_amdgcn_raw_buffer_load_b128(rb, vo16, 20480 + (vt * 2 + 0) * 1024, 0); Yl[vt][1] = __builtin_amdgcn_raw_buffer_load_b128(rb, vo16, 20480 + (vt * 2 + 1) * 1024, 0); }
#pragma unroll
        for (int vt = 0; vt < 2; ++vt) {
            f32x16 y = unpack16(Yl[vt][0], Yl[vt][1]);
#pragma unroll
            for (int kp = 0; kp < 2; ++kp)
#pragma unroll
                for (int s = 0; s < 2; ++s) y = MFMA32(__builtin_bit_cast(bf16x8, R[kp][s]), __builtin_bit_cast(bf16x8, Hq[kp][vt][s]), y);
            Y[vt] = y;
        }
    }
    float vs[2][16], gt[2][16], bo[16];
    {
        const __amdgpu_buffer_rsrc_t rV = BUFR((const bf16_t*)(A.ws + WS_RKV) + ((size_t)b * LP + t0 - 1) * 3072 + 2048 + h * 64, 34 * 6144);
        const __amdgpu_buffer_rsrc_t rG = BUFR((const bf16_t*)(A.ws + WS_GR) + ((size_t)b * LP + t0) * 1024 + h * 64, 33 * 2048);
        const __amdgpu_buffer_rsrc_t rBn = BUFR(rw_block(A, task) + 24576, 128);
#pragma unroll
        for (int r = 0; r < 16; ++r) bo[r] = __uint_as_float(__builtin_amdgcn_raw_buffer_load_b32(rBn, (unsigned)(hi * 16), 4 * ((r & 3) + 8 * (r >> 2)), 0));
        const f32x2 muv = *(const f32x2*)(A.in[4] + 2048 + h * 64 + 2 * n);
        const unsigned voV = (unsigned)(hi * 4 * 6144 + 4 * n), voG = (unsigned)(hi * 4 * 2048 + 4 * n);
        unsigned cv[16], pv4[4];
#pragma unroll
        for (int r = 0; r < 16; ++r) { const int T0 = (r & 3) + 8 * (r >> 2); cv[r] = __builtin_amdgcn_raw_buffer_load_b32(rV, voV, (T0 + 1) * 6144, 0);
            const unsigned g2 = __builtin_amdgcn_raw_buffer_load_b32(rG, voG, T0 * 2048, 0); gt[0][r] = bflo(g2); gt[1][r] = bfhi(g2); }
#pragma unroll
        for (int g = 0; g < 4; ++g) pv4[g] = __builtin_amdgcn_raw_buffer_load_b32(rV, voV, (8 * g) * 6144, 0);
        asm volatile("" : "+v"(pv4[0]), "+v"(pv4[1]), "+v"(pv4[2]), "+v"(pv4[3]));
#pragma unroll
        for (int g = 0; g < 4; ++g) if (t0 + Tk(4 * g, hi) == 0) pv4[g] = 0u;
#pragma unroll
        for (int r = 0; r < 16; ++r) { const unsigned pv = (r & 3) ? cv[r - 1] : pv4[r >> 2]; const float c0 = bflo(cv[r]), c1 = bfhi(cv[r]), p0 = bflo(pv), p1 = bfhi(pv);
            vs[0][r] = c0 + (p0 - c0) * muv[0]; vs[1][r] = c1 + (p1 - c1) * muv[1]; }
    }
    __builtin_amdgcn_s_barrier();
    const f32x2 gnw = *(const f32x2*)(A.in[12] + h * 64 + 2 * n), gnb = *(const f32x2*)(A.in[13] + h * 64 + 2 * n);
#pragma unroll
    for (int r = 0; r < 16; ++r) {
        const int t = t0 + Tk(r, hi);
        const float y0 = Y[0][r], y1 = Y[1][r];
        const float mean = sum32h(y0 + y1) * (1.f / 64.f);
        const float d0 = y0 - mean, d1 = y1 - mean;
        const float var = sum32h(d0 * d0 + d1 * d1) * (1.f / 64.f);
        const float rs = __builtin_amdgcn_rsqf(var + 64e-5f);
        float o0 = d0 * rs * gnw[0] + gnb[0] + bo[r] * vs[0][r], o1 = d1 * rs * gnw[1] + gnb[1] + bo[r] * vs[1][r];
        o0 *= gt[0][r] * sigmoidf_(gt[0][r]); o1 *= gt[1][r] * sigmoidf_(gt[1][r]);
        if (t >= NMETA && t < LSEQ) *(unsigned*)(Yo + (size_t)(b * TS + t - NMETA) * DM + h * 64 + 2 * n) = pk2(o0, o1);
    }
    __builtin_amdgcn_s_barrier();
}
}

namespace att {
constexpr float THR = 8.f;
constexpr int O_K = 0, O_V = 32768, O_WSF = 69632, XP = 132;
__device__ __forceinline__ unsigned off_b(unsigned row, unsigned ch) { return 256u * row + 16u * (ch ^ (((row & 3u) << 2) | ((row >> 2) & 3u))); }

__device__ __forceinline__ void unit(const Args& A, int b, int h, int qb, float lam, unsigned char* ldsb) {
    const int tid = threadIdx.x, lane = tid & 63, wid = __builtin_amdgcn_readfirstlane(tid >> 6), r32 = lane & 31, hh = lane >> 5, qblk = wid >> 1, comp = wid & 1;
    const bf16_t* QD = (const bf16_t*)(A.ws + WS_QD); const bf16_t* KD = (const bf16_t*)(A.ws + WS_KD); const bf16_t* VD = (const bf16_t*)(A.ws + WS_VD); const bf16_t* GD = (const bf16_t*)(A.ws + WS_GD);
    bf16_t* Y = (bf16_t*)(A.ws + WS_Y);
    LAS unsigned char* lds3 = (LAS unsigned char*)ldsb;
    const int qpos0 = NMETA + 128 * qb + 32 * qblk, qpos = qpos0 + r32;
    const int NT = 2 * qb + 3, wlast = (qpos0 + 31) >> 6;
    bf16x8 qf[4];
    { const bf16_t* qp = QD + (size_t)(b * LP + qpos) * 1024 + h * 128 + comp * 64 + 8 * hh;
#pragma unroll
      for (int d0 = 0; d0 < 4; ++d0) qf[d0] = *(const bf16x8*)(qp + 16 * d0); }
    const int srow = tid >> 4, sch = tid & 15;
    const unsigned sdst0 = off_b(srow, sch), sdst1 = off_b(srow + 32, sch);
    const bf16_t* kg = KD + (size_t)(b * LP + srow) * 1024 + h * 128 + sch * 8; const bf16_t* vg = VD + (size_t)(b * LP + srow) * 1024 + h * 128 + sch * 8;
    u32x4 kA0, kA1, vA0, vA1, kB0, kB1, vB0, vB1;
#define ATT_LOAD(X, tl_) do { const size_t o_ = (size_t)(tl_) * 64 * 1024; k##X##0 = *(const u32x4*)(kg + o_); k##X##1 = *(const u32x4*)(kg + o_ + 32 * 1024); v##X##0 = *(const u32x4*)(vg + o_); v##X##1 = *(const u32x4*)(vg + o_ + 32 * 1024); } while (0)
#define ATT_STORE(X, buf) do { *(LAS u32x4*)(lds3 + O_K + (buf) * 16384 + sdst0) = k##X##0; *(LAS u32x4*)(lds3 + O_K + (buf) * 16384 + sdst1) = k##X##1; \
                               *(LAS u32x4*)(lds3 + O_V + (buf) * 16384 + sdst0) = v##X##0; *(LAS u32x4*)(lds3 + O_V + (buf) * 16384 + sdst1) = v##X##1; } while (0)
    const unsigned sw = ((r32 & 3) << 2) | ((r32 >> 2) & 3);
    const unsigned kx = (unsigned)(comp * 8 + hh) ^ sw;
    const unsigned kbase = 256u * r32;
    const unsigned q4 = (lane & 15) >> 2, p4 = lane & 3, blk = (lane >> 4) & 1, cb = 2 * blk + (p4 >> 1);
    float m = 0.f, lsum = 0.f;
    f32x16 NEGM;
#pragma unroll
    for (int i = 0; i < 16; ++i) NEGM[i] = 0.f;
    f32x16 O[4];
#pragma unroll
    for (int d = 0; d < 4; ++d)
#pragma unroll
        for (int i = 0; i < 16; ++i) O[d][i] = 0.f;
    LAS float* wsf = (LAS float*)(lds3 + O_WSF) + wid * 64;
    unsigned valo[4], vahi[4];
#pragma unroll
    for (int d = 0; d < 4; ++d) { valo[d] = 256u * (4 * hh + q4) + 16u * ((((unsigned)d ^ q4) << 2) | (cb ^ (unsigned)hh)) + 8u * (p4 & 1);
                                  vahi[d] = 256u * (8 + 4 * hh + q4) + 16u * ((((unsigned)d ^ q4) << 2) | (cb ^ (2u + (unsigned)hh))) + 8u * (p4 & 1); }
#define MAX3G(r_, a_, b_, c_) asm volatile("s_nop 15\n\tv_max3_f32 %0, %1, %2, %3" : "=v"(r_) : "v"(a_), "v"(b_), "v"(c_))
#define MAX3(r_, a_, b_, c_) asm("v_max3_f32 %0, %1, %2, %3" : "=v"(r_) : "v"(a_), "v"(b_), "v"(c_))
#define ATT_COMPUTE(tl_, cur_) do { const int tl = (tl_); \
            LAS unsigned char* Kb = lds3 + O_K + (cur_) * 16384; LAS unsigned char* Vb = lds3 + O_V + (cur_) * 16384; \
            f32x16 p0 = NEGM, p1 = NEGM; \
            _Pragma("unroll") for (int d0 = 0; d0 < 4; ++d0) { \
                const bf16x8 a0 = *(const LAS bf16x8*)(Kb + kbase + 16u * (kx ^ (2u * d0))); \
                const bf16x8 a1 = *(const LAS bf16x8*)(Kb + 8192 + kbase + 16u * (kx ^ (2u * d0))); \
                p0 = __builtin_amdgcn_mfma_f32_32x32x16_bf16(a0, qf[d0], p0, 0, 0, 0); \
                p1 = __builtin_amdgcn_mfma_f32_32x32x16_bf16(a1, qf[d0], p1, 0, 0, 0); } \
            if (64 * tl + 63 > qpos0) { \
                _Pragma("unroll") for (int r = 0; r < 16; ++r) { const int kp = 64 * tl + (r & 3) + 8 * (r >> 2) + 4 * hh; if (kp > qpos) p0[r] = -INFINITY; if (kp + 32 > qpos) p1[r] = -INFINITY; } } \
            float rm, rm2; MAX3G(rm, p0[0], p1[0], p0[1]); MAX3(rm2, rm, p1[1], p0[2]); MAX3(rm, rm, p1[2], p0[3]); \
            MAX3(rm2, rm2, p1[3], p0[4]); MAX3(rm, rm, p1[4], p0[5]); MAX3(rm2, rm2, p1[5], p0[6]); MAX3(rm, rm, p1[6], p0[7]); \
            MAX3(rm2, rm2, p1[7], p0[8]); MAX3(rm, rm, p1[8], p0[9]); MAX3(rm2, rm2, p1[9], p0[10]); MAX3(rm, rm, p1[10], p0[11]); \
            MAX3(rm2, rm2, p1[11], p0[12]); MAX3(rm, rm, p1[12], p0[13]); MAX3(rm2, rm2, p1[13], p0[14]); MAX3(rm, rm, p1[14], p0[15]); \
            MAX3(rm, rm, rm2, p1[15]); \
            rm = swap32_max(rm); \
            if (tl == 0 || __any(rm > THR)) {            \
                const float dm = (tl == 0) ? rm : fmaxf(rm, 0.f), alpha = (tl == 0) ? 1.f : __builtin_amdgcn_exp2f(-dm);        \
                lsum *= alpha; m += dm; \
                if (hh == 0) wsf[r32] = alpha; \
                asm volatile("s_waitcnt lgkmcnt(0)" ::: "memory"); \
                _Pragma("unroll") for (int g = 0; g < 4; ++g) { const f32x4 a4 = *(const LAS f32x4*)(wsf + 8 * g + 4 * hh); \
                    _Pragma("unroll") for (int d = 0; d < 4; ++d) { O[d][4 * g] *= a4[0]; O[d][4 * g + 1] *= a4[1]; O[d][4 * g + 2] *= a4[2]; O[d][4 * g + 3] *= a4[3]; } } \
                _Pragma("unroll") for (int r = 0; r < 16; ++r) { p0[r] -= dm; p1[r] -= dm; NEGM[r] = -m; } \
            } \
            float ps0 = 0.f, ps1 = 0.f; \
            _Pragma("unroll") for (int r = 0; r < 16; ++r) { p0[r] = __builtin_amdgcn_exp2f(p0[r]); p1[r] = __builtin_amdgcn_exp2f(p1[r]); ps0 += p0[r]; ps1 += p1[r]; } \
            lsum += ps0 + ps1; \
            bf16x8 pw[4]; \
            pw[0] = __builtin_bit_cast(bf16x8, (u32x4){pk2(p0[0], p0[1]), pk2(p0[2], p0[3]), pk2(p0[4], p0[5]), pk2(p0[6], p0[7])}); \
            pw[1] = __builtin_bit_cast(bf16x8, (u32x4){pk2(p0[8], p0[9]), pk2(p0[10], p0[11]), pk2(p0[12], p0[13]), pk2(p0[14], p0[15])}); \
            pw[2] = __builtin_bit_cast(bf16x8, (u32x4){pk2(p1[0], p1[1]), pk2(p1[2], p1[3]), pk2(p1[4], p1[5]), pk2(p1[6], p1[7])}); \
            pw[3] = __builtin_bit_cast(bf16x8, (u32x4){pk2(p1[8], p1[9]), pk2(p1[10], p1[11]), pk2(p1[12], p1[13]), pk2(p1[14], p1[15])}); \
            _Pragma("unroll") for (int s = 0; s < 4; ++s) \
                _Pragma("unroll") for (int d = 0; d < 4; ++d) { \
                    const s16x4 lo = __builtin_amdgcn_ds_read_tr16_b64_v4i16((LAS s16x4*)(Vb + 4096 * s + valo[d])); \
                    const s16x4 hi = __builtin_amdgcn_ds_read_tr16_b64_v4i16((LAS s16x4*)(Vb + 4096 * s + vahi[d])); \
                    const bf16x8 vf = {lo[0], lo[1], lo[2], lo[3], hi[0], hi[1], hi[2], hi[3]}; \
                    O[d] = __builtin_amdgcn_mfma_f32_32x32x16_bf16(pw[s], vf, O[d], 0, 0, 0); } \
        } while (0)

    ATT_LOAD(A, 0); ATT_STORE(A, 0);
    __syncthreads();
    if (NT > 1) ATT_LOAD(A, 1);
    for (int t2 = 0; t2 < NT; t2 += 2) {
        if (t2 + 2 < NT) ATT_LOAD(B, t2 + 2);
        if (t2 <= wlast) ATT_COMPUTE(t2, 0);
        if (t2 + 1 < NT) ATT_STORE(A, 1);
        __syncthreads();
        if (t2 + 1 >= NT) break;
        if (t2 + 3 < NT) ATT_LOAD(A, t2 + 3);
        if (t2 + 1 <= wlast) ATT_COMPUTE(t2 + 1, 1);
        if (t2 + 2 < NT) ATT_STORE(B, 0);
        __syncthreads();
    }
#undef ATT_COMPUTE
#undef MAX3
#undef MAX3G
#undef ATT_LOAD
#undef ATT_STORE
    const float lt = swap32_sum(lsum);
    const float sc = (comp ? lam : 1.f) / lt;
    if (hh == 0) wsf[r32] = sc;
    asm volatile("s_waitcnt lgkmcnt(0)" ::: "memory");
    LAS float* X = (LAS float*)lds3 + qblk * (32 * XP);
    if (comp == 1) {
#pragma unroll
        for (int g = 0; g < 4; ++g) { const f32x4 s4 = *(const LAS f32x4*)(wsf + 8 * g + 4 * hh);
#pragma unroll
            for (int i = 0; i < 4; ++i)
#pragma unroll
                for (int d = 0; d < 4; ++d) X[(8 * g + 4 * hh + i) * XP + 32 * d + r32] = O[d][4 * g + i] * s4[i]; }
    }
    __syncthreads();
    if (comp == 0) {
#pragma unroll
        for (int g = 0; g < 4; ++g) { const f32x4 s4 = *(const LAS f32x4*)(wsf + 8 * g + 4 * hh);
#pragma unroll
            for (int i = 0; i < 4; ++i)
#pragma unroll
                for (int d = 0; d < 4; ++d) { LAS float* xp = X + (8 * g + 4 * hh + i) * XP + 32 * d + r32; *xp = O[d][4 * g + i] * s4[i] - *xp; } }
        asm volatile("s_waitcnt lgkmcnt(0)" ::: "memory");
        const LAS float* xr = X + r32 * XP + 64 * hh;
        f32x4 dv[16]; float ss = 0.f;
#pragma unroll
        for (int i = 0; i < 16; ++i) { dv[i] = *(const LAS f32x4*)(xr + 4 * i); ss += (dv[i][0] * dv[i][0] + dv[i][1] * dv[i][1]) + (dv[i][2] * dv[i][2] + dv[i][3] * dv[i][3]); }
        ss = swap32_sum(ss);
        const float rms = __builtin_amdgcn_rsqf(ss * (1.f / 128.f) + 1e-5f) * 0.8f;
        const bf16_t* gp = GD + (size_t)(b * LP + qpos) * 1024 + h * 128 + 64 * hh; const float* sw_ = A.in[18] + 64 * hh;
        bf16_t* yp = Y + (size_t)(b * TS + qpos - NMETA) * DM + 1024 + h * 128 + 64 * hh;
#pragma unroll
        for (int c8 = 0; c8 < 8; ++c8) {
            const u32x4 gv = *(const u32x4*)(gp + 8 * c8); const f32x4 w0 = *(const f32x4*)(sw_ + 8 * c8), w1 = *(const f32x4*)(sw_ + 8 * c8 + 4);
            const float g0 = bflo(gv.x), g1 = bfhi(gv.x), g2 = bflo(gv.y), g3 = bfhi(gv.y), g4 = bflo(gv.z), g5 = bfhi(gv.z), g6 = bflo(gv.w), g7 = bfhi(gv.w);
            const f32x4 d0 = dv[2 * c8], d1 = dv[2 * c8 + 1];
            u32x4 o;
            o.x = pk2(d0[0] * rms * w0[0] * g0 * sigmoidf_(g0), d0[1] * rms * w0[1] * g1 * sigmoidf_(g1));
            o.y = pk2(d0[2] * rms * w0[2] * g2 * sigmoidf_(g2), d0[3] * rms * w0[3] * g3 * sigmoidf_(g3));
            o.z = pk2(d1[0] * rms * w1[0] * g4 * sigmoidf_(g4), d1[1] * rms * w1[1] * g5 * sigmoidf_(g5));
            o.w = pk2(d1[2] * rms * w1[2] * g6 * sigmoidf_(g6), d1[3] * rms * w1[3] * g7 * sigmoidf_(g7));
            *(u32x4*)(yp + 8 * c8) = o;
        }
    }
    __syncthreads();
}
}

#define XB_TMO      128
#define XB_XCNT(j)  (256  + 64 * (j))
#define XB_XSUB(j)  (1280 + 64 * (j))
#define XB_XGEN(j)  (2304 + 64 * (j))
#define XB_TOP      3328
#define XB_TOPGEN   3392
#define XCD_BAR_WORDS 3456
#define XB_SPIN_CAP (1u << 18)

__device__ __forceinline__ unsigned xb_ld(unsigned* p)              { return __hip_atomic_load(p, __ATOMIC_RELAXED, __HIP_MEMORY_SCOPE_AGENT); }
__device__ __forceinline__ unsigned xb_add(unsigned* p, unsigned v) { return __hip_atomic_fetch_add(p, v, __ATOMIC_RELAXED, __HIP_MEMORY_SCOPE_AGENT); }
__device__ __forceinline__ unsigned xb_xcc_id() { return (unsigned)__builtin_amdgcn_s_getreg((3 << 11) | 20) & 0xFu; }
#define XB_SPIN(cond, bar) do { unsigned _sp = 0; while (cond) { __builtin_amdgcn_s_sleep(1); \
    if ((++_sp & 255u) == 0u) { if (xb_ld(&(bar)[XB_TMO])) break; if (_sp > XB_SPIN_CAP) { atomicAdd(&(bar)[XB_TMO], 1u); break; } } } } while (0)

struct XcdBarrier {
    unsigned* bar; unsigned x;
    volatile LAS unsigned* st;
};

__device__ __forceinline__ XcdBarrier xcd_barrier_post(unsigned* bar, volatile LAS unsigned* st) {
    XcdBarrier b; b.bar = bar; b.x = xb_xcc_id(); b.st = st;
    if (threadIdx.x == 0) (void)xb_add(&bar[XB_XCNT(b.x)], 1u);
    return b;
}
__device__ __forceinline__ void xcd_barrier_complete(unsigned* bar, unsigned x, unsigned& nloc, unsigned& nx) {
    const unsigned G = gridDim.x * gridDim.y * gridDim.z;
    unsigned sum, cnt, mine, sp = 0u;
    for (;;) {
        sum = 0u; cnt = 0u; mine = 0u;
#pragma unroll
        for (unsigned j = 0; j < 16; ++j) { const unsigned c = xb_ld(&bar[XB_XCNT(j)]); sum += c; cnt += (c > 0u) ? 1u : 0u; mine = (j == x) ? c : mine; }
        if (sum == G) break;
        __builtin_amdgcn_s_sleep(1);
        if ((++sp & 255u) == 0u) { if (xb_ld(&bar[XB_TMO])) break; if (sp > XB_SPIN_CAP) { atomicAdd(&bar[XB_TMO], 1u); break; } }
    }
    nloc = mine > 0u ? mine : 1u; nx = cnt > 0u ? cnt : 1u;
}

__device__ __forceinline__ void xcd_barrier(const XcdBarrier& b) {
    asm volatile("s_waitcnt vmcnt(0)" ::: "memory");
    __syncthreads();
    if (threadIdx.x == 0) {
        unsigned* bar = b.bar;
        __builtin_amdgcn_s_waitcnt(0);
        unsigned nloc = b.st[0], nx = b.st[1];
        if (nloc == 0u) { xcd_barrier_complete(bar, b.x, nloc, nx); b.st[0] = nloc; b.st[1] = nx; }
        const unsigned old = xb_add(&bar[XB_XSUB(b.x)], 1u);
        const unsigned gen = old / nloc;
        if (old + 1u == (gen + 1u) * nloc) {
            __builtin_amdgcn_fence(__ATOMIC_RELEASE, "agent");
            asm volatile("s_waitcnt vmcnt(0)" ::: "memory");
            const unsigned og = xb_add(&bar[XB_TOP], 1u);
            const unsigned tg = og / nx;
            if (og + 1u == (tg + 1u) * nx) xb_add(&bar[XB_TOPGEN], 1u);
            else XB_SPIN(xb_ld(&bar[XB_TOPGEN]) == tg, bar);
            __builtin_amdgcn_fence(__ATOMIC_ACQUIRE, "agent");
            xb_add(&bar[XB_XGEN(b.x)], 1u);
            asm volatile("s_waitcnt vmcnt(0)" ::: "memory");
        } else {
            XB_SPIN(xb_ld(&bar[XB_XGEN(b.x)]) == gen, bar);
            __builtin_amdgcn_fence(__ATOMIC_ACQUIRE, "agent");
            asm volatile("s_waitcnt vmcnt(0)" ::: "memory");
        }
    }
    __syncthreads();
}


__global__ void __launch_bounds__(512, 2) hymba_fwd(Args A) {
    extern __shared__ __attribute__((aligned(16))) unsigned char lds[];
    const int tid = threadIdx.x, lane = tid & 63, wave = __builtin_amdgcn_readfirstlane(tid >> 6);
    const int G = gridDim.x, bx = blockIdx.x;
    const int lo = A.ph_lo, hi = A.ph_hi;
    unsigned char* ws = A.ws;
    bf16_t* W1T = (bf16_t*)(ws + WS_W1T); bf16_t* W2T = (bf16_t*)(ws + WS_W2T); bf16_t* XN = (bf16_t*)(ws + WS_XN);
    float* ROPE = (float*)(ws + WS_ROPE); float* SSQ = (float*)(ws + WS_SSQ);
#define IN_PH(k) (lo <= (k) && (k) < hi)
    volatile LAS unsigned* bst = (volatile LAS unsigned*)((LAS unsigned char*)lds + LDS_BARW);
    if (tid < 2) bst[tid] = 0u;
    __syncthreads();
    XcdBarrier gbar; gbar.bar = (unsigned*)(ws + WS_CTL) + CW_BAR; gbar.x = 0; gbar.st = nullptr;
    if (A.coop) gbar = xcd_barrier_post((unsigned*)(ws + WS_CTL) + CW_BAR, bst);
#define GRID_SYNC(k) do { if (A.coop && IN_PH(k) && IN_PH((k) + 1)) { xcd_barrier(gbar); } } while (0)

    if (IN_PH(0)) {
        const int gw = bx * 8 + wave, NGW = G * 8;
        LAS float* scr = (LAS float*)((LAS unsigned char*)lds + wave * 17408);
        constexpr int I_1 = P0_I1, I_2 = 0;
        if (gw < I_1 + I_2) {
            f32x4 cur[16]; p0_ld(cur, A, gw, lane);
            for (int it = gw; it < I_1 + I_2; it += NGW) {
                f32x4 nxt[16]; { const int nx = it + NGW; p0_ld(nxt, A, nx < I_1 + I_2 ? nx : it, lane); }
                p0_emit(cur, W1T, W2T, scr, it, lane);
#pragma unroll
                for (int i = 0; i < 16; ++i) cur[i] = nxt[i];
            }
        }
        for (int e = bx * 512 + tid; e < 128 * 2048 / 8; e += G * 512) *(u32x4*)(W1T + (size_t)8320 * 2048 + (size_t)e * 8) = (u32x4){0u, 0u, 0u, 0u};
        { const f32x4* wv = (const f32x4*)A.in[2] + lane; f32x4 pw[8];
#pragma unroll
          for (int j = 0; j < 8; ++j) pw[j] = wv[64 * j];
          constexpr int NREAL = MR + NMETA;
#define XN_SRC(row) ((const f32x4*)(((row) < MR) ? A.in[0] + (size_t)(row) * DM : A.in[1] + (size_t)((row) - MR) * DM) + lane)
          f32x4 v[8];
          { const f32x4* xr = XN_SRC(gw);
#pragma unroll
            for (int j = 0; j < 8; ++j) v[j] = __builtin_nontemporal_load(xr + 64 * j); }
          for (int mrow = gw; mrow < NREAL; mrow += NGW) {
              f32x4 nv[8]; { const int nx = mrow + NGW; const int nr = nx < NREAL ? nx : mrow; const f32x4* xr = XN_SRC(nr);
#pragma unroll
                for (int j = 0; j < 8; ++j) nv[j] = __builtin_nontemporal_load(xr + 64 * j); }
              unsigned long long* o8 = (unsigned long long*)(XN + (size_t)mrow * DM) + lane;
              float s = 0.f;
#pragma unroll
              for (int j = 0; j < 8; ++j) s += (v[j][0] * v[j][0] + v[j][1] * v[j][1]) + (v[j][2] * v[j][2] + v[j][3] * v[j][3]);
              const float rstd = __builtin_amdgcn_rsqf(wave_sum(s) * (1.f / DM) + 1e-6f);
#pragma unroll
              for (int j = 0; j < 8; ++j) { const f32x4 y = v[j] * rstd * pw[j]; o8[64 * j] = (unsigned long long)pk2(y[0], y[1]) | ((unsigned long long)pk2(y[2], y[3]) << 32); }
#pragma unroll
              for (int j = 0; j < 8; ++j) v[j] = nv[j];
          }
#undef XN_SRC
          for (int mrow = NREAL + gw; mrow < MP; mrow += NGW) {
              unsigned long long* o8 = (unsigned long long*)(XN + (size_t)mrow * DM) + lane;
#pragma unroll
              for (int j = 0; j < 8; ++j) o8[64 * j] = 0ull;
          } }
        for (int e = bx * 512 + tid; e < LSEQ * 32; e += G * 512) {
            const int pos = e >> 5, i = e & 31; const double rev = (double)pos * (double)A.inv_freq[i] * 0.15915494309189535; const float f = (float)(rev - floor(rev));
            ROPE[2 * e] = __builtin_amdgcn_cosf(f); ROPE[2 * e + 1] = __builtin_amdgcn_sinf(f); }
        { u32x4* LF = (u32x4*)(ws + WS_LF);
          for (int e = bx * 512 + tid; e < 16 * 2 * 2 * 4 * 64; e += G * 512) {
              const int l = e & 63, s_ = (e >> 6) & 3, nb = (e >> 8) & 1, mat = (e >> 9) & 1, hd = e >> 10; const float* up = mat ? A.in[8] : A.in[6];
              const float* p = up + (size_t)(16 * s_ + 8 * (l >> 5)) * 1024 + hd * 64 + 2 * (l & 31) + nb;
              LF[e] = (u32x4){pk2(p[0], p[1024]), pk2(p[2048], p[3072]), pk2(p[4096], p[5120]), pk2(p[6144], p[7168])}; } }
        { bf16_t* KD = (bf16_t*)(ws + WS_KD); bf16_t* VD = (bf16_t*)(ws + WS_VD); constexpr int PADC = (LP - LSEQ) * 1024 / 8;
          for (int e = bx * 512 + tid; e < NB * PADC * 2; e += G * 512) { const int which = e / (NB * PADC), r = e % (NB * PADC), b = r / PADC, c = r % PADC;
              *(u32x4*)((which ? VD : KD) + (size_t)(b * LP + LSEQ) * 1024 + (size_t)c * 8) = (u32x4){0u, 0u, 0u, 0u}; } }
    }
    GRID_SYNC(0);

    if (IN_PH(1)) {
        pg8::Gemm g{XN, W1T, MP, N1, DM}; pg8::StaticOrder S; S.init(MP, N1, G, bx);
        EpiProj E{(bf16_t*)(ws + WS_RKV), (bf16_t*)(ws + WS_GR), (bf16_t*)(ws + WS_WA), (bf16_t*)(ws + WS_QD), (bf16_t*)(ws + WS_KD), (bf16_t*)(ws + WS_VD), (bf16_t*)(ws + WS_GD), ROPE};
        pg8::gemm_phase<EpiProj, pg8::StaticOrder, true, true>((PG8_LAS unsigned char*)lds, g, S, E);
    }
    GRID_SYNC(1);

    if (IN_PH(2)) {
        const int gw = bx * 8 + wave, NGW = G * 8;
        LAS unsigned char* wl = (LAS unsigned char*)lds + wave * 18432;
        for (int sl = gw; sl < 128 * (RW_NCH - 1); sl += NGW) { rwa::task(A, (sl >> 6) * RW_NCH + (sl & 63), wl, lane); __builtin_amdgcn_s_barrier(); }
    }
    GRID_SYNC(2);

    if (IN_PH(3)) {
        float lam;
        { const float a = A.in[14][lane] * A.in[15][lane], c = A.in[16][lane] * A.in[17][lane];
          lam = fexp(wave_sum(a)) - fexp(wave_sum(c)) + 0.2f; }
        unsigned* qctr = (unsigned*)(ws + WS_CTL);
        volatile LAS int* qw = (volatile LAS int*)((LAS unsigned char*)lds + LDS_QW);
        constexpr int NRG = 32, NTL = 16, NW2 = 16, NITEMS = NRG + NTL + NW2 + 1024;
#define Q_FETCH(dst) do { __syncthreads(); if (tid == 0) *qw = (int)atomicAdd(qctr, 1u); __syncthreads(); dst = *qw; } while (0)
        int item; Q_FETCH(item);
        while (item < NRG) { rwc::hrec(A, item); Q_FETCH(item); }
        while (item < NRG + NTL) { rwa::task(A, ((item - NRG) * 8 + wave) * RW_NCH + (RW_NCH - 1), (LAS unsigned char*)lds + wave * 18432, lane); __builtin_amdgcn_s_barrier(); Q_FETCH(item); }
        while (item < NRG + NTL + NW2) {
            LAS float* scr = (LAS float*)((LAS unsigned char*)lds + wave * 17408);
            const int base = P0_I1 + (item - NRG - NTL) * 64 + wave * 8;
            f32x4 cur[16]; p0_ld(cur, A, base, lane);
            for (int j = 0; j < 8; ++j) { f32x4 nxt[16]; p0_ld(nxt, A, base + (j < 7 ? j + 1 : j), lane); p0_emit(cur, W1T, W2T, scr, base + j, lane);
#pragma unroll
                for (int i = 0; i < 16; ++i) cur[i] = nxt[i]; }
            Q_FETCH(item);
        }
        while (item < NITEMS) { const int a = item - NRG - NTL - NW2, qb = 15 - (a >> 6), bh = a & 63; att::unit(A, bh >> 3, bh & 7, qb, lam, lds); Q_FETCH(item); }
#undef Q_FETCH
    }
    GRID_SYNC(3);

    if (IN_PH(4)) {
        const int gw = bx * 8 + wave, NGW = G * 8;
        const int full_ = RW_TASKS / NGW;
        for (int it_ = 0; it_ < full_; ++it_) rwc::ytask(A, gw + it_ * NGW, lane);
        { const int left_ = RW_TASKS - full_ * NGW;
          for (int base_ = 0; base_ < left_; base_ += G) {
              if (wave == 0 && base_ + bx < left_) rwc::ytask(A, full_ * NGW + base_ + bx, lane);
              else { __builtin_amdgcn_s_barrier(); __builtin_amdgcn_s_barrier(); }
          } }
    }
    GRID_SYNC(4);

    if (IN_PH(5)) {
        pg8::Gemm g{(const bf16_t*)(ws + WS_Y), W2T, MR, DM, DM}; pg8::StaticOrder S; S.init(MR, DM, G, bx);
        EpiY E{XN  , SSQ};
        pg8::gemm_phase<EpiY, pg8::StaticOrder, true, true>((PG8_LAS unsigned char*)lds, g, S, E);
    }
    GRID_SYNC(5);

    if (IN_PH(6)) {
        const int gw = bx * 8 + wave, NGW = G * 8;
        const f32x4* wv = (const f32x4*)A.in[20] + lane; f32x4 pw[8];
#pragma unroll
        for (int j = 0; j < 8; ++j) pw[j] = wv[64 * j];
        const bf16_t* YO = XN;
        u32x2 yv[8];
        { const u32x2* yr = (const u32x2*)(YO + (size_t)gw * DM) + lane;
#pragma unroll
          for (int j = 0; j < 8; ++j) yv[j] = yr[64 * j]; }
        for (int row = gw; row < MR; row += NGW) {
            const f32x4* xr = (const f32x4*)(A.in[0] + (size_t)row * DM) + lane;
            f32x4 xv[8];
#pragma unroll
            for (int j = 0; j < 8; ++j) xv[j] = __builtin_nontemporal_load(xr + 64 * j);
            u32x2 nyv[8];
            { const int nx = row + NGW; const u32x2* yr = (const u32x2*)(YO + (size_t)(nx < MR ? nx : row) * DM) + lane;
#pragma unroll
              for (int j = 0; j < 8; ++j) nyv[j] = yr[64 * j]; }
            float ssq = 0.f;
#pragma unroll
            for (int j = 0; j < 8; ++j) { const float e0 = bflo(yv[j].x), e1 = bfhi(yv[j].x), e2 = bflo(yv[j].y), e3 = bfhi(yv[j].y); ssq += (e0 * e0 + e1 * e1) + (e2 * e2 + e3 * e3); }
            const float rstd = __builtin_amdgcn_rsqf(wave_sum(ssq) * (1.f / DM) + 1e-6f);
            f32x4* orow = (f32x4*)(A.out + (size_t)row * DM) + lane;
#pragma unroll
            for (int j = 0; j < 8; ++j) { const f32x4 y = {bflo(yv[j].x), bfhi(yv[j].x), bflo(yv[j].y), bfhi(yv[j].y)};
                orow[64 * j] = xv[j] + y * rstd * pw[j]; }
#pragma unroll
            for (int j = 0; j < 8; ++j) yv[j] = nyv[j];
        }
    }
#undef IN_PH
#undef GRID_SYNC
}

extern "C" void kernel_launch(void* const* d_in, const int* in_sizes, int n_in, void* d_out, int out_size, void* d_ws, size_t ws_size, hipStream_t stream) {
    static int grid = 0;
    if (grid == 0) {
        if (n_in != 21 || in_sizes[0] != MR * DM || out_size != MR * DM || ws_size < WS_END) { fprintf(stderr, "kernel_launch: unexpected shapes (n_in %d, in0 %d, out %d, ws %zu); nothing launched\n", n_in, n_in > 0 ? in_sizes[0] : -1, out_size, ws_size); grid = -1; return; }
        int dev = 0, cus = 0, per_cu = 0;
        if (hipGetDevice(&dev) != hipSuccess || hipDeviceGetAttribute(&cus, hipDeviceAttributeMultiprocessorCount, dev) != hipSuccess) { grid = -1; return; }
        if (hipFuncSetAttribute((const void*)hymba_fwd, hipFuncAttributeMaxDynamicSharedMemorySize, LDS_BYTES) != hipSuccess) { fprintf(stderr, "kernel_launch: hipFuncSetAttribute failed\n"); grid = -1; return; }
        if (hipOccupancyMaxActiveBlocksPerMultiprocessor(&per_cu, (const void*)hymba_fwd, 512, LDS_BYTES) != hipSuccess || per_cu < 1) { fprintf(stderr, "kernel_launch: occupancy query reports %d\n", per_cu); per_cu = 1; }
        (void)hipGetLastError();
        grid = cus;
    }
    if (grid < 0) return;
    (void)hipMemsetAsync((char*)d_ws + WS_CTL, 0, CTL_ZERO_BYTES, stream);
    Args a{};
    for (int i = 0; i < 21; ++i) a.in[i] = (const float*)d_in[i];
    a.out = (float*)d_out; a.ws = (unsigned char*)d_ws;
    for (int i = 0; i < 32; ++i) a.inv_freq[i] = (float)pow(10000.0, -(double)(2 * i) / 64.0);
#if MK_N_LAUNCHES == 1
    a.ph_lo = 0; a.ph_hi = NPH; a.coop = 1;
    void* kargs[] = {&a};
    (void)kargs;
    hipLaunchKernelGGL(hymba_fwd, dim3(grid), dim3(512), LDS_BYTES, stream, a);
#else
    for (int p = 0; p < NPH; ++p) { a.ph_lo = p; a.ph_hi = p + 1; a.coop = 0; hipLaunchKernelGGL(hymba_fwd, dim3(grid), dim3(512), LDS_BYTES, stream, a); }
#endif
}
```
